# Optimizing an MI355X kernel written in HIP

```python
import numpy as np
import jax
import jax.numpy as jnp
from jax import lax

D_MODEL = 2048
BATCH = 8
SEQ = 2048
DEPTH = 1

CHUNK = 64
N_MEM = 256
NORM_EPS = 1e-6
NEG_INF = -1e30

A_HEADS = 8
A_HEAD_DIM = 128
A_WIDTH = A_HEADS * A_HEAD_DIM
A_LEFT_CHUNKS = 8
A_BAND = (A_LEFT_CHUNKS + 1) * CHUNK
REL_CLIP = 128

B_HEADS = 16
B_HEAD_DIM = 64
B_WIDTH = B_HEADS * B_HEAD_DIM
DECAY_LORA = 64
ICLR_LORA = 64
GN_EPS = 64e-5

C_HEADS = 4
C_HEAD_DIM = 256
C_WIDTH = C_HEADS * C_HEAD_DIM

IN_SPLITS = (A_WIDTH,) * 4 + (B_WIDTH,) * 4 + (DECAY_LORA, ICLR_LORA) + (C_WIDTH,) * 2 + (D_MODEL,) * 3
IN_COLS = sum(IN_SPLITS)

kernel_name = "hybrid_chunkattn_rwkv7_memxattn"


def rms_norm(x, g):
    xf = x.astype(jnp.float32)
    y = xf * lax.rsqrt(jnp.mean(xf * xf, axis=-1, keepdims=True) + NORM_EPS)
    return (y * g.astype(jnp.float32)).astype(x.dtype)


def _rel_index():
    r = np.arange(CHUNK)[:, None]
    m = np.arange(A_BAND)[None, :]
    dist = r + A_LEFT_CHUNKS * CHUNK - m
    return np.clip(dist, -REL_CLIP, REL_CLIP) + REL_CLIP


def chunked_band_attention(q, k, v, rel_bias):
    bsz, s, h, dh = q.shape
    n_chunks = s // CHUNK
    pad = A_LEFT_CHUNKS * CHUNK
    kp = jnp.pad(k, ((0, 0), (pad, 0), (0, 0), (0, 0)))
    vp = jnp.pad(v, ((0, 0), (pad, 0), (0, 0), (0, 0)))
    bias = rel_bias[:, _rel_index()].astype(jnp.float32)
    band_pos = jnp.arange(A_BAND) - pad
    scale = dh ** -0.5

    def one_chunk(c):
        start = c * CHUNK
        qc = lax.dynamic_slice_in_dim(q, start, CHUNK, axis=1)
        kc = lax.dynamic_slice_in_dim(kp, start, A_BAND, axis=1)
        vc = lax.dynamic_slice_in_dim(vp, start, A_BAND, axis=1)
        sc = jnp.einsum('bqhd,bkhd->bhqk', qc, kc, preferred_element_type=jnp.float32) * scale + bias
        valid = (start + band_pos) >= 0
        sc = jnp.where(valid[None, None, None, :], sc, NEG_INF)
        p = jax.nn.softmax(sc, axis=-1)
        return jnp.einsum('bhqk,bkhd->bqhd', p.astype(vc.dtype), vc)

    out = lax.map(one_chunk, jnp.arange(n_chunks))
    return jnp.transpose(out, (1, 0, 2, 3, 4)).reshape(bsz, s, h * dh)


def token_shift_lerp(p, mu):
    prev = jnp.pad(p, ((0, 0), (1, 0), (0, 0)))[:, :-1]
    return p + mu * (prev - p)


def rwkv7_scan(r, decay, k, v, a_vec, b_vec):
    bsz, _, h, n = r.shape

    def step(state, inp):
        r_t, w_t, k_t, v_t, a_t, b_t = inp
        sa = jnp.einsum('bhij,bhj->bhi', state, a_t)
        state = state * w_t[:, :, None, :] + sa[..., None] * b_t[:, :, None, :] + v_t[..., None] * k_t[:, :, None, :]
        return state, jnp.einsum('bhij,bhj->bhi', state, r_t)

    xs = tuple(jnp.moveaxis(t, 1, 0) for t in (r, decay, k, v, a_vec, b_vec))
    s0 = jnp.zeros((bsz, h, n, n), jnp.float32)
    _, out = lax.scan(step, s0, xs)
    return jnp.moveaxis(out, 0, 1)


def rwkv7_time_mix(p_r, p_k, p_v, p_wd, p_ad, mu_rkv, mu_w, mu_a, w0, w2, a0, a2, k_k, k_a, r_k, ln_w, ln_b):
    f = lambda t: t.astype(jnp.float32)
    p_r, p_k, p_v, p_wd, p_ad = f(p_r), f(p_k), f(p_v), f(p_wd), f(p_ad)
    bsz, s, _ = p_r.shape
    r = token_shift_lerp(p_r, f(mu_rkv[0]))
    k = token_shift_lerp(p_k, f(mu_rkv[1]))
    v = token_shift_lerp(p_v, f(mu_rkv[2]))
    wd = token_shift_lerp(p_wd, f(mu_w))
    ad = token_shift_lerp(p_ad, f(mu_a))
    w = -jax.nn.softplus(-(f(w0) + jnp.tanh(wd) @ f(w2))) - 0.5
    decay = jnp.exp(-jnp.exp(w))
    a = jax.nn.sigmoid(f(a0) + ad @ f(a2))
    heads = lambda t: t.reshape(bsz, s, B_HEADS, B_HEAD_DIM)
    kk = heads(k * f(k_k))
    kk = kk * lax.rsqrt(jnp.maximum(jnp.sum(kk * kk, axis=-1, keepdims=True), 1e-24))
    k = k * (1.0 + (a - 1.0) * f(k_a))
    rh, kh, vh, ah, dh = heads(r), heads(k), heads(v), heads(a), heads(decay)
    o = rwkv7_scan(rh, dh, kh, vh, -kk, kk * ah)
    mean = jnp.mean(o, axis=-1, keepdims=True)
    var = jnp.mean(jnp.square(o - mean), axis=-1, keepdims=True)
    o = ((o - mean) * lax.rsqrt(var + GN_EPS)).reshape(bsz, s, B_WIDTH) * f(ln_w) + f(ln_b)
    bonus = jnp.sum(rh * kh * f(r_k), axis=-1, keepdims=True) * vh
    return o + bonus.reshape(bsz, s, B_WIDTH)


def memory_cross_attention(q, mk, mv):
    bsz, s, h, dh = q.shape
    sc = jnp.einsum('bshd,bmhd->bhsm', q, mk, preferred_element_type=jnp.float32) * (dh ** -0.5)
    p = jax.nn.softmax(sc, axis=-1)
    out = jnp.einsum('bhsm,bmhd->bshd', p.astype(mv.dtype), mv)
    return out.reshape(bsz, s, h * dh)


def hybrid_layer(x, mem, norm_g, w_in, a_q_g, a_k_g, a_rel_bias, w_up_a,
                 b_mu_rkv, b_mu_w, b_mu_a, b_w0, b_w2, b_a0, b_a2, b_k_k, b_k_a, b_r_k,
                 b_ln_w, b_ln_b, w_up_b, mem_norm_g, w_mem_kv, c_q_g, c_k_g, w_up_c, w_o):
    bsz, s, _ = x.shape
    h = rms_norm(x, norm_g)
    proj = h @ w_in
    offsets = np.cumsum(np.array(IN_SPLITS))[:-1].tolist()
    (aq, ak, av, az, br, bk, bv, bz, bwd, bad, cq, cz, ga, gb, gc) = jnp.split(proj, offsets, axis=-1)

    aq = rms_norm(aq.reshape(bsz, s, A_HEADS, A_HEAD_DIM), a_q_g)
    ak = rms_norm(ak.reshape(bsz, s, A_HEADS, A_HEAD_DIM), a_k_g)
    av = av.reshape(bsz, s, A_HEADS, A_HEAD_DIM)
    ya = chunked_band_attention(aq, ak, av, a_rel_bias) * jax.nn.silu(az)

    yb = rwkv7_time_mix(br, bk, bv, bwd, bad, b_mu_rkv, b_mu_w, b_mu_a, b_w0, b_w2, b_a0, b_a2,
                        b_k_k, b_k_a, b_r_k, b_ln_w, b_ln_b).astype(x.dtype) * jax.nn.silu(bz)

    m = rms_norm(mem, mem_norm_g)
    mk, mv = jnp.split(m @ w_mem_kv, 2, axis=-1)
    mk = rms_norm(mk.reshape(bsz, N_MEM, C_HEADS, C_HEAD_DIM), c_k_g)
    mv = mv.reshape(bsz, N_MEM, C_HEADS, C_HEAD_DIM)
    cq = rms_norm(cq.reshape(bsz, s, C_HEADS, C_HEAD_DIM), c_q_g)
    yc = memory_cross_attention(cq, mk, mv) * jax.nn.silu(cz)

    merged = (jax.nn.sigmoid(ga) * (ya @ w_up_a)
              + jax.nn.sigmoid(gb) * (yb @ w_up_b)
              + jax.nn.sigmoid(gc) * (yc @ w_up_c))
    return x + merged @ w_o


def setup_inputs(seed: int = 0) -> dict:
    key = jax.random.key(seed)
    ks = jax.random.split(key, 32)
    nrm = lambda k, shape, sc: jax.random.normal(k, shape, jnp.float32) * sc
    L = DEPTH
    return {
        "x": nrm(ks[0], (BATCH, SEQ, D_MODEL), 1.0),
        "mem": nrm(ks[1], (BATCH, N_MEM, D_MODEL), 1.0),
        "norm_g": 1.0 + nrm(ks[2], (L, D_MODEL), 0.1),
        "w_in": nrm(ks[3], (L, D_MODEL, IN_COLS), D_MODEL ** -0.5),
        "a_q_g": 1.0 + nrm(ks[4], (L, A_HEAD_DIM), 0.1),
        "a_k_g": 1.0 + nrm(ks[5], (L, A_HEAD_DIM), 0.1),
        "a_rel_bias": nrm(ks[6], (L, A_HEADS, 2 * REL_CLIP + 1), 0.5),
        "w_up_a": nrm(ks[7], (L, A_WIDTH, D_MODEL), A_WIDTH ** -0.5),
        "b_mu_rkv": jax.random.uniform(ks[8], (L, 3, B_WIDTH), jnp.float32),
        "b_mu_w": jax.random.uniform(ks[9], (L, DECAY_LORA), jnp.float32),
        "b_mu_a": jax.random.uniform(ks[10], (L, ICLR_LORA), jnp.float32),
        "b_w0": jax.random.uniform(ks[11], (L, B_WIDTH), jnp.float32, minval=-3.0, maxval=0.5),
        "b_w2": nrm(ks[12], (L, DECAY_LORA, B_WIDTH), 0.1),
        "b_a0": nrm(ks[13], (L, B_WIDTH), 0.5),
        "b_a2": nrm(ks[14], (L, ICLR_LORA, B_WIDTH), 0.1),
        "b_k_k": 0.85 + nrm(ks[15], (L, B_WIDTH), 0.05),
        "b_k_a": 1.0 + nrm(ks[16], (L, B_WIDTH), 0.05),
        "b_r_k": nrm(ks[17], (L, B_HEADS, B_HEAD_DIM), 0.1),
        "b_ln_w": 1.0 + nrm(ks[18], (L, B_WIDTH), 0.1),
        "b_ln_b": nrm(ks[19], (L, B_WIDTH), 0.02),
        "w_up_b": nrm(ks[20], (L, B_WIDTH, D_MODEL), B_WIDTH ** -0.5),
        "mem_norm_g": 1.0 + nrm(ks[21], (L, D_MODEL), 0.1),
        "w_mem_kv": nrm(ks[22], (L, D_MODEL, 2 * C_WIDTH), D_MODEL ** -0.5),
        "c_q_g": 1.0 + nrm(ks[23], (L, C_HEAD_DIM), 0.1),
        "c_k_g": 1.0 + nrm(ks[24], (L, C_HEAD_DIM), 0.1),
        "w_up_c": nrm(ks[25], (L, C_WIDTH, D_MODEL), C_WIDTH ** -0.5),
        "w_o": nrm(ks[26], (L, D_MODEL, D_MODEL), D_MODEL ** -0.5),
    }


def reference(x, mem, norm_g, w_in, a_q_g, a_k_g, a_rel_bias, w_up_a,
              b_mu_rkv, b_mu_w, b_mu_a, b_w0, b_w2, b_a0, b_a2, b_k_k, b_k_a, b_r_k,
              b_ln_w, b_ln_b, w_up_b, mem_norm_g, w_mem_kv, c_q_g, c_k_g, w_up_c, w_o):
    for l in range(DEPTH):
        x = hybrid_layer(x, mem, norm_g[l], w_in[l], a_q_g[l], a_k_g[l], a_rel_bias[l], w_up_a[l],
                         b_mu_rkv[l], b_mu_w[l], b_mu_a[l], b_w0[l], b_w2[l], b_a0[l], b_a2[l],
                         b_k_k[l], b_k_a[l], b_r_k[l], b_ln_w[l], b_ln_b[l], w_up_b[l],
                         mem_norm_g[l], w_mem_kv[l], c_q_g[l], c_k_g[l], w_up_c[l], w_o[l])
    return x
```

```cpp
#include <hip/hip_runtime.h>
#include <hip/hip_cooperative_groups.h>
#include <cstdio>
namespace cg = cooperative_groups;

#define DI __device__ __forceinline__
#define LAS __attribute__((address_space(3)))
typedef unsigned short bf16_t;
typedef short bf16x8 __attribute__((ext_vector_type(8)));
typedef float f32x2 __attribute__((ext_vector_type(2)));
typedef float f32x4 __attribute__((ext_vector_type(4)));
typedef float f32x16 __attribute__((ext_vector_type(16)));
typedef unsigned u32x2 __attribute__((ext_vector_type(2)));
typedef unsigned u32x4 __attribute__((ext_vector_type(4)));
typedef __bf16 bf16v2 __attribute__((ext_vector_type(2)));

constexpr int T_TOK = 16384, DM = 2048, SEQ = 2048, NB = 8, NMEM = 256;
constexpr int INC = 16512;
constexpr int NTHREADS = 512;
constexpr int LDS_BYTES = 139264;

constexpr size_t SZ_WT = (size_t)INC * DM * 2;
constexpr size_t OFF_WT = 0;
constexpr size_t OFF_WMEM = OFF_WT + SZ_WT;
constexpr size_t OFF_WUA = OFF_WMEM + (size_t)2048 * 2048 * 2;
constexpr size_t OFF_WUB = OFF_WUA + (size_t)2048 * 1024 * 2;
constexpr size_t OFF_WUC = OFF_WUB + (size_t)2048 * 1024 * 2;
constexpr size_t OFF_WO = OFF_WUC + (size_t)2048 * 1024 * 2;
constexpr size_t OFF_H = OFF_WO + (size_t)2048 * 2048 * 2;
constexpr size_t OFF_M = OFF_H + (size_t)T_TOK * 2048 * 2;
constexpr size_t OFF_PA = OFF_M + (size_t)2048 * 2048 * 2;
constexpr size_t OFF_PB = OFF_PA + (size_t)T_TOK * 3072 * 2;
constexpr size_t OFF_PL = OFF_PB + (size_t)T_TOK * 4096 * 2;
constexpr size_t OFF_PC = OFF_PL + (size_t)T_TOK * 256 * 2;
constexpr size_t OFF_VT = OFF_PC + (size_t)T_TOK * 2048 * 2;
constexpr size_t OFF_MK = OFF_VT + (size_t)1024 * T_TOK * 2;
constexpr size_t OFF_MVT = OFF_MK + (size_t)2048 * 1024 * 2;
constexpr size_t OFF_CTR = OFF_MVT + (size_t)1024 * 2048 * 2;
constexpr size_t WS_END = OFF_CTR + 256;
constexpr size_t OFF_MERGED = OFF_PA;
constexpr size_t OFF_SCR = OFF_PB;
constexpr size_t SCR_PER_WG = 2 * 131072;
constexpr size_t OFF_YA = 0, OFF_YB = (size_t)T_TOK * 1024 * 2, OFF_YC = 2 * OFF_YB;

struct Params {
    const float* in[27];
    float* out;
    unsigned char* ws;
    int G; int pad;
};
enum { I_X = 0, I_MEM, I_NORMG, I_WIN, I_AQG, I_AKG, I_RELB, I_WUPA, I_MURKV, I_MUW, I_MUA, I_W0, I_W2, I_A0, I_A2, I_KK, I_KA, I_RK, I_LNW, I_LNB, I_WUPB,
       I_MEMG, I_WMEMKV, I_CQG, I_CKG, I_WUPC, I_WO };

DI unsigned pack2(float lo, float hi) { f32x2 v = {lo, hi}; bf16v2 b = __builtin_convertvector(v, bf16v2); return __builtin_bit_cast(unsigned, b); }
DI float bflo(unsigned u) { return __uint_as_float(u << 16); }
DI float bfhi(unsigned u) { return __uint_as_float(u & 0xffff0000u); }
DI float sigmoidf_(float x) { return __builtin_amdgcn_rcpf(1.0f + __expf(-x)); }
DI float siluf_(float x) { return x * sigmoidf_(x); }
DI float wave_sum(float v) {
#pragma unroll
    for (int o = 32; o > 0; o >>= 1) v += __shfl_xor(v, o);
    return v;
}
template <int CTRL> DI float dpp_mov(float x) { return __int_as_float(__builtin_amdgcn_update_dpp(0, __float_as_int(x), CTRL, 0xf, 0xf, false)); }
DI float reduce8(float x) {
    x += dpp_mov<0xB1>(x);
    x += dpp_mov<0x4E>(x);
    x += dpp_mov<0x141>(x);
    return x;
}
DI int crow(int i, int h) { return (i & 3) + 8 * (i >> 2) + 4 * h; }
#define MFMA32(a, b, c) __builtin_amdgcn_mfma_f32_32x32x16_bf16((a), (b), (c), 0, 0, 0)

DI void transpose_tile(const float* __restrict__ src, bf16_t* __restrict__ dst, int R, int C, int tr, int tc, float* lds) {
    const int tid = threadIdx.x;
    const int r = tid >> 3, cs = (tid & 7) * 8;
    const float* sp = src + (size_t)(tr * 64 + r) * C + tc * 64 + cs;
    f32x4 v0 = *(const f32x4*)sp, v1 = *(const f32x4*)(sp + 4);
    float* lp = lds + r * 65 + cs;
    lp[0] = v0[0]; lp[1] = v0[1]; lp[2] = v0[2]; lp[3] = v0[3]; lp[4] = v1[0]; lp[5] = v1[1]; lp[6] = v1[2]; lp[7] = v1[3];
    __syncthreads();
    const int c = tid >> 3, ks = (tid & 7) * 8;
    u32x4 o;
    o[0] = pack2(lds[(ks + 0) * 65 + c], lds[(ks + 1) * 65 + c]);
    o[1] = pack2(lds[(ks + 2) * 65 + c], lds[(ks + 3) * 65 + c]);
    o[2] = pack2(lds[(ks + 4) * 65 + c], lds[(ks + 5) * 65 + c]);
    o[3] = pack2(lds[(ks + 6) * 65 + c], lds[(ks + 7) * 65 + c]);
    *(u32x4*)(dst + (size_t)(tc * 64 + c) * R + tr * 64 + ks) = o;
    __syncthreads();
}
DI void rmsnorm_row2048(const float* __restrict__ x, const float* __restrict__ g, bf16_t* __restrict__ out, int lane) {
    f32x4 v[8]; float ss = 0.f;
#pragma unroll
    for (int i = 0; i < 8; ++i) { v[i] = ((const f32x4*)x)[i * 64 + lane]; ss += v[i][0] * v[i][0] + v[i][1] * v[i][1] + v[i][2] * v[i][2] + v[i][3] * v[i][3]; }
    ss = wave_sum(ss);
    const float rstd = rsqrtf(ss * (1.0f / 2048.0f) + 1e-6f);
#pragma unroll
    for (int i = 0; i < 8; ++i) {
        const f32x4 g4 = ((const f32x4*)g)[i * 64 + lane];
        u32x2 o; o[0] = pack2(v[i][0] * rstd * g4[0], v[i][1] * rstd * g4[1]); o[1] = pack2(v[i][2] * rstd * g4[2], v[i][3] * rstd * g4[3]);
        ((u32x2*)out)[i * 64 + lane] = o;
    }
}
DI void phase0(const Params& p, unsigned char* smem) {
    float* lds = (float*)smem;
    const int G = p.G, c = blockIdx.x;
    if (c == 0 && threadIdx.x == 0) *(unsigned*)(p.ws + OFF_CTR) = 0u;
    constexpr int N_WIN = 32 * 258, N_SQ = 32 * 32, N_UP = 16 * 32;
    constexpr int NTR = N_WIN + N_SQ + 3 * N_UP + N_SQ;
    for (int u = c; u < NTR; u += G) {
        int l = u;
        if (l < N_WIN) { transpose_tile(p.in[I_WIN], (bf16_t*)(p.ws + OFF_WT), 2048, INC, l & 31, l >> 5, lds); continue; }
        l -= N_WIN;
        if (l < N_SQ) { transpose_tile(p.in[I_WMEMKV], (bf16_t*)(p.ws + OFF_WMEM), 2048, 2048, l & 31, l >> 5, lds); continue; }
        l -= N_SQ;
        if (l < 3 * N_UP) {
            const int w = l / N_UP; l -= w * N_UP;
            const float* src = w == 0 ? p.in[I_WUPA] : (w == 1 ? p.in[I_WUPB] : p.in[I_WUPC]);
            bf16_t* dst = (bf16_t*)(p.ws + (w == 0 ? OFF_WUA : (w == 1 ? OFF_WUB : OFF_WUC)));
            transpose_tile(src, dst, 1024, 2048, l & 15, l >> 4, lds); continue;
        }
        l -= 3 * N_UP;
        transpose_tile(p.in[I_WO], (bf16_t*)(p.ws + OFF_WO), 2048, 2048, l & 31, l >> 5, lds);
    }
    const int wid = threadIdx.x >> 6, lane = threadIdx.x & 63;
    for (int rg = c; rg < (T_TOK + 2048) / 8; rg += G) {
        const int row = rg * 8 + wid;
        if (row < T_TOK) rmsnorm_row2048(p.in[I_X] + (size_t)row * 2048, p.in[I_NORMG], (bf16_t*)(p.ws + OFF_H) + (size_t)row * 2048, lane);
        else rmsnorm_row2048(p.in[I_MEM] + (size_t)(row - T_TOK) * 2048, p.in[I_MEMG], (bf16_t*)(p.ws + OFF_M) + (size_t)(row - T_TOK) * 2048, lane);
    }
}

constexpr int BM = 256, BK = 64, HALF = 128, HTB = HALF * BK * 2;
DI int lds_byte(int r, int c) { const int st = (r >> 4) * 2 + (c >> 5), rr = r & 15, cc = c & 31, ob = rr * 64 + cc * 2; return st * 1024 + (ob ^ (((ob >> 9) & 1) << 5)); }
DI void stage_rc(int b, int& R, int& C) { const int st = b / 1024, sb = b % 1024, swz = sb ^ (((sb >> 9) & 1) << 5); R = (st >> 1) * 16 + swz / 64; C = (st & 1) * 32 + (swz % 64) / 2; }

enum { EPI_BF16 = 0, EPI_UP = 1, EPI_GATE = 2, EPI_OUT = 4 };
struct Unit { const char* A; const char* B; char* C; int K; int ldc; int kind; int aux; const float* X; };

DI void epilogue(const f32x4 (&acc)[2][2][4][2], const Unit& u, int wr, int wc, int fr, int fq, int tid, char* scr) {
    if (u.kind == EPI_BF16) {
#pragma unroll
        for (int ai = 0; ai < 2; ++ai)
#pragma unroll
            for (int m = 0; m < 4; ++m) {
                bf16_t* rowp = (bf16_t*)u.C + (size_t)(ai * 128 + wr * 64 + m * 16 + fr) * u.ldc + wc * 32 + 4 * fq;
#pragma unroll
                for (int bj = 0; bj < 2; ++bj)
#pragma unroll
                    for (int n = 0; n < 2; ++n) {
                        const f32x4 a = acc[ai][bj][m][n]; u32x2 o; o[0] = pack2(a[0], a[1]); o[1] = pack2(a[2], a[3]);
                        *(u32x2*)(rowp + bj * 128 + n * 16) = o;
                    }
            }
    } else if (u.kind == EPI_OUT) {
#pragma unroll
        for (int ai = 0; ai < 2; ++ai)
#pragma unroll
            for (int m = 0; m < 4; ++m) {
                const size_t ro = (size_t)(ai * 128 + wr * 64 + m * 16 + fr) * 2048 + wc * 32 + 4 * fq;
#pragma unroll
                for (int bj = 0; bj < 2; ++bj)
#pragma unroll
                    for (int n = 0; n < 2; ++n) {
                        const f32x4 xv = *(const f32x4*)(u.X + ro + bj * 128 + n * 16);
                        *(f32x4*)((float*)u.C + ro + bj * 128 + n * 16) = acc[ai][bj][m][n] + xv;
                    }
            }
    } else if (u.kind == EPI_UP) {
        u32x2* sp = (u32x2*)scr + tid;
#pragma unroll
        for (int ai = 0; ai < 2; ++ai)
#pragma unroll
            for (int m = 0; m < 4; ++m) {
                asm volatile("" : "+v"(sp) : : "memory");
#pragma unroll
                for (int bj = 0; bj < 2; ++bj)
#pragma unroll
                    for (int n = 0; n < 2; ++n) {
                        const f32x4 a = acc[ai][bj][m][n];
                        u32x2 o; o[0] = pack2(a[0], a[1]); o[1] = pack2(a[2], a[3]);
                        sp[(bj * 2 + n) * 512] = o;
                    }
                sp += 4 * 512;
            }
    } else {
        u32x2* sp = (u32x2*)scr + tid;
        const int mode = u.aux;
#pragma unroll
        for (int ai = 0; ai < 2; ++ai)
#pragma unroll
            for (int m = 0; m < 4; ++m) {
                asm volatile("" : "+v"(sp) : : "memory");
                __builtin_amdgcn_sched_barrier(0);
                bf16_t* rowp = (bf16_t*)u.C + (size_t)(ai * 128 + wr * 64 + m * 16 + fr) * u.ldc + wc * 32 + 4 * fq;
#pragma unroll
                for (int bj = 0; bj < 2; ++bj)
#pragma unroll
                    for (int n = 0; n < 2; ++n) {
                        const int idx = (bj * 2 + n) * 512;
                        const u32x2 uu = sp[idx];
                        u32x2 mm = {0u, 0u};
                        if (mode != 0) mm = sp[idx + 16384];
                        const f32x4 a = acc[ai][bj][m][n];
                        const float r0 = bflo(mm[0]) + sigmoidf_(a[0]) * bflo(uu[0]);
                        const float r1 = bfhi(mm[0]) + sigmoidf_(a[1]) * bfhi(uu[0]);
                        const float r2 = bflo(mm[1]) + sigmoidf_(a[2]) * bflo(uu[1]);
                        const float r3 = bfhi(mm[1]) + sigmoidf_(a[3]) * bfhi(uu[1]);
                        u32x2 o; o[0] = pack2(r0, r1); o[1] = pack2(r2, r3);
                        if (mode == 2) *(u32x2*)(rowp + bj * 128 + n * 16) = o; else sp[idx + 16384] = o;
                    }
                sp += 4 * 512;
            }
    }
}

DI bool p1_unit(const Params& p, int L, Unit& u) {
    if (L >= 2688) return false;
    u.K = 2048; u.kind = EPI_BF16; u.aux = 0; u.X = nullptr;
    const char* ws = (const char*)p.ws;
    if (L < 2368) {
        const int gid = L / 296, rem = L - gid * 296, pm = gid * 8 + (rem & 7), ct = rem >> 3;
        int brow, col, ldc; size_t cb;
        if (ct < 8) { brow = ct * 256; cb = OFF_PA; col = ct * 256; ldc = 3072; }
        else if (ct < 12) { brow = 3072 + (ct - 8) * 256; cb = OFF_PA; col = 2048 + (ct - 8) * 256; ldc = 3072; }
        else if (ct < 28) { brow = 4096 + (ct - 12) * 256; cb = OFF_PB; col = (ct - 12) * 256; ldc = 4096; }
        else if (ct == 28) { brow = 8192; cb = OFF_PL; col = 0; ldc = 256; }
        else { brow = 8320 + (ct - 29) * 256; cb = OFF_PC; col = (ct - 29) * 256; ldc = 2048; }
        u.A = ws + OFF_H + (size_t)pm * 256 * 4096; u.B = ws + OFF_WT + (size_t)brow * 4096;
        u.C = (char*)p.ws + cb + ((size_t)pm * 256 * ldc + col) * 2; u.ldc = ldc;
    } else if (L < 2624) {
        const int l = L - 2368, pm = l & 3, pn = l >> 2;
        u.A = ws + OFF_WT + (size_t)(2048 + pm * 256) * 4096; u.B = ws + OFF_H + (size_t)pn * 256 * 4096;
        u.C = (char*)p.ws + OFF_VT + ((size_t)pm * 256 * T_TOK + pn * 256) * 2; u.ldc = T_TOK;
    } else if (L < 2656) {
        const int l = L - 2624, pm = l & 7, pn = l >> 3;
        u.A = ws + OFF_M + (size_t)pm * 256 * 4096; u.B = ws + OFF_WMEM + (size_t)pn * 256 * 4096;
        u.C = (char*)p.ws + OFF_MK + ((size_t)pm * 256 * 1024 + pn * 256) * 2; u.ldc = 1024;
    } else {
        const int l = L - 2656, pm = l & 3, pn = l >> 2;
        u.A = ws + OFF_WMEM + (size_t)(1024 + pm * 256) * 4096; u.B = ws + OFF_M + (size_t)pn * 256 * 4096;
        u.C = (char*)p.ws + OFF_MVT + ((size_t)pm * 256 * 2048 + pn * 256) * 2; u.ldc = 2048;
    }
    return true;
}
DI void tile_pmpn(int tl, int& pm, int& pn) { pm = (tl & 7) + 8 * (tl >> 6); pn = (tl >> 3) & 7; }
DI bool p3_unit(const Params& p, int cp, int ui, Unit& u) {
    const int ti = ui / 6, sub = ui - ti * 6, tl = cp + p.G * ti;
    if (tl >= 512) return false;
    int pm, pn; tile_pmpn(tl, pm, pn);
    const char* ws = (const char*)p.ws; const char* yo = (const char*)p.out;
    u.X = nullptr; u.ldc = 2048;
    u.C = (char*)p.ws + OFF_MERGED + ((size_t)pm * 256 * 2048 + pn * 256) * 2;
    const int x = sub >> 1;
    if ((sub & 1) == 0) {
        u.K = 1024; u.kind = EPI_UP; u.aux = 0;
        u.A = yo + (size_t)x * OFF_YB + (size_t)pm * 256 * 2048;
        u.B = ws + (x == 0 ? OFF_WUA : (x == 1 ? OFF_WUB : OFF_WUC)) + (size_t)pn * 256 * 2048;
    } else {
        u.K = 2048; u.kind = EPI_GATE; u.aux = x;
        u.A = ws + OFF_H + (size_t)pm * 256 * 4096;
        u.B = ws + OFF_WT + (size_t)(10368 + 2048 * x + 256 * pn) * 4096;
    }
    return true;
}
DI bool p4_unit(const Params& p, int cp, int ui, Unit& u) {
    const int tl = cp + p.G * ui;
    if (tl >= 512) return false;
    int pm, pn; tile_pmpn(tl, pm, pn);
    const char* ws = (const char*)p.ws;
    u.K = 2048; u.kind = EPI_OUT; u.aux = 0; u.ldc = 2048;
    u.A = ws + OFF_MERGED + (size_t)pm * 256 * 4096; u.B = ws + OFF_WO + (size_t)pn * 256 * 4096;
    u.C = (char*)(p.out + (size_t)pm * 256 * 2048 + pn * 256);
    u.X = p.in[I_X] + (size_t)pm * 256 * 2048 + pn * 256;
    return true;
}
template <int PH> DI bool get_unit(const Params& p, int cp, int ui, Unit& u) {
    if (PH == 1) return p1_unit(p, ui * p.G + cp, u);
    if (PH == 3) return p3_unit(p, cp, ui, u);
    return p4_unit(p, cp, ui, u);
}

template <int PH>
DI void gemm_phase(LAS unsigned char* lds, const Params& p) {
    int tid = threadIdx.x; asm volatile("" : "+v"(tid));
    const int wid = __builtin_amdgcn_readfirstlane(tid >> 6), lane = tid & 63, wr = wid >> 2, wc = wid & 3, fr = lane & 15, fq = lane >> 4;
    const int c = blockIdx.x, cp = (p.G & 7) == 0 ? (c & 7) * (p.G >> 3) + (c >> 3) : c;
    char* scr = (char*)p.ws + OFF_SCR + (size_t)c * SCR_PER_WG;
    int sR[2], sC[2];
#pragma unroll
    for (int i = 0; i < 2; ++i) stage_rc(tid * 16 + i * 8192, sR[i], sC[i]);
    const unsigned ldsw = (unsigned)wid * 1024u;
    const int aoff = lds_byte(wr * 64 + fr, fq * 8), boff = lds_byte(wc * 32 + fr, fq * 8);
#define G_SA(b, h) (((b) * 2 + (h)) * HTB)
#define G_SB(b, h) ((4 + (b) * 2 + (h)) * HTB)
#define G_STAGE(bufoff, gbase, KK) do { _Pragma("unroll") for (int _i = 0; _i < 2; ++_i) \
        __builtin_amdgcn_global_load_lds((const unsigned*)((gbase) + (size_t)(unsigned)((sR[_i] * (KK) + sC[_i]) * 2)), (LAS unsigned*)(lds + (bufoff) + ldsw + _i * 8192), 16, 0, 0); } while (0)
#define G_LDA(dst, b, h) do { _Pragma("unroll") for (int m = 0; m < 4; ++m) _Pragma("unroll") for (int k = 0; k < 2; ++k) dst[m][k] = *(const LAS bf16x8*)(lds + G_SA(b, h) + aoff + m * 2048 + k * 1024); } while (0)
#define G_LDB(dst, b, h) do { _Pragma("unroll") for (int n = 0; n < 2; ++n) _Pragma("unroll") for (int k = 0; k < 2; ++k) dst[n][k] = *(const LAS bf16x8*)(lds + G_SB(b, h) + boff + n * 2048 + k * 1024); } while (0)
#define G_MMA(ai, bj, At, Bt) do { __builtin_amdgcn_s_setprio(1); _Pragma("unroll") for (int m = 0; m < 4; ++m) _Pragma("unroll") for (int n = 0; n < 2; ++n) _Pragma("unroll") for (int k = 0; k < 2; ++k) \
        acc[ai][bj][m][n] = __builtin_amdgcn_mfma_f32_16x16x32_bf16(Bt[n][k], At[m][k], acc[ai][bj][m][n], 0, 0, 0); __builtin_amdgcn_s_setprio(0); } while (0)
#define G_WAIT_V(n) asm volatile("s_waitcnt vmcnt(" #n ")" ::: "memory")
#define G_WAIT_L(n) asm volatile("s_waitcnt lgkmcnt(" #n ")" ::: "memory")
#define G_BAR __builtin_amdgcn_s_barrier()
#define G_SCHED __builtin_amdgcn_sched_barrier(0)
    Unit cur, nxt; int ui = 0;
    if (!get_unit<PH>(p, cp, 0, cur)) return;
    f32x4 acc[2][2][4][2];
#pragma unroll
    for (int a = 0; a < 2; ++a)
#pragma unroll
        for (int b = 0; b < 2; ++b)
#pragma unroll
            for (int m = 0; m < 4; ++m)
#pragma unroll
                for (int n = 0; n < 2; ++n) acc[a][b][m][n] = (f32x4){0.f, 0.f, 0.f, 0.f};
    bf16x8 At[4][2], B0[2][2], B1[2][2];
    const char* cA = cur.A; const char* cB = cur.B; int Kc = cur.K;
    {
        const size_t hs = (size_t)HALF * Kc * 2;
        G_STAGE(G_SB(0, 0), cB, Kc); G_STAGE(G_SA(0, 0), cA, Kc); G_STAGE(G_SB(0, 1), cB + hs, Kc); G_STAGE(G_SA(0, 1), cA + hs, Kc);
        if (wr == 1) G_BAR;
        G_WAIT_V(4); G_BAR;
        G_STAGE(G_SB(1, 0), cB + 128, Kc); G_STAGE(G_SA(1, 0), cA + 128, Kc); G_STAGE(G_SB(1, 1), cB + hs + 128, Kc);
        G_WAIT_V(6); G_BAR;
    }
    for (;;) {
        const bool has_next = get_unit<PH>(p, cp, ui + 1, nxt);
        const char* nA = has_next ? nxt.A : cA; const char* nB = has_next ? nxt.B : cB; const int Kn = has_next ? nxt.K : Kc;
        const int nt = Kc / BK;
        const size_t hsc = (size_t)HALF * Kc * 2;
        for (int t = 0; t < nt; t += 2) {
            const bool last = (t == nt - 2);
            const char* a1 = cA + (size_t)(t + 1) * 128;
            const int K2 = last ? Kn : Kc;
            const size_t hs2 = (size_t)HALF * K2 * 2;
            const char* a2 = last ? nA : cA + (size_t)(t + 2) * 128; const char* b2 = last ? nB : cB + (size_t)(t + 2) * 128;
            const char* a3 = a2 + 128; const char* b3 = b2 + 128;
            G_LDB(B0, 0, 0); G_SCHED; G_LDA(At, 0, 0); G_STAGE(G_SA(1, 1), a1 + hsc, Kc);
            G_WAIT_L(8); G_BAR; G_WAIT_L(0); G_MMA(0, 0, At, B0); G_BAR; G_SCHED;
            G_LDB(B1, 0, 1); G_STAGE(G_SB(0, 0), b2, K2);
            G_BAR; G_WAIT_L(0); G_MMA(0, 1, At, B1); G_BAR;
            G_LDA(At, 0, 1); G_STAGE(G_SA(0, 0), a2, K2);
            G_BAR; G_WAIT_L(0); G_MMA(1, 0, At, B0); G_BAR; G_SCHED;
            G_STAGE(G_SB(0, 1), b2 + hs2, K2);
            G_WAIT_V(6); G_BAR; G_MMA(1, 1, At, B1); G_BAR;
            G_LDB(B0, 1, 0); G_SCHED; G_LDA(At, 1, 0); G_STAGE(G_SA(0, 1), a2 + hs2, K2);
            G_WAIT_L(8); G_BAR; G_WAIT_L(0); G_MMA(0, 0, At, B0); G_BAR; G_SCHED;
            G_LDB(B1, 1, 1); G_STAGE(G_SB(1, 0), b3, K2);
            G_BAR; G_WAIT_L(0); G_MMA(0, 1, At, B1); G_BAR;
            G_LDA(At, 1, 1); G_STAGE(G_SA(1, 0), a3, K2);
            G_BAR; G_WAIT_L(0); G_MMA(1, 0, At, B0); G_BAR; G_SCHED;
            G_STAGE(G_SB(1, 1), b3 + hs2, K2);
            G_WAIT_V(6); G_BAR; G_MMA(1, 1, At, B1); G_BAR;
        }
        epilogue(acc, cur, wr, wc, fr, fq, tid, scr);
        if (!has_next) break;
#pragma unroll
        for (int a = 0; a < 2; ++a)
#pragma unroll
            for (int b = 0; b < 2; ++b)
#pragma unroll
                for (int m = 0; m < 4; ++m)
#pragma unroll
                    for (int n = 0; n < 2; ++n) acc[a][b][m][n] = (f32x4){0.f, 0.f, 0.f, 0.f};
        cur = nxt; cA = nA; cB = nB; Kc = Kn; ++ui;
    }
    G_WAIT_V(0);
    if (wr == 0) G_BAR;
    G_BAR;
}

constexpr int SC_W = 0, SC_KK = 16384, SC_BV = 32768, SC_KP = 49152, SC_R = 65536, SC_V = 81920, SC_O = 98304, SC_AWD = 114688, SC_AAD = 123904;
constexpr int SC_ASTR = 144;
DI void ld8(const bf16_t* ptr, float (&f)[8]) {
    const u32x4 v = *(const u32x4*)ptr;
#pragma unroll
    for (int i = 0; i < 4; ++i) { f[2 * i] = bflo(v[i]); f[2 * i + 1] = bfhi(v[i]); }
}
DI void scan_item(const Params& p, unsigned char* smem, int item) {
    const int b = item >> 4, h = item & 15;
    int tid = threadIdx.x; asm volatile("" : "+v"(tid));
    const int wid = tid >> 6, lane = tid & 63;
    const bf16_t* PB = (const bf16_t*)(p.ws + OFF_PB);
    const bf16_t* PL = (const bf16_t*)(p.ws + OFF_PL);
    bf16_t* YB = (bf16_t*)((char*)p.out + OFF_YB);
    LAS unsigned char* lds = (LAS unsigned char*)smem;
    const int mat = wid >> 2, tm = (wid >> 1) & 1, tn = wid & 1, mr = lane & 31, mh = lane >> 5;
    bf16x8 Bf[4];
    {
        const float* Wx = (mat == 0 ? p.in[I_W2] : p.in[I_A2]) + h * 64 + tn * 32 + mr;
#pragma unroll
        for (int s = 0; s < 4; ++s) {
            u32x4 pk;
#pragma unroll
            for (int jj = 0; jj < 4; ++jj) pk[jj] = pack2(Wx[(size_t)(16 * s + 8 * mh + 2 * jj) * 1024], Wx[(size_t)(16 * s + 8 * mh + 2 * jj + 1) * 1024]);
            Bf[s] = __builtin_bit_cast(bf16x8, pk);
        }
    }
    const int cj = h * 64 + tn * 32 + mr;
    const float w0c = p.in[I_W0][cj], a0c = p.in[I_A0][cj], kac = p.in[I_KA][cj];
    const int et = tid >> 3, eg = tid & 7, ec = h * 64 + eg * 8;
    const int il = lane >> 3, jl = lane & 7, srow = wid * 8 + il;
    float S[8];
#pragma unroll
    for (int j = 0; j < 8; ++j) S[j] = 0.f;

    for (int ch = 0; ch < SEQ / 64; ++ch) {
        const int t0 = ch * 64;
        const size_t row = (size_t)b * SEQ + t0 + et;
        const bool hasprev = (t0 + et) > 0;
        {
            float cur[8], prv[8], mu[8];
            ld8(PL + row * 256 + eg * 8, cur);
            if (hasprev) ld8(PL + (row - 1) * 256 + eg * 8, prv); else {
#pragma unroll
                for (int i = 0; i < 8; ++i) prv[i] = 0.f; }
            { const f32x4 m0 = *(const f32x4*)(p.in[I_MUW] + eg * 8), m1 = *(const f32x4*)(p.in[I_MUW] + eg * 8 + 4);
              mu[0] = m0[0]; mu[1] = m0[1]; mu[2] = m0[2]; mu[3] = m0[3]; mu[4] = m1[0]; mu[5] = m1[1]; mu[6] = m1[2]; mu[7] = m1[3]; }
            u32x4 o;
#pragma unroll
            for (int i = 0; i < 4; ++i) { const float x0 = cur[2 * i] + mu[2 * i] * (prv[2 * i] - cur[2 * i]), x1 = cur[2 * i + 1] + mu[2 * i + 1] * (prv[2 * i + 1] - cur[2 * i + 1]); o[i] = pack2(tanhf(x0), tanhf(x1)); }
            *(LAS u32x4*)(lds + SC_AWD + et * SC_ASTR + eg * 16) = o;
            ld8(PL + row * 256 + 64 + eg * 8, cur);
            if (hasprev) ld8(PL + (row - 1) * 256 + 64 + eg * 8, prv);
            { const f32x4 m0 = *(const f32x4*)(p.in[I_MUA] + eg * 8), m1 = *(const f32x4*)(p.in[I_MUA] + eg * 8 + 4);
              mu[0] = m0[0]; mu[1] = m0[1]; mu[2] = m0[2]; mu[3] = m0[3]; mu[4] = m1[0]; mu[5] = m1[1]; mu[6] = m1[2]; mu[7] = m1[3]; }
#pragma unroll
            for (int i = 0; i < 4; ++i) { const float x0 = cur[2 * i] + mu[2 * i] * (prv[2 * i] - cur[2 * i]), x1 = cur[2 * i + 1] + mu[2 * i + 1] * (prv[2 * i + 1] - cur[2 * i + 1]); o[i] = pack2(x0, x1); }
            *(LAS u32x4*)(lds + SC_AAD + et * SC_ASTR + eg * 16) = o;
#pragma unroll
            for (int q = 0; q < 3; ++q) {
                ld8(PB + row * 4096 + q * 1024 + ec, cur);
                if (hasprev) ld8(PB + (row - 1) * 4096 + q * 1024 + ec, prv);
                const float* mup = p.in[I_MURKV] + q * 1024 + ec;
                const f32x4 m0 = *(const f32x4*)mup, m1 = *(const f32x4*)(mup + 4);
                mu[0] = m0[0]; mu[1] = m0[1]; mu[2] = m0[2]; mu[3] = m0[3]; mu[4] = m1[0]; mu[5] = m1[1]; mu[6] = m1[2]; mu[7] = m1[3];
                float x[8];
#pragma unroll
                for (int i = 0; i < 8; ++i) x[i] = cur[i] + mu[i] * (prv[i] - cur[i]);
                const int dsto = (q == 0 ? SC_R : (q == 1 ? SC_KP : SC_V)) + et * 256 + eg * 32;
                *(LAS f32x4*)(lds + dsto) = (f32x4){x[0], x[1], x[2], x[3]};
                *(LAS f32x4*)(lds + dsto + 16) = (f32x4){x[4], x[5], x[6], x[7]};
                if (q == 1) {
                    const f32x4 k0 = *(const f32x4*)(p.in[I_KK] + ec), k1 = *(const f32x4*)(p.in[I_KK] + ec + 4);
                    float kk[8]; float ss = 0.f;
#pragma unroll
                    for (int i = 0; i < 8; ++i) { kk[i] = x[i] * (i < 4 ? k0[i] : k1[i - 4]); ss += kk[i] * kk[i]; }
                    ss = reduce8(ss);
                    const float rn = rsqrtf(fmaxf(ss, 1e-24f));
                    *(LAS f32x4*)(lds + SC_KK + et * 256 + eg * 32) = (f32x4){kk[0] * rn, kk[1] * rn, kk[2] * rn, kk[3] * rn};
                    *(LAS f32x4*)(lds + SC_KK + et * 256 + eg * 32 + 16) = (f32x4){kk[4] * rn, kk[5] * rn, kk[6] * rn, kk[7] * rn};
                }
            }
        }
        __syncthreads();
        {
            f32x16 acc;
#pragma unroll
            for (int i = 0; i < 16; ++i) acc[i] = 0.f;
            const int abase = (mat == 0 ? SC_AWD : SC_AAD) + (tm * 32 + mr) * SC_ASTR + mh * 16;
#pragma unroll
            for (int s = 0; s < 4; ++s) { const bf16x8 a = *(const LAS bf16x8*)(lds + abase + s * 32); acc = MFMA32(a, Bf[s], acc); }
            const int jcol = tn * 32 + mr;
#pragma unroll
            for (int i = 0; i < 16; ++i) {
                const int t = tm * 32 + crow(i, mh);
                if (mat == 0) {
                    const float y = -(w0c + acc[i]);
                    const float sp = fmaxf(y, 0.f) + log1pf(__expf(-fabsf(y)));
                    const float w = -sp - 0.5f;
                    *(LAS float*)(lds + SC_W + t * 256 + jcol * 4) = __expf(-__expf(w));
                } else {
                    const float a = sigmoidf_(a0c + acc[i]);
                    const float kl = *(LAS float*)(lds + SC_KP + t * 256 + jcol * 4);
                    const float kk = *(LAS float*)(lds + SC_KK + t * 256 + jcol * 4);
                    *(LAS float*)(lds + SC_KP + t * 256 + jcol * 4) = kl * (1.0f + (a - 1.0f) * kac);
                    *(LAS float*)(lds + SC_BV + t * 256 + jcol * 4) = kk * a;
                }
            }
        }
        __syncthreads();
        {
            const LAS unsigned char* bw = lds + jl * 32;
#pragma unroll 2
            for (int t = 0; t < 64; ++t) {
                const f32x4 w0 = *(const LAS f32x4*)(bw + SC_W + t * 256), w1 = *(const LAS f32x4*)(bw + SC_W + t * 256 + 16);
                const f32x4 a0 = *(const LAS f32x4*)(bw + SC_KK + t * 256), a1 = *(const LAS f32x4*)(bw + SC_KK + t * 256 + 16);
                const f32x4 b0 = *(const LAS f32x4*)(bw + SC_BV + t * 256), b1 = *(const LAS f32x4*)(bw + SC_BV + t * 256 + 16);
                const f32x4 k0 = *(const LAS f32x4*)(bw + SC_KP + t * 256), k1 = *(const LAS f32x4*)(bw + SC_KP + t * 256 + 16);
                const f32x4 r0 = *(const LAS f32x4*)(bw + SC_R + t * 256), r1 = *(const LAS f32x4*)(bw + SC_R + t * 256 + 16);
                const float vi = *(const LAS float*)(lds + SC_V + t * 256 + srow * 4);
                float sa = S[0] * a0[0] + S[1] * a0[1] + S[2] * a0[2] + S[3] * a0[3] + S[4] * a1[0] + S[5] * a1[1] + S[6] * a1[2] + S[7] * a1[3];
                sa = -reduce8(sa);
#pragma unroll
                for (int j = 0; j < 4; ++j) {
                    S[j] = S[j] * w0[j] + (sa * b0[j] + vi * k0[j]);
                    S[j + 4] = S[j + 4] * w1[j] + (sa * b1[j] + vi * k1[j]);
                }
                float o = S[0] * r0[0] + S[1] * r0[1] + S[2] * r0[2] + S[3] * r0[3] + S[4] * r1[0] + S[5] * r1[1] + S[6] * r1[2] + S[7] * r1[3];
                o = reduce8(o);
                if (jl == 0) *(LAS float*)(lds + SC_O + t * 256 + srow * 4) = o;
            }
        }
        __syncthreads();
        {
            const f32x4 o0 = *(const LAS f32x4*)(lds + SC_O + et * 256 + eg * 32), o1 = *(const LAS f32x4*)(lds + SC_O + et * 256 + eg * 32 + 16);
            float o[8] = {o0[0], o0[1], o0[2], o0[3], o1[0], o1[1], o1[2], o1[3]};
            float sm = 0.f;
#pragma unroll
            for (int i = 0; i < 8; ++i) sm += o[i];
            const float mean = reduce8(sm) * (1.0f / 64.0f);
            float sv = 0.f;
#pragma unroll
            for (int i = 0; i < 8; ++i) { const float d = o[i] - mean; sv += d * d; }
            const float rstd = rsqrtf(reduce8(sv) * (1.0f / 64.0f) + 64e-5f);
            const f32x4 r0 = *(const LAS f32x4*)(lds + SC_R + et * 256 + eg * 32), r1 = *(const LAS f32x4*)(lds + SC_R + et * 256 + eg * 32 + 16);
            const f32x4 k0 = *(const LAS f32x4*)(lds + SC_KP + et * 256 + eg * 32), k1 = *(const LAS f32x4*)(lds + SC_KP + et * 256 + eg * 32 + 16);
            const f32x4 q0 = *(const f32x4*)(p.in[I_RK] + ec), q1 = *(const f32x4*)(p.in[I_RK] + ec + 4);
            float bs = r0[0] * k0[0] * q0[0] + r0[1] * k0[1] * q0[1] + r0[2] * k0[2] * q0[2] + r0[3] * k0[3] * q0[3]
                     + r1[0] * k1[0] * q1[0] + r1[1] * k1[1] * q1[1] + r1[2] * k1[2] * q1[2] + r1[3] * k1[3] * q1[3];
            bs = reduce8(bs);
            const f32x4 v0 = *(const LAS f32x4*)(lds + SC_V + et * 256 + eg * 32), v1 = *(const LAS f32x4*)(lds + SC_V + et * 256 + eg * 32 + 16);
            const f32x4 lw0 = *(const f32x4*)(p.in[I_LNW] + ec), lw1 = *(const f32x4*)(p.in[I_LNW] + ec + 4);
            const f32x4 lb0 = *(const f32x4*)(p.in[I_LNB] + ec), lb1 = *(const f32x4*)(p.in[I_LNB] + ec + 4);
            float z[8]; ld8(PB + row * 4096 + 3072 + ec, z);
            float y[8];
#pragma unroll
            for (int i = 0; i < 8; ++i) {
                const float lw = i < 4 ? lw0[i] : lw1[i - 4], lb = i < 4 ? lb0[i] : lb1[i - 4], vv = i < 4 ? v0[i] : v1[i - 4];
                y[i] = ((o[i] - mean) * rstd * lw + lb + bs * vv) * siluf_(z[i]);
            }
            u32x4 ov; ov[0] = pack2(y[0], y[1]); ov[1] = pack2(y[2], y[3]); ov[2] = pack2(y[4], y[5]); ov[3] = pack2(y[6], y[7]);
            *(u32x4*)(YB + row * 1024 + ec) = ov;
        }
        __syncthreads();
    }
}

template <int HD> struct AttnCfg { static constexpr int KSTR = HD * 2 + 16, VSTR = 136, VROWS = HD, K_OFF = 0, V_OFF = 64 * KSTR, BIAS_OFF = V_OFF + VROWS * VSTR; };

template <int HD>
DI void attn_load_q(bf16x8 (&Qf)[HD / 16], const bf16_t* qrow, const float* g, float scale, int mh) {
    u32x4 raw[HD / 16]; float ss = 0.f;
#pragma unroll
    for (int s = 0; s < HD / 16; ++s) {
        raw[s] = *(const u32x4*)(qrow + 16 * s + 8 * mh);
#pragma unroll
        for (int i = 0; i < 4; ++i) { const float a = bflo(raw[s][i]), bb = bfhi(raw[s][i]); ss += a * a + bb * bb; }
    }
    ss += __shfl_xor(ss, 32);
    const float rstd = rsqrtf(ss * (1.0f / HD) + 1e-6f) * scale;
#pragma unroll
    for (int s = 0; s < HD / 16; ++s) {
        const f32x4 g0 = *(const f32x4*)(g + 16 * s + 8 * mh), g1 = *(const f32x4*)(g + 16 * s + 8 * mh + 4);
        u32x4 o;
        o[0] = pack2(bflo(raw[s][0]) * rstd * g0[0], bfhi(raw[s][0]) * rstd * g0[1]);
        o[1] = pack2(bflo(raw[s][1]) * rstd * g0[2], bfhi(raw[s][1]) * rstd * g0[3]);
        o[2] = pack2(bflo(raw[s][2]) * rstd * g1[0], bfhi(raw[s][2]) * rstd * g1[1]);
        o[3] = pack2(bflo(raw[s][3]) * rstd * g1[2], bfhi(raw[s][3]) * rstd * g1[3]);
        Qf[s] = __builtin_bit_cast(bf16x8, o);
    }
}
template <int HD>
DI void attn_load_k(LAS unsigned char* lds, const bf16_t* ksrc, size_t ldk, const float* gk, int tid) {
    constexpr int EPT = HD / 8;
    const int key = tid >> 3, part = tid & 7;
    const bf16_t* src = ksrc + (size_t)key * ldk + part * EPT;
    u32x4 raw[EPT / 8]; float ss = 0.f;
#pragma unroll
    for (int v = 0; v < EPT / 8; ++v) {
        raw[v] = *(const u32x4*)(src + v * 8);
#pragma unroll
        for (int i = 0; i < 4; ++i) { const float a = bflo(raw[v][i]), bb = bfhi(raw[v][i]); ss += a * a + bb * bb; }
    }
    ss = reduce8(ss);
    const float rstd = rsqrtf(ss * (1.0f / HD) + 1e-6f);
#pragma unroll
    for (int v = 0; v < EPT / 8; ++v) {
        const float* gp = gk + part * EPT + v * 8;
        const f32x4 g0 = *(const f32x4*)gp, g1 = *(const f32x4*)(gp + 4);
        u32x4 o;
        o[0] = pack2(bflo(raw[v][0]) * rstd * g0[0], bfhi(raw[v][0]) * rstd * g0[1]);
        o[1] = pack2(bflo(raw[v][1]) * rstd * g0[2], bfhi(raw[v][1]) * rstd * g0[3]);
        o[2] = pack2(bflo(raw[v][2]) * rstd * g1[0], bfhi(raw[v][2]) * rstd * g1[1]);
        o[3] = pack2(bflo(raw[v][3]) * rstd * g1[2], bfhi(raw[v][3]) * rstd * g1[3]);
        *(LAS u32x4*)(lds + AttnCfg<HD>::K_OFF + key * AttnCfg<HD>::KSTR + (part * EPT + v * 8) * 2) = o;
    }
}
template <int HD>
DI void attn_load_v(LAS unsigned char* lds, const bf16_t* vsrc, size_t ldv, int tid) {
    constexpr int TPR = 512 / HD, KPT = 64 / TPR;
    const int d = tid / TPR, part = tid % TPR;
    const bf16_t* src = vsrc + (size_t)d * ldv + part * KPT;
#pragma unroll
    for (int v = 0; v < KPT / 8; ++v) {
        const u32x4 raw = *(const u32x4*)(src + v * 8);
        LAS unsigned char* dp = lds + AttnCfg<HD>::V_OFF + d * AttnCfg<HD>::VSTR + (part * KPT + v * 8) * 2;
        *(LAS u32x2*)dp = (u32x2){raw[0], raw[1]};
        *(LAS u32x2*)(dp + 8) = (u32x2){raw[2], raw[3]};
    }
}
template <int HD, bool BIAS, bool QLDS>
DI void attn_chunk(const bf16x8 (&Qf)[HD / 16], const LAS unsigned char* qp, f32x16 (&O)[4], float& m_run, float& l_run, const LAS unsigned char* lds, int dbase, int mr, int mh, int qk_delta) {
#pragma unroll 1
    for (int kt = 0; kt < 2; ++kt) {
        f32x16 sc;
#pragma unroll
        for (int i = 0; i < 16; ++i) sc[i] = 0.f;
        const LAS unsigned char* kp = lds + AttnCfg<HD>::K_OFF + (kt * 32 + mr) * AttnCfg<HD>::KSTR + mh * 16;
#pragma unroll
        for (int s = 0; s < HD / 16; ++s) { if ((s & 3) == 0) __builtin_amdgcn_sched_barrier(0); const bf16x8 a = *(const LAS bf16x8*)(kp + s * 32); const bf16x8 qb = QLDS ? *(const LAS bf16x8*)(qp + s * 32) : Qf[s]; sc = MFMA32(a, qb, sc); }
        float mx = -1e30f;
#pragma unroll
        for (int i = 0; i < 16; ++i) {
            if (BIAS) {
                int dist = qk_delta + mr - (kt * 32 + crow(i, mh));
                dist = dist < -128 ? -128 : (dist > 128 ? 128 : dist);
                sc[i] += *(const LAS float*)(lds + AttnCfg<HD>::BIAS_OFF + (dist + 128) * 4);
            }
            mx = fmaxf(mx, sc[i]);
        }
        mx = fmaxf(mx, __shfl_xor(mx, 32));
        const float m_new = fmaxf(m_run, mx), alpha = __expf(m_run - m_new);
        float ls = 0.f;
#pragma unroll
        for (int i = 0; i < 16; ++i) { const float pv = __expf(sc[i] - m_new); sc[i] = pv; ls += pv; }
        l_run = l_run * alpha + ls; m_run = m_new;
#pragma unroll
        for (int dt = 0; dt < 4; ++dt)
#pragma unroll
            for (int i = 0; i < 16; ++i) O[dt][i] *= alpha;
#pragma unroll
        for (int s2 = 0; s2 < 2; ++s2) {
            u32x4 pk;
#pragma unroll
            for (int j = 0; j < 4; ++j) pk[j] = pack2(sc[8 * s2 + 2 * j], sc[8 * s2 + 2 * j + 1]);
            const bf16x8 pb = __builtin_bit_cast(bf16x8, pk);
#pragma unroll
            for (int dt = 0; dt < 4; ++dt) {
                const LAS unsigned char* vp = lds + AttnCfg<HD>::V_OFF + (dbase + dt * 32 + mr) * AttnCfg<HD>::VSTR + (kt * 32 + 16 * s2 + 4 * mh) * 2;
                const u32x2 lo = *(const LAS u32x2*)vp, hi = *(const LAS u32x2*)(vp + 16);
                const u32x4 va = {lo[0], lo[1], hi[0], hi[1]};
                O[dt] = MFMA32(__builtin_bit_cast(bf16x8, va), pb, O[dt]);
            }
        }
    }
}
DI void attn_store(const f32x16 (&O)[4], float l_run, const bf16_t* zrow, bf16_t* yrow, int mh) {
    const float lt = l_run + __shfl_xor(l_run, 32);
    const float inv = 1.0f / lt;
#pragma unroll
    for (int dt = 0; dt < 4; ++dt)
#pragma unroll
        for (int g = 0; g < 4; ++g) {
            const int d = dt * 32 + 8 * g + 4 * mh;
            const u32x2 zz = *(const u32x2*)(zrow + d);
            u32x2 o;
            o[0] = pack2(O[dt][4 * g] * inv * siluf_(bflo(zz[0])), O[dt][4 * g + 1] * inv * siluf_(bfhi(zz[0])));
            o[1] = pack2(O[dt][4 * g + 2] * inv * siluf_(bflo(zz[1])), O[dt][4 * g + 3] * inv * siluf_(bfhi(zz[1])));
            *(u32x2*)(yrow + d) = o;
        }
}

DI void attnA_item(const Params& p, unsigned char* smem, int item) {
    const int b = item >> 6, head = (item >> 3) & 7, cgp = item & 7;
    int tid = threadIdx.x; asm volatile("" : "+v"(tid));
    const int wid = tid >> 6, lane = tid & 63, mr = lane & 31, mh = lane >> 5;
    LAS unsigned char* lds = (LAS unsigned char*)smem;
    const bf16_t* PA = (const bf16_t*)(p.ws + OFF_PA);
    const bf16_t* VT = (const bf16_t*)(p.ws + OFF_VT);
    bf16_t* YA = (bf16_t*)((char*)p.out + OFF_YA);
    const int cw = cgp * 4 + (wid >> 1), qt = wid & 1;
    const size_t qrow = (size_t)b * SEQ + cw * 64 + qt * 32 + mr;
    if (tid < 257) *(LAS float*)(lds + AttnCfg<128>::BIAS_OFF + tid * 4) = p.in[I_RELB][head * 257 + tid];
    bf16x8 Qf[8];
    attn_load_q<128>(Qf, PA + qrow * 3072 + head * 128, p.in[I_AQG], 0.08838834764831845f, mh);
    f32x16 O[4];
#pragma unroll
    for (int dt = 0; dt < 4; ++dt)
#pragma unroll
        for (int i = 0; i < 16; ++i) O[dt][i] = 0.f;
    float m_run = -1e30f, l_run = 0.f;
    for (int kc = cgp * 4 - 8; kc <= cgp * 4 + 3; ++kc) {
        if (kc < 0) continue;
        __syncthreads();
        attn_load_k<128>(lds, PA + ((size_t)b * SEQ + kc * 64) * 3072 + 1024 + head * 128, 3072, p.in[I_AKG], tid);
        attn_load_v<128>(lds, VT + (size_t)(head * 128) * T_TOK + (size_t)b * SEQ + kc * 64, T_TOK, tid);
        __syncthreads();
        if (kc >= cw - 8 && kc <= cw)
            attn_chunk<128, true, false>(Qf, lds, O, m_run, l_run, lds, 0, mr, mh, (cw - kc) * 64 + qt * 32);
    }
    attn_store(O, l_run, PA + qrow * 3072 + 2048 + head * 128, YA + qrow * 1024 + head * 128, mh);
    __syncthreads();
}
DI void attnC_item(const Params& p, unsigned char* smem, int item) {
    const int b = item >> 6, hc = (item >> 4) & 3, qg = item & 15;
    int tid = threadIdx.x; asm volatile("" : "+v"(tid));
    const int wid = tid >> 6, lane = tid & 63, mr = lane & 31, mh = lane >> 5;
    LAS unsigned char* lds = (LAS unsigned char*)smem;
    const bf16_t* PC = (const bf16_t*)(p.ws + OFF_PC);
    const bf16_t* MK = (const bf16_t*)(p.ws + OFF_MK);
    const bf16_t* MVT = (const bf16_t*)(p.ws + OFF_MVT);
    bf16_t* YC = (bf16_t*)((char*)p.out + OFF_YC);
    const int qt = wid >> 1, dh = wid & 1;
    const size_t qrow = (size_t)b * SEQ + qg * 128 + qt * 32 + mr;
    constexpr int Q_OFF = AttnCfg<256>::V_OFF + 256 * AttnCfg<256>::VSTR;
    __syncthreads();
    {
        bf16x8 Qf[16];
        attn_load_q<256>(Qf, PC + qrow * 2048 + hc * 256, p.in[I_CQG], 0.0625f, mh);
        if (dh == 0) {
#pragma unroll
            for (int s = 0; s < 16; ++s) *(LAS bf16x8*)(lds + Q_OFF + (qt * 32 + mr) * 528 + s * 32 + mh * 16) = Qf[s];
        }
    }
    const LAS unsigned char* qp = lds + Q_OFF + (qt * 32 + mr) * 528 + mh * 16;
    bf16x8 Qd[16];
    f32x16 O[4];
#pragma unroll
    for (int dt = 0; dt < 4; ++dt)
#pragma unroll
        for (int i = 0; i < 16; ++i) O[dt][i] = 0.f;
    float m_run = -1e30f, l_run = 0.f;
    for (int kc = 0; kc < 4; ++kc) {
        __syncthreads();
        attn_load_k<256>(lds, MK + ((size_t)b * NMEM + kc * 64) * 1024 + hc * 256, 1024, p.in[I_CKG], tid);
        attn_load_v<256>(lds, MVT + (size_t)(hc * 256) * 2048 + (size_t)b * NMEM + kc * 64, 2048, tid);
        __syncthreads();
        attn_chunk<256, false, true>(Qd, qp, O, m_run, l_run, lds, dh * 128, mr, mh, 0);
    }
    attn_store(O, l_run, PC + qrow * 2048 + 1024 + hc * 256 + dh * 128, YC + qrow * 1024 + hc * 256 + dh * 128, mh);
    __syncthreads();
}
DI void phase2(const Params& p, unsigned char* smem) {
    const int c = blockIdx.x;
    if (c < 128) scan_item(p, smem, c);
    for (int it = c + p.G; it < 128 && c < 128; it += p.G) scan_item(p, smem, it);
    unsigned* ctr = (unsigned*)(p.ws + OFF_CTR);
    LAS int* sitem = (LAS int*)((LAS unsigned char*)smem + LDS_BYTES - 16);
    auto fetch = [&]() -> int {
        __syncthreads();
        if (threadIdx.x == 0) *sitem = (int)atomicAdd(ctr, 1u);
        __syncthreads();
        return *sitem;
    };
    int item = fetch();
    while (item < 512) { attnA_item(p, smem, item); item = fetch(); }
    while (item < 1024) { attnC_item(p, smem, item - 512); item = fetch(); }
}

__global__ void __launch_bounds__(NTHREADS) hybrid_fwd(Params p) {
    extern __shared__ __attribute__((aligned(16))) unsigned char smem[];
    cg::grid_group grid = cg::this_grid();
#ifndef PHMASK
#define PHMASK 31
#endif
    if (PHMASK & 1) phase0(p, smem);
    grid.sync();
    if (PHMASK & 2) gemm_phase<1>((LAS unsigned char*)smem, p);
    grid.sync();
    if (PHMASK & 4) phase2(p, smem);
    grid.sync();
    if (PHMASK & 8) gemm_phase<3>((LAS unsigned char*)smem, p);
    grid.sync();
    if (PHMASK & 16) gemm_phase<4>((LAS unsigned char*)smem, p);
}

extern "C" void kernel_launch(void* const* d_in, const int* in_sizes, int n_in, void* d_out, int out_size, void* d_ws, size_t ws_size, hipStream_t stream) {
    static int grid_blocks = 0;
    if (grid_blocks == 0) {
        if (n_in != 27 || ws_size < WS_END || out_size != T_TOK * DM) { fprintf(stderr, "kernel_launch: unexpected shapes (n_in %d ws %zu out %d)\n", n_in, ws_size, out_size); grid_blocks = -1; return; }
        int dev = 0, cus = 0, per_cu = 0;
        hipGetDevice(&dev);
        hipDeviceGetAttribute(&cus, hipDeviceAttributeMultiprocessorCount, dev);
        if (hipFuncSetAttribute((const void*)hybrid_fwd, hipFuncAttributeMaxDynamicSharedMemorySize, LDS_BYTES) != hipSuccess) { fprintf(stderr, "kernel_launch: hipFuncSetAttribute failed\n"); grid_blocks = -1; return; }
        if (hipOccupancyMaxActiveBlocksPerMultiprocessor(&per_cu, (const void*)hybrid_fwd, NTHREADS, LDS_BYTES) != hipSuccess || per_cu < 1) { fprintf(stderr, "kernel_launch: occupancy query failed (%d)\n", per_cu); grid_blocks = -1; return; }
        grid_blocks = cus * 1;
    }
    if (grid_blocks < 0) return;
    Params p{};
    for (int i = 0; i < 27; ++i) p.in[i] = (const float*)d_in[i];
    p.out = (float*)d_out; p.ws = (unsigned char*)d_ws; p.G = grid_blocks; p.pad = 0;
    void* args[] = {&p};
    hipError_t e = hipLaunchCooperativeKernel((const void*)hybrid_fwd, dim3(grid_blocks), dim3(NTHREADS), args, LDS_BYTES, stream);
    if (e != hipSuccess) fprintf(stderr, "cooperative launch failed: %s (grid %d)\n", hipGetErrorString(e), grid_blocks);
}
```

```cpp
#include <hip/hip_runtime.h>
#include <hip/hip_cooperative_groups.h>
#include <cstdio>
namespace cg = cooperative_groups;

#define DI __device__ __forceinline__
#define LAS __attribute__((address_space(3)))
typedef unsigned short bf16_t;
typedef short bf16x8 __attribute__((ext_vector_type(8)));
typedef float f32x2 __attribute__((ext_vector_type(2)));
typedef float f32x4 __attribute__((ext_vector_type(4)));
typedef float f32x16 __attribute__((ext_vector_type(16)));
typedef unsigned u32x2 __attribute__((ext_vector_type(2)));
typedef unsigned u32x4 __attribute__((ext_vector_type(4)));
typedef __bf16 bf16v2 __attribute__((ext_vector_type(2)));

constexpr int T_TOK = 16384, DM = 2048, SEQ = 2048, NB = 8, NMEM = 256;
constexpr int INC = 16512;
constexpr int NTHREADS = 512;
constexpr int LDS_BYTES = 139264;

constexpr size_t SZ_WT = (size_t)INC * DM * 2;
constexpr size_t OFF_WT = 0;
constexpr size_t OFF_WMEM = OFF_WT + SZ_WT;
constexpr size_t OFF_WUA = OFF_WMEM + (size_t)2048 * 2048 * 2;
constexpr size_t OFF_WUB = OFF_WUA + (size_t)2048 * 1024 * 2;
constexpr size_t OFF_WUC = OFF_WUB + (size_t)2048 * 1024 * 2;
constexpr size_t OFF_WO = OFF_WUC + (size_t)2048 * 1024 * 2;
constexpr size_t OFF_H = OFF_WO + (size_t)2048 * 2048 * 2;
constexpr size_t OFF_M = OFF_H + (size_t)T_TOK * 2048 * 2;
constexpr size_t OFF_PA = OFF_M + (size_t)2048 * 2048 * 2;
constexpr size_t OFF_PB = OFF_PA + (size_t)T_TOK * 3072 * 2;
constexpr size_t OFF_PL = OFF_PB + (size_t)T_TOK * 4096 * 2;
constexpr size_t OFF_PC = OFF_PL + (size_t)T_TOK * 256 * 2;
constexpr size_t OFF_VT = OFF_PC + (size_t)T_TOK * 2048 * 2;
constexpr size_t OFF_MK = OFF_VT + (size_t)1024 * T_TOK * 2;
constexpr size_t OFF_MVT = OFF_MK + (size_t)2048 * 1024 * 2;
constexpr size_t OFF_CTR = OFF_MVT + (size_t)1024 * 2048 * 2;
constexpr size_t WS_END = OFF_CTR + 256;
constexpr size_t OFF_MERGED = OFF_PA;
constexpr size_t OFF_SCR = OFF_PB;
constexpr size_t SCR_PER_WG = 2 * 131072;
constexpr size_t OFF_YA = 0, OFF_YB = (size_t)T_TOK * 1024 * 2, OFF_YC = 2 * OFF_YB;

struct Params {
    const float* in[27];
    float* out;
    unsigned char* ws;
    int G; int pad;
};
enum { I_X = 0, I_MEM, I_NORMG, I_WIN, I_AQG, I_AKG, I_RELB, I_WUPA, I_MURKV, I_MUW, I_MUA, I_W0, I_W2, I_A0, I_A2, I_KK, I_KA, I_RK, I_LNW, I_LNB, I_WUPB,
       I_MEMG, I_WMEMKV, I_CQG, I_CKG, I_WUPC, I_WO };

DI unsigned pack2(float lo, float hi) { f32x2 v = {lo, hi}; bf16v2 b = __builtin_convertvector(v, bf16v2); return __builtin_bit_cast(unsigned, b); }
DI float bflo(unsigned u) { return __uint_as_float(u << 16); }
DI float bfhi(unsigned u) { return __uint_as_float(u & 0xffff0000u); }
DI float sigmoidf_(float x) { return __builtin_amdgcn_rcpf(1.0f + __expf(-x)); }
DI float siluf_(float x) { return x * sigmoidf_(x); }
DI float wave_sum(float v) {
#pragma unroll
    for (int o = 32; o > 0; o >>= 1) v += __shfl_xor(v, o);
    return v;
}
template <int CTRL> DI float dpp_mov(float x) { return __int_as_float(__builtin_amdgcn_update_dpp(0, __float_as_int(x), CTRL, 0xf, 0xf, false)); }
DI float reduce8(float x) {
    x += dpp_mov<0xB1>(x);
    x += dpp_mov<0x4E>(x);
    x += dpp_mov<0x141>(x);
    return x;
}
DI int crow(int i, int h) { return (i & 3) + 8 * (i >> 2) + 4 * h; }
#define MFMA32(a, b, c) __builtin_amdgcn_mfma_f32_32x32x16_bf16((a), (b), (c), 0, 0, 0)

DI void transpose_tile(const float* __restrict__ src, bf16_t* __restrict__ dst, int R, int C, int tr, int tc, float* lds) {
    const int tid = threadIdx.x;
    const int r = tid >> 3, cs = (tid & 7) * 8;
    const float* sp = src + (size_t)(tr * 64 + r) * C + tc * 64 + cs;
    f32x4 v0 = *(const f32x4*)sp, v1 = *(const f32x4*)(sp + 4);
    float* lp = lds + r * 65 + cs;
    lp[0] = v0[0]; lp[1] = v0[1]; lp[2] = v0[2]; lp[3] = v0[3]; lp[4] = v1[0]; lp[5] = v1[1]; lp[6] = v1[2]; lp[7] = v1[3];
    __syncthreads();
    const int c = tid >> 3, ks = (tid & 7) * 8;
    u32x4 o;
    o[0] = pack2(lds[(ks + 0) * 65 + c], lds[(ks + 1) * 65 + c]);
    o[1] = pack2(lds[(ks + 2) * 65 + c], lds[(ks + 3) * 65 + c]);
    o[2] = pack2(lds[(ks + 4) * 65 + c], lds[(ks + 5) * 65 + c]);
    o[3] = pack2(lds[(ks + 6) * 65 + c], lds[(ks + 7) * 65 + c]);
    *(u32x4*)(dst + (size_t)(tc * 64 + c) * R + tr * 64 + ks) = o;
    __syncthreads();
}
DI void rmsnorm_row2048(const float* __restrict__ x, const float* __restrict__ g, bf16_t* __restrict__ out, int lane) {
    f32x4 v[8]; float ss = 0.f;
#pragma unroll
    for (int i = 0; i < 8; ++i) { v[i] = ((const f32x4*)x)[i * 64 + lane]; ss += v[i][0] * v[i][0] + v[i][1] * v[i][1] + v[i][2] * v[i][2] + v[i][3] * v[i][3]; }
    ss = wave_sum(ss);
    const float rstd = rsqrtf(ss * (1.0f / 2048.0f) + 1e-6f);
#pragma unroll
    for (int i = 0; i < 8; ++i) {
        const f32x4 g4 = ((const f32x4*)g)[i * 64 + lane];
        u32x2 o; o[0] = pack2(v[i][0] * rstd * g4[0], v[i][1] * rstd * g4[1]); o[1] = pack2(v[i][2] * rstd * g4[2], v[i][3] * rstd * g4[3]);
        ((u32x2*)out)[i * 64 + lane] = o;
    }
}
DI void phase0(const Params& p, unsigned char* smem) {
    float* lds = (float*)smem;
    const int G = p.G, c = blockIdx.x;
    if (c == 0 && threadIdx.x == 0) *(unsigned*)(p.ws + OFF_CTR) = 0u;
    constexpr int N_WIN = 32 * 258, N_SQ = 32 * 32, N_UP = 16 * 32;
    constexpr int NTR = N_WIN + N_SQ + 3 * N_UP + N_SQ;
    for (int u = c; u < NTR; u += G) {
        int l = u;
        if (l < N_WIN) { transpose_tile(p.in[I_WIN], (bf16_t*)(p.ws + OFF_WT), 2048, INC, l & 31, l >> 5, lds); continue; }
        l -= N_WIN;
        if (l < N_SQ) { transpose_tile(p.in[I_WMEMKV], (bf16_t*)(p.ws + OFF_WMEM), 2048, 2048, l & 31, l >> 5, lds); continue; }
        l -= N_SQ;
        if (l < 3 * N_UP) {
            const int w = l / N_UP; l -= w * N_UP;
            const float* src = w == 0 ? p.in[I_WUPA] : (w == 1 ? p.in[I_WUPB] : p.in[I_WUPC]);
            bf16_t* dst = (bf16_t*)(p.ws + (w == 0 ? OFF_WUA : (w == 1 ? OFF_WUB : OFF_WUC)));
            transpose_tile(src, dst, 1024, 2048, l & 15, l >> 4, lds); continue;
        }
        l -= 3 * N_UP;
        transpose_tile(p.in[I_WO], (bf16_t*)(p.ws + OFF_WO), 2048, 2048, l & 31, l >> 5, lds);
    }
    const int wid = threadIdx.x >> 6, lane = threadIdx.x & 63;
    for (int rg = c; rg < (T_TOK + 2048) / 8; rg += G) {
        const int row = rg * 8 + wid;
        if (row < T_TOK) rmsnorm_row2048(p.in[I_X] + (size_t)row * 2048, p.in[I_NORMG], (bf16_t*)(p.ws + OFF_H) + (size_t)row * 2048, lane);
        else rmsnorm_row2048(p.in[I_MEM] + (size_t)(row - T_TOK) * 2048, p.in[I_MEMG], (bf16_t*)(p.ws + OFF_M) + (size_t)(row - T_TOK) * 2048, lane);
    }
}

constexpr int BM = 256, BK = 64, HALF = 128, HTB = HALF * BK * 2;
DI int lds_byte(int r, int c) { const int st = (r >> 4) * 2 + (c >> 5), rr = r & 15, cc = c & 31, ob = rr * 64 + cc * 2; return st * 1024 + (ob ^ (((ob >> 9) & 1) << 5)); }
DI void stage_rc(int b, int& R, int& C) { const int st = b / 1024, sb = b % 1024, swz = sb ^ (((sb >> 9) & 1) << 5); R = (st >> 1) * 16 + swz / 64; C = (st & 1) * 32 + (swz % 64) / 2; }

enum { EPI_BF16 = 0, EPI_UP = 1, EPI_GATE = 2, EPI_OUT = 4 };
struct Unit { const char* A; const char* B; char* C; int K; int ldc; int kind; int aux; const float* X; };

DI void epilogue(const f32x4 (&acc)[2][2][4][2], const Unit& u, int wr, int wc, int fr, int fq, int tid, char* scr) {
    if (u.kind == EPI_BF16) {
#pragma unroll
        for (int ai = 0; ai < 2; ++ai)
#pragma unroll
            for (int m = 0; m < 4; ++m) {
                bf16_t* rowp = (bf16_t*)u.C + (size_t)(ai * 128 + wr * 64 + m * 16 + fr) * u.ldc + wc * 32 + 4 * fq;
#pragma unroll
                for (int bj = 0; bj < 2; ++bj)
#pragma unroll
                    for (int n = 0; n < 2; ++n) {
                        const f32x4 a = acc[ai][bj][m][n]; u32x2 o; o[0] = pack2(a[0], a[1]); o[1] = pack2(a[2], a[3]);
                        *(u32x2*)(rowp + bj * 128 + n * 16) = o;
                    }
            }
    } else if (u.kind == EPI_OUT) {
#pragma unroll
        for (int ai = 0; ai < 2; ++ai)
#pragma unroll
            for (int m = 0; m < 4; ++m) {
                const size_t ro = (size_t)(ai * 128 + wr * 64 + m * 16 + fr) * 2048 + wc * 32 + 4 * fq;
#pragma unroll
                for (int bj = 0; bj < 2; ++bj)
#pragma unroll
                    for (int n = 0; n < 2; ++n) {
                        const f32x4 xv = *(const f32x4*)(u.X + ro + bj * 128 + n * 16);
                        *(f32x4*)((float*)u.C + ro + bj * 128 + n * 16) = acc[ai][bj][m][n] + xv;
                    }
            }
    } else if (u.kind == EPI_UP) {
        u32x2* sp = (u32x2*)scr + tid;
#pragma unroll
        for (int ai = 0; ai < 2; ++ai)
#pragma unroll
            for (int m = 0; m < 4; ++m) {
                asm volatile("" : "+v"(sp) : : "memory");
#pragma unroll
                for (int bj = 0; bj < 2; ++bj)
#pragma unroll
                    for (int n = 0; n < 2; ++n) {
                        const f32x4 a = acc[ai][bj][m][n];
                        u32x2 o; o[0] = pack2(a[0], a[1]); o[1] = pack2(a[2], a[3]);
                        sp[(bj * 2 + n) * 512] = o;
                    }
                sp += 4 * 512;
            }
    } else {
        u32x2* sp = (u32x2*)scr + tid;
        const int mode = u.aux;
#pragma unroll
        for (int ai = 0; ai < 2; ++ai)
#pragma unroll
            for (int m = 0; m < 4; ++m) {
                asm volatile("" : "+v"(sp) : : "memory");
                __builtin_amdgcn_sched_barrier(0);
                bf16_t* rowp = (bf16_t*)u.C + (size_t)(ai * 128 + wr * 64 + m * 16 + fr) * u.ldc + wc * 32 + 4 * fq;
#pragma unroll
                for (int bj = 0; bj < 2; ++bj)
#pragma unroll
                    for (int n = 0; n < 2; ++n) {
                        const int idx = (bj * 2 + n) * 512;
                        const u32x2 uu = sp[idx];
                        u32x2 mm = {0u, 0u};
                        if (mode != 0) mm = sp[idx + 16384];
                        const f32x4 a = acc[ai][bj][m][n];
                        const float r0 = bflo(mm[0]) + sigmoidf_(a[0]) * bflo(uu[0]);
                        const float r1 = bfhi(mm[0]) + sigmoidf_(a[1]) * bfhi(uu[0]);
                        const float r2 = bflo(mm[1]) + sigmoidf_(a[2]) * bflo(uu[1]);
                        const float r3 = bfhi(mm[1]) + sigmoidf_(a[3]) * bfhi(uu[1]);
                        u32x2 o; o[0] = pack2(r0, r1); o[1] = pack2(r2, r3);
                        if (mode == 2) *(u32x2*)(rowp + bj * 128 + n * 16) = o; else sp[idx + 16384] = o;
                    }
                sp += 4 * 512;
            }
    }
}

DI bool p1_unit(const Params& p, int L, Unit& u) {
    if (L >= 2688) return false;
    u.K = 2048; u.kind = EPI_BF16; u.aux = 0; u.X = nullptr;
    const char* ws = (const char*)p.ws;
    if (L < 2368) {
        const int gid = L / 296, rem = L - gid * 296, pm = gid * 8 + (rem & 7), ct = rem >> 3;
        int brow, col, ldc; size_t cb;
        if (ct < 8) { brow = ct * 256; cb = OFF_PA; col = ct * 256; ldc = 3072; }
        else if (ct < 12) { brow = 3072 + (ct - 8) * 256; cb = OFF_PA; col = 2048 + (ct - 8) * 256; ldc = 3072; }
        else if (ct < 28) { brow = 4096 + (ct - 12) * 256; cb = OFF_PB; col = (ct - 12) * 256; ldc = 4096; }
        else if (ct == 28) { brow = 8192; cb = OFF_PL; col = 0; ldc = 256; }
        else { brow = 8320 + (ct - 29) * 256; cb = OFF_PC; col = (ct - 29) * 256; ldc = 2048; }
        u.A = ws + OFF_H + (size_t)pm * 256 * 4096; u.B = ws + OFF_WT + (size_t)brow * 4096;
        u.C = (char*)p.ws + cb + ((size_t)pm * 256 * ldc + col) * 2; u.ldc = ldc;
    } else if (L < 2624) {
        const int l = L - 2368, pm = l & 3, pn = l >> 2;
        u.A = ws + OFF_WT + (size_t)(2048 + pm * 256) * 4096; u.B = ws + OFF_H + (size_t)pn * 256 * 4096;
        u.C = (char*)p.ws + OFF_VT + ((size_t)pm * 256 * T_TOK + pn * 256) * 2; u.ldc = T_TOK;
    } else if (L < 2656) {
        const int l = L - 2624, pm = l & 7, pn = l >> 3;
        u.A = ws + OFF_M + (size_t)pm * 256 * 4096; u.B = ws + OFF_WMEM + (size_t)pn * 256 * 4096;
        u.C = (char*)p.ws + OFF_MK + ((size_t)pm * 256 * 1024 + pn * 256) * 2; u.ldc = 1024;
    } else {
        const int l = L - 2656, pm = l & 3, pn = l >> 2;
        u.A = ws + OFF_WMEM + (size_t)(1024 + pm * 256) * 4096; u.B = ws + OFF_M + (size_t)pn * 256 * 4096;
        u.C = (char*)p.ws + OFF_MVT + ((size_t)pm * 256 * 2048 + pn * 256) * 2; u.ldc = 2048;
    }
    return true;
}
DI void tile_pmpn(int tl, int& pm, int& pn) { pm = (tl & 7) + 8 * (tl >> 6); pn = (tl >> 3) & 7; }
DI bool p3_unit(const Params& p, int cp, int ui, Unit& u) {
    const int ti = ui / 6, sub = ui - ti * 6, tl = cp + p.G * ti;
    if (tl >= 512) return false;
    int pm, pn; tile_pmpn(tl, pm, pn);
    const char* ws = (const char*)p.ws; const char* yo = (const char*)p.out;
    u.X = nullptr; u.ldc = 2048;
    u.C = (char*)p.ws + OFF_MERGED + ((size_t)pm * 256 * 2048 + pn * 256) * 2;
    const int x = sub >> 1;
    if ((sub & 1) == 0) {
        u.K = 1024; u.kind = EPI_UP; u.aux = 0;
        u.A = yo + (size_t)x * OFF_YB + (size_t)pm * 256 * 2048;
        u.B = ws + (x == 0 ? OFF_WUA : (x == 1 ? OFF_WUB : OFF_WUC)) + (size_t)pn * 256 * 2048;
    } else {
        u.K = 2048; u.kind = EPI_GATE; u.aux = x;
        u.A = ws + OFF_H + (size_t)pm * 256 * 4096;
        u.B = ws + OFF_WT + (size_t)(10368 + 2048 * x + 256 * pn) * 4096;
    }
    return true;
}
DI bool p4_unit(const Params& p, int cp, int ui, Unit& u) {
    const int tl = cp + p.G * ui;
    if (tl >= 512) return false;
    int pm, pn; tile_pmpn(tl, pm, pn);
    const char* ws = (const char*)p.ws;
    u.K = 2048; u.kind = EPI_OUT; u.aux = 0; u.ldc = 2048;
    u.A = ws + OFF_MERGED + (size_t)pm * 256 * 4096; u.B = ws + OFF_WO + (size_t)pn * 256 * 4096;
    u.C = (char*)(p.out + (size_t)pm * 256 * 2048 + pn * 256);
    u.X = p.in[I_X] + (size_t)pm * 256 * 2048 + pn * 256;
    return true;
}
template <int PH> DI bool get_unit(const Params& p, int cp, int ui, Unit& u) {
    if (PH == 1) return p1_unit(p, ui * p.G + cp, u);
    if (PH == 3) return p3_unit(p, cp, ui, u);
    return p4_unit(p, cp, ui, u);
}

template <int PH>
DI void gemm_phase(LAS unsigned char* lds, const Params& p) {
    int tid = threadIdx.x; asm volatile("" : "+v"(tid));
    const int wid = __builtin_amdgcn_readfirstlane(tid >> 6), lane = tid & 63, wr = wid >> 2, wc = wid & 3, fr = lane & 15, fq = lane >> 4;
    const int c = blockIdx.x, cp = (p.G & 7) == 0 ? (c & 7) * (p.G >> 3) + (c >> 3) : c;
    char* scr = (char*)p.ws + OFF_SCR + (size_t)c * SCR_PER_WG;
    int sR[2], sC[2];
#pragma unroll
    for (int i = 0; i < 2; ++i) stage_rc(tid * 16 + i * 8192, sR[i], sC[i]);
    const unsigned ldsw = (unsigned)wid * 1024u;
    const int aoff = lds_byte(wr * 64 + fr, fq * 8), boff = lds_byte(wc * 32 + fr, fq * 8);
#define G_SA(b, h) (((b) * 2 + (h)) * HTB)
#define G_SB(b, h) ((4 + (b) * 2 + (h)) * HTB)
#define G_STAGE(bufoff, gbase, KK) do { _Pragma("unroll") for (int _i = 0; _i < 2; ++_i) \
        __builtin_amdgcn_global_load_lds((const unsigned*)((gbase) + (size_t)(unsigned)((sR[_i] * (KK) + sC[_i]) * 2)), (LAS unsigned*)(lds + (bufoff) + ldsw + _i * 8192), 16, 0, 0); } while (0)
#define G_LDA(dst, b, h) do { _Pragma("unroll") for (int m = 0; m < 4; ++m) _Pragma("unroll") for (int k = 0; k < 2; ++k) dst[m][k] = *(const LAS bf16x8*)(lds + G_SA(b, h) + aoff + m * 2048 + k * 1024); } while (0)
#define G_LDB(dst, b, h) do { _Pragma("unroll") for (int n = 0; n < 2; ++n) _Pragma("unroll") for (int k = 0; k < 2; ++k) dst[n][k] = *(const LAS bf16x8*)(lds + G_SB(b, h) + boff + n * 2048 + k * 1024); } while (0)
#define G_MMA(ai, bj, At, Bt) do { __builtin_amdgcn_s_setprio(1); _Pragma("unroll") for (int m = 0; m < 4; ++m) _Pragma("unroll") for (int n = 0; n < 2; ++n) _Pragma("unroll") for (int k = 0; k < 2; ++k) \
        acc[ai][bj][m][n] = __builtin_amdgcn_mfma_f32_16x16x32_bf16(Bt[n][k], At[m][k], acc[ai][bj][m][n], 0, 0, 0); __builtin_amdgcn_s_setprio(0); } while (0)
#define G_WAIT_V(n) asm volatile("s_waitcnt vmcnt(" #n ")" ::: "memory")
#define G_WAIT_L(n) asm volatile("s_waitcnt lgkmcnt(" #n ")" ::: "memory")
#define G_BAR __builtin_amdgcn_s_barrier()
#define G_SCHED __builtin_amdgcn_sched_barrier(0)
    Unit cur, nxt; int ui = 0;
    if (!get_unit<PH>(p, cp, 0, cur)) return;
    f32x4 acc[2][2][4][2];
#pragma unroll
    for (int a = 0; a < 2; ++a)
#pragma unroll
        for (int b = 0; b < 2; ++b)
#pragma unroll
            for (int m = 0; m < 4; ++m)
#pragma unroll
                for (int n = 0; n < 2; ++n) acc[a][b][m][n] = (f32x4){0.f, 0.f, 0.f, 0.f};
    bf16x8 At[4][2], B0[2][2], B1[2][2];
    const char* cA = cur.A; const char* cB = cur.B; int Kc = cur.K;
    {
        const size_t hs = (size_t)HALF * Kc * 2;
        G_STAGE(G_SB(0, 0), cB, Kc); G_STAGE(G_SA(0, 0), cA, Kc); G_STAGE(G_SB(0, 1), cB + hs, Kc); G_STAGE(G_SA(0, 1), cA + hs, Kc);
        if (wr == 1) G_BAR;
        G_WAIT_V(4); G_BAR;
        G_STAGE(G_SB(1, 0), cB + 128, Kc); G_STAGE(G_SA(1, 0), cA + 128, Kc); G_STAGE(G_SB(1, 1), cB + hs + 128, Kc);
        G_WAIT_V(6); G_BAR;
    }
    for (;;) {
        const bool has_next = get_unit<PH>(p, cp, ui + 1, nxt);
        const char* nA = has_next ? nxt.A : cA; const char* nB = has_next ? nxt.B : cB; const int Kn = has_next ? nxt.K : Kc;
        const int nt = Kc / BK;
        const size_t hsc = (size_t)HALF * Kc * 2;
        for (int t = 0; t < nt; t += 2) {
            const bool last = (t == nt - 2);
            const char* a1 = cA + (size_t)(t + 1) * 128;
            const int K2 = last ? Kn : Kc;
            const size_t hs2 = (size_t)HALF * K2 * 2;
            const char* a2 = last ? nA : cA + (size_t)(t + 2) * 128; const char* b2 = last ? nB : cB + (size_t)(t + 2) * 128;
            const char* a3 = a2 + 128; const char* b3 = b2 + 128;
            G_LDB(B0, 0, 0); G_SCHED; G_LDA(At, 0, 0); G_STAGE(G_SA(1, 1), a1 + hsc, Kc);
            G_WAIT_L(8); G_BAR; G_WAIT_L(0); G_MMA(0, 0, At, B0); G_BAR; G_SCHED;
            G_LDB(B1, 0, 1); G_STAGE(G_SB(0, 0), b2, K2);
            G_BAR; G_WAIT_L(0); G_MMA(0, 1, At, B1); G_BAR;
            G_LDA(At, 0, 1); G_STAGE(G_SA(0, 0), a2, K2);
            G_BAR; G_WAIT_L(0); G_MMA(1, 0, At, B0); G_BAR; G_SCHED;
            G_STAGE(G_SB(0, 1), b2 + hs2, K2);
            G_WAIT_V(6); G_BAR; G_MMA(1, 1, At, B1); G_BAR;
            G_LDB(B0, 1, 0); G_SCHED; G_LDA(At, 1, 0); G_STAGE(G_SA(0, 1), a2 + hs2, K2);
            G_WAIT_L(8); G_BAR; G_WAIT_L(0); G_MMA(0, 0, At, B0); G_BAR; G_SCHED;
            G_LDB(B1, 1, 1); G_STAGE(G_SB(1, 0), b3, K2);
            G_BAR; G_WAIT_L(0); G_MMA(0, 1, At, B1); G_BAR;
            G_LDA(At, 1, 1); G_STAGE(G_SA(1, 0), a3, K2);
            G_BAR; G_WAIT_L(0); G_MMA(1, 0, At, B0); G_BAR; G_SCHED;
            G_STAGE(G_SB(1, 1), b3 + hs2, K2);
            G_WAIT_V(6); G_BAR; G_MMA(1, 1, At, B1); G_BAR;
        }
        epilogue(acc, cur, wr, wc, fr, fq, tid, scr);
        if (!has_next) break;
#pragma unroll
        for (int a = 0; a < 2; ++a)
#pragma unroll
            for (int b = 0; b < 2; ++b)
#pragma unroll
                for (int m = 0; m < 4; ++m)
#pragma unroll
                    for (int n = 0; n < 2; ++n) acc[a][b][m][n] = (f32x4){0.f, 0.f, 0.f, 0.f};
        cur = nxt; cA = nA; cB = nB; Kc = Kn; ++ui;
    }
    G_WAIT_V(0);
    if (wr == 0) G_BAR;
    G_BAR;
}

constexpr int SB_W = 0, SB_KK = 8192, SB_BV = 16384, SB_KP = 24576, SB_R = 32768, SB_V = 40960, SB_O = 49152, SB_SIZE = 57344;
constexpr int SC_AWD = 114688, SC_AAD = 119296;
constexpr int SC_ASTR = 144;
DI void ld8(const bf16_t* ptr, float (&f)[8]) {
    const u32x4 v = *(const u32x4*)ptr;
#pragma unroll
    for (int i = 0; i < 4; ++i) { f[2 * i] = bflo(v[i]); f[2 * i + 1] = bfhi(v[i]); }
}
struct ScanOps { f32x4 w0, w1, a0, a1, b0, b1, k0, k1, r0, r1; f32x2 v; };
DI void scan_load(ScanOps& o, const LAS unsigned char* bp, const LAS unsigned char* vp) {
    o.w0 = *(const LAS f32x4*)(bp + SB_W); o.w1 = *(const LAS f32x4*)(bp + SB_W + 16);
    o.a0 = *(const LAS f32x4*)(bp + SB_KK); o.a1 = *(const LAS f32x4*)(bp + SB_KK + 16);
    o.b0 = *(const LAS f32x4*)(bp + SB_BV); o.b1 = *(const LAS f32x4*)(bp + SB_BV + 16);
    o.k0 = *(const LAS f32x4*)(bp + SB_KP); o.k1 = *(const LAS f32x4*)(bp + SB_KP + 16);
    o.r0 = *(const LAS f32x4*)(bp + SB_R); o.r1 = *(const LAS f32x4*)(bp + SB_R + 16);
    o.v = *(const LAS f32x2*)vp;
}
DI f32x2 lo2(f32x4 x) { return (f32x2){x[0], x[1]}; }
DI f32x2 hi2(f32x4 x) { return (f32x2){x[2], x[3]}; }
DI f32x2 splat2(float x) { return (f32x2){x, x}; }
DI void scan_step(f32x2 (&S0)[4], f32x2 (&S1)[4], const ScanOps& o, LAS unsigned char* op, bool wr) {
    const f32x2 kk[4] = {lo2(o.a0), hi2(o.a0), lo2(o.a1), hi2(o.a1)};
    f32x2 p0 = S0[0] * kk[0], p1 = S1[0] * kk[0];
#pragma unroll
    for (int q = 1; q < 4; ++q) { p0 = __builtin_elementwise_fma(S0[q], kk[q], p0); p1 = __builtin_elementwise_fma(S1[q], kk[q], p1); }
    const float sa0 = -reduce8(p0[0] + p0[1]), sa1 = -reduce8(p1[0] + p1[1]);
    const f32x2 ww[4] = {lo2(o.w0), hi2(o.w0), lo2(o.w1), hi2(o.w1)};
    const f32x2 bb[4] = {lo2(o.b0), hi2(o.b0), lo2(o.b1), hi2(o.b1)};
    const f32x2 kv[4] = {lo2(o.k0), hi2(o.k0), lo2(o.k1), hi2(o.k1)};
    const f32x2 rr[4] = {lo2(o.r0), hi2(o.r0), lo2(o.r1), hi2(o.r1)};
    const f32x2 v0 = splat2(o.v[0]), v1 = splat2(o.v[1]), s0 = splat2(sa0), s1 = splat2(sa1);
#pragma unroll
    for (int q = 0; q < 4; ++q) {
        const f32x2 t0 = __builtin_elementwise_fma(bb[q], s0, kv[q] * v0), t1 = __builtin_elementwise_fma(bb[q], s1, kv[q] * v1);
        S0[q] = __builtin_elementwise_fma(S0[q], ww[q], t0); S1[q] = __builtin_elementwise_fma(S1[q], ww[q], t1);
    }
    f32x2 q0 = S0[0] * rr[0], q1 = S1[0] * rr[0];
#pragma unroll
    for (int q = 1; q < 4; ++q) { q0 = __builtin_elementwise_fma(S0[q], rr[q], q0); q1 = __builtin_elementwise_fma(S1[q], rr[q], q1); }
    const float o0 = reduce8(q0[0] + q0[1]), o1 = reduce8(q1[0] + q1[1]);
    if (wr) *(LAS f32x2*)op = (f32x2){o0, o1};
}
DI void scan_item(const Params& p, unsigned char* smem, int item) {
    const int b = item >> 4, h = item & 15;
    int tid = threadIdx.x; asm volatile("" : "+v"(tid));
    const int wid = __builtin_amdgcn_readfirstlane(tid >> 6), lane = tid & 63;
    const bf16_t* PB = (const bf16_t*)(p.ws + OFF_PB);
    const bf16_t* PL = (const bf16_t*)(p.ws + OFF_PL);
    bf16_t* YB = (bf16_t*)((char*)p.out + OFF_YB);
    LAS unsigned char* lds = (LAS unsigned char*)smem;
    const bool helper = wid >= 4;
    const int hw = wid & 3, mat = hw >> 1, tn = hw & 1, mr = lane & 31, mh = lane >> 5;
    bf16x8 Bf[4];
    float w0c = 0.f, a0c = 0.f, kac = 0.f;
    if (helper) {
        const float* Wx = (mat == 0 ? p.in[I_W2] : p.in[I_A2]) + h * 64 + tn * 32 + mr;
#pragma unroll
        for (int s = 0; s < 4; ++s) {
            u32x4 pk;
#pragma unroll
            for (int jj = 0; jj < 4; ++jj) pk[jj] = pack2(Wx[(size_t)(16 * s + 8 * mh + 2 * jj) * 1024], Wx[(size_t)(16 * s + 8 * mh + 2 * jj + 1) * 1024]);
            Bf[s] = __builtin_bit_cast(bf16x8, pk);
        }
        const int cj = h * 64 + tn * 32 + mr;
        w0c = p.in[I_W0][cj]; a0c = p.in[I_A0][cj]; kac = p.in[I_KA][cj];
    }
    const int ht = tid & 255, et = ht >> 3, eg = ht & 7, ec = h * 64 + eg * 8;

    auto stepA = [&](int ch, int buf) {
        const size_t row = (size_t)b * SEQ + ch * 32 + et;
        const bool hasprev = (ch * 32 + et) > 0;
        LAS unsigned char* bb = lds + buf * SB_SIZE;
        float cur[8], prv[8], mu[8];
        ld8(PL + row * 256 + eg * 8, cur);
        if (hasprev) ld8(PL + (row - 1) * 256 + eg * 8, prv); else {
#pragma unroll
            for (int i = 0; i < 8; ++i) prv[i] = 0.f; }
        { const f32x4 m0 = *(const f32x4*)(p.in[I_MUW] + eg * 8), m1 = *(const f32x4*)(p.in[I_MUW] + eg * 8 + 4);
          mu[0] = m0[0]; mu[1] = m0[1]; mu[2] = m0[2]; mu[3] = m0[3]; mu[4] = m1[0]; mu[5] = m1[1]; mu[6] = m1[2]; mu[7] = m1[3]; }
        u32x4 o;
#pragma unroll
        for (int i = 0; i < 4; ++i) { const float x0 = cur[2 * i] + mu[2 * i] * (prv[2 * i] - cur[2 * i]), x1 = cur[2 * i + 1] + mu[2 * i + 1] * (prv[2 * i + 1] - cur[2 * i + 1]); o[i] = pack2(tanhf(x0), tanhf(x1)); }
        *(LAS u32x4*)(lds + SC_AWD + et * SC_ASTR + eg * 16) = o;
        ld8(PL + row * 256 + 64 + eg * 8, cur);
        if (hasprev) ld8(PL + (row - 1) * 256 + 64 + eg * 8, prv);
        { const f32x4 m0 = *(const f32x4*)(p.in[I_MUA] + eg * 8), m1 = *(const f32x4*)(p.in[I_MUA] + eg * 8 + 4);
          mu[0] = m0[0]; mu[1] = m0[1]; mu[2] = m0[2]; mu[3] = m0[3]; mu[4] = m1[0]; mu[5] = m1[1]; mu[6] = m1[2]; mu[7] = m1[3]; }
#pragma unroll
        for (int i = 0; i < 4; ++i) { const float x0 = cur[2 * i] + mu[2 * i] * (prv[2 * i] - cur[2 * i]), x1 = cur[2 * i + 1] + mu[2 * i + 1] * (prv[2 * i + 1] - cur[2 * i + 1]); o[i] = pack2(x0, x1); }
        *(LAS u32x4*)(lds + SC_AAD + et * SC_ASTR + eg * 16) = o;
#pragma unroll
        for (int q = 0; q < 3; ++q) {
            ld8(PB + row * 4096 + q * 1024 + ec, cur);
            if (hasprev) ld8(PB + (row - 1) * 4096 + q * 1024 + ec, prv);
            const float* mup = p.in[I_MURKV] + q * 1024 + ec;
            const f32x4 m0 = *(const f32x4*)mup, m1 = *(const f32x4*)(mup + 4);
            mu[0] = m0[0]; mu[1] = m0[1]; mu[2] = m0[2]; mu[3] = m0[3]; mu[4] = m1[0]; mu[5] = m1[1]; mu[6] = m1[2]; mu[7] = m1[3];
            float x[8];
#pragma unroll
            for (int i = 0; i < 8; ++i) x[i] = cur[i] + mu[i] * (prv[i] - cur[i]);
            const int dsto = (q == 0 ? SB_R : (q == 1 ? SB_KP : SB_V)) + et * 256 + eg * 32;
            *(LAS f32x4*)(bb + dsto) = (f32x4){x[0], x[1], x[2], x[3]};
            *(LAS f32x4*)(bb + dsto + 16) = (f32x4){x[4], x[5], x[6], x[7]};
            if (q == 1) {
                const f32x4 k0 = *(const f32x4*)(p.in[I_KK] + ec), k1 = *(const f32x4*)(p.in[I_KK] + ec + 4);
                float kk[8]; float ss = 0.f;
#pragma unroll
                for (int i = 0; i < 8; ++i) { kk[i] = x[i] * (i < 4 ? k0[i] : k1[i - 4]); ss += kk[i] * kk[i]; }
                ss = reduce8(ss);
                const float rn = rsqrtf(fmaxf(ss, 1e-24f));
                *(LAS f32x4*)(bb + SB_KK + et * 256 + eg * 32) = (f32x4){kk[0] * rn, kk[1] * rn, kk[2] * rn, kk[3] * rn};
                *(LAS f32x4*)(bb + SB_KK + et * 256 + eg * 32 + 16) = (f32x4){kk[4] * rn, kk[5] * rn, kk[6] * rn, kk[7] * rn};
            }
        }
    };
    auto stepB = [&](int buf) {
        LAS unsigned char* bb = lds + buf * SB_SIZE;
        f32x16 acc;
#pragma unroll
        for (int i = 0; i < 16; ++i) acc[i] = 0.f;
        const int abase = (mat == 0 ? SC_AWD : SC_AAD) + mr * SC_ASTR + mh * 16;
#pragma unroll
        for (int s = 0; s < 4; ++s) { const bf16x8 a = *(const LAS bf16x8*)(lds + abase + s * 32); acc = MFMA32(a, Bf[s], acc); }
        const int jcol = tn * 32 + mr;
#pragma unroll
        for (int i = 0; i < 16; ++i) {
            const int t = crow(i, mh);
            if (mat == 0) {
                const float y = -(w0c + acc[i]);
                const float sp = fmaxf(y, 0.f) + log1pf(__expf(-fabsf(y)));
                const float w = -sp - 0.5f;
                *(LAS float*)(bb + SB_W + t * 256 + jcol * 4) = __expf(-__expf(w));
            } else {
                const float a = sigmoidf_(a0c + acc[i]);
                const float kl = *(LAS float*)(bb + SB_KP + t * 256 + jcol * 4);
                const float kk = *(LAS float*)(bb + SB_KK + t * 256 + jcol * 4);
                *(LAS float*)(bb + SB_KP + t * 256 + jcol * 4) = kl * (1.0f + (a - 1.0f) * kac);
                *(LAS float*)(bb + SB_BV + t * 256 + jcol * 4) = kk * a;
            }
        }
    };
    auto epi = [&](int ch, int buf) {
        const size_t row = (size_t)b * SEQ + ch * 32 + et;
        LAS unsigned char* bb = lds + buf * SB_SIZE;
        const f32x4 o0 = *(const LAS f32x4*)(bb + SB_O + et * 256 + eg * 32), o1 = *(const LAS f32x4*)(bb + SB_O + et * 256 + eg * 32 + 16);
        float o[8] = {o0[0], o0[1], o0[2], o0[3], o1[0], o1[1], o1[2], o1[3]};
        float sm = 0.f;
#pragma unroll
        for (int i = 0; i < 8; ++i) sm += o[i];
        const float mean = reduce8(sm) * (1.0f / 64.0f);
        float sv = 0.f;
#pragma unroll
        for (int i = 0; i < 8; ++i) { const float d = o[i] - mean; sv += d * d; }
        const float rstd = rsqrtf(reduce8(sv) * (1.0f / 64.0f) + 64e-5f);
        const f32x4 r0 = *(const LAS f32x4*)(bb + SB_R + et * 256 + eg * 32), r1 = *(const LAS f32x4*)(bb + SB_R + et * 256 + eg * 32 + 16);
        const f32x4 k0 = *(const LAS f32x4*)(bb + SB_KP + et * 256 + eg * 32), k1 = *(const LAS f32x4*)(bb + SB_KP + et * 256 + eg * 32 + 16);
        const f32x4 q0 = *(const f32x4*)(p.in[I_RK] + ec), q1 = *(const f32x4*)(p.in[I_RK] + ec + 4);
        float bs = r0[0] * k0[0] * q0[0] + r0[1] * k0[1] * q0[1] + r0[2] * k0[2] * q0[2] + r0[3] * k0[3] * q0[3]
                 + r1[0] * k1[0] * q1[0] + r1[1] * k1[1] * q1[1] + r1[2] * k1[2] * q1[2] + r1[3] * k1[3] * q1[3];
        bs = reduce8(bs);
        const f32x4 v0 = *(const LAS f32x4*)(bb + SB_V + et * 256 + eg * 32), v1 = *(const LAS f32x4*)(bb + SB_V + et * 256 + eg * 32 + 16);
        const f32x4 lw0 = *(const f32x4*)(p.in[I_LNW] + ec), lw1 = *(const f32x4*)(p.in[I_LNW] + ec + 4);
        const f32x4 lb0 = *(const f32x4*)(p.in[I_LNB] + ec), lb1 = *(const f32x4*)(p.in[I_LNB] + ec + 4);
        float z[8]; ld8(PB + row * 4096 + 3072 + ec, z);
        float y[8];
#pragma unroll
        for (int i = 0; i < 8; ++i) {
            const float lw = i < 4 ? lw0[i] : lw1[i - 4], lb = i < 4 ? lb0[i] : lb1[i - 4], vv = i < 4 ? v0[i] : v1[i - 4];
            y[i] = ((o[i] - mean) * rstd * lw + lb + bs * vv) * siluf_(z[i]);
        }
        u32x4 ov; ov[0] = pack2(y[0], y[1]); ov[1] = pack2(y[2], y[3]); ov[2] = pack2(y[4], y[5]); ov[3] = pack2(y[6], y[7]);
        *(u32x4*)(YB + row * 1024 + ec) = ov;
    };

    const int il = lane >> 3, jl = lane & 7, row0 = (wid & 3) * 16 + il * 2;
    f32x2 S0[4], S1[4];
#pragma unroll
    for (int q = 0; q < 4; ++q) { S0[q] = (f32x2){0.f, 0.f}; S1[q] = (f32x2){0.f, 0.f}; }

    if (helper) stepA(0, 0);
    __syncthreads();
    if (helper) stepB(0);
    __syncthreads();
    for (int ch = 0; ch < SEQ / 32; ++ch) {
        const int buf = ch & 1;
        const LAS unsigned char* bp = lds + buf * SB_SIZE + jl * 32;
        const LAS unsigned char* vp = lds + buf * SB_SIZE + SB_V + row0 * 4;
        LAS unsigned char* op = lds + buf * SB_SIZE + SB_O + row0 * 4;
#pragma unroll 1
        for (int half = 0; half < 2; ++half) {
            if (!helper) {
                ScanOps oa, ob;
                scan_load(oa, bp + half * 16 * 256, vp + half * 16 * 256);
#pragma unroll 1
                for (int t = half * 16; t < half * 16 + 16; t += 2) {
                    scan_load(ob, bp + (t + 1) * 256, vp + (t + 1) * 256);
                    scan_step(S0, S1, oa, op + t * 256, jl == 0);
                    scan_load(oa, bp + (t + 2) * 256, vp + (t + 2) * 256);
                    scan_step(S0, S1, ob, op + (t + 1) * 256, jl == 0);
                }
            } else if (half == 0) {
                if (ch > 0) epi(ch - 1, buf ^ 1);
                if (ch + 1 < SEQ / 32) stepA(ch + 1, buf ^ 1);
            } else {
                if (ch + 1 < SEQ / 32) stepB(buf ^ 1);
            }
            __syncthreads();
        }
    }
    if (helper) epi(SEQ / 32 - 1, 1);
    __syncthreads();
}

template <int HD> struct AttnCfg { static constexpr int KSTR = HD * 2 + 16, VSTR = 136, VROWS = HD, K_OFF = 0, V_OFF = 64 * KSTR, BIAS_OFF = V_OFF + VROWS * VSTR; };

template <int HD>
DI void attn_load_q(bf16x8 (&Qf)[HD / 16], const bf16_t* qrow, const float* g, float scale, int mh) {
    u32x4 raw[HD / 16]; float ss = 0.f;
#pragma unroll
    for (int s = 0; s < HD / 16; ++s) {
        raw[s] = *(const u32x4*)(qrow + 16 * s + 8 * mh);
#pragma unroll
        for (int i = 0; i < 4; ++i) { const float a = bflo(raw[s][i]), bb = bfhi(raw[s][i]); ss += a * a + bb * bb; }
    }
    ss += __shfl_xor(ss, 32);
    const float rstd = rsqrtf(ss * (1.0f / HD) + 1e-6f) * scale;
#pragma unroll
    for (int s = 0; s < HD / 16; ++s) {
        const f32x4 g0 = *(const f32x4*)(g + 16 * s + 8 * mh), g1 = *(const f32x4*)(g + 16 * s + 8 * mh + 4);
        u32x4 o;
        o[0] = pack2(bflo(raw[s][0]) * rstd * g0[0], bfhi(raw[s][0]) * rstd * g0[1]);
        o[1] = pack2(bflo(raw[s][1]) * rstd * g0[2], bfhi(raw[s][1]) * rstd * g0[3]);
        o[2] = pack2(bflo(raw[s][2]) * rstd * g1[0], bfhi(raw[s][2]) * rstd * g1[1]);
        o[3] = pack2(bflo(raw[s][3]) * rstd * g1[2], bfhi(raw[s][3]) * rstd * g1[3]);
        Qf[s] = __builtin_bit_cast(bf16x8, o);
    }
}
template <int HD>
DI void attn_load_k(LAS unsigned char* lds, const bf16_t* ksrc, size_t ldk, const float* gk, int tid) {
    constexpr int EPT = HD / 8;
    const int key = tid >> 3, part = tid & 7;
    const bf16_t* src = ksrc + (size_t)key * ldk + part * EPT;
    u32x4 raw[EPT / 8]; float ss = 0.f;
#pragma unroll
    for (int v = 0; v < EPT / 8; ++v) {
        raw[v] = *(const u32x4*)(src + v * 8);
#pragma unroll
        for (int i = 0; i < 4; ++i) { const float a = bflo(raw[v][i]), bb = bfhi(raw[v][i]); ss += a * a + bb * bb; }
    }
    ss = reduce8(ss);
    const float rstd = rsqrtf(ss * (1.0f / HD) + 1e-6f);
#pragma unroll
    for (int v = 0; v < EPT / 8; ++v) {
        const float* gp = gk + part * EPT + v * 8;
        const f32x4 g0 = *(const f32x4*)gp, g1 = *(const f32x4*)(gp + 4);
        u32x4 o;
        o[0] = pack2(bflo(raw[v][0]) * rstd * g0[0], bfhi(raw[v][0]) * rstd * g0[1]);
        o[1] = pack2(bflo(raw[v][1]) * rstd * g0[2], bfhi(raw[v][1]) * rstd * g0[3]);
        o[2] = pack2(bflo(raw[v][2]) * rstd * g1[0], bfhi(raw[v][2]) * rstd * g1[1]);
        o[3] = pack2(bflo(raw[v][3]) * rstd * g1[2], bfhi(raw[v][3]) * rstd * g1[3]);
        *(LAS u32x4*)(lds + AttnCfg<HD>::K_OFF + key * AttnCfg<HD>::KSTR + (part * EPT + v * 8) * 2) = o;
    }
}
template <int HD>
DI void attn_load_v(LAS unsigned char* lds, const bf16_t* vsrc, size_t ldv, int tid) {
    constexpr int TPR = 512 / HD, KPT = 64 / TPR;
    const int d = tid / TPR, part = tid % TPR;
    const bf16_t* src = vsrc + (size_t)d * ldv + part * KPT;
#pragma unroll
    for (int v = 0; v < KPT / 8; ++v) {
        const u32x4 raw = *(const u32x4*)(src + v * 8);
        LAS unsigned char* dp = lds + AttnCfg<HD>::V_OFF + d * AttnCfg<HD>::VSTR + (part * KPT + v * 8) * 2;
        *(LAS u32x2*)dp = (u32x2){raw[0], raw[1]};
        *(LAS u32x2*)(dp + 8) = (u32x2){raw[2], raw[3]};
    }
}
template <int HD, bool BIAS, bool QLDS>
DI void attn_chunk(const bf16x8 (&Qf)[HD / 16], const LAS unsigned char* qp, f32x16 (&O)[4], float& m_run, float& l_run, const LAS unsigned char* lds, int dbase, int mr, int mh, int qk_delta) {
#pragma unroll 1
    for (int kt = 0; kt < 2; ++kt) {
        f32x16 sc;
#pragma unroll
        for (int i = 0; i < 16; ++i) sc[i] = 0.f;
        const LAS unsigned char* kp = lds + AttnCfg<HD>::K_OFF + (kt * 32 + mr) * AttnCfg<HD>::KSTR + mh * 16;
#pragma unroll
        for (int s = 0; s < HD / 16; ++s) { if ((s & 3) == 0) __builtin_amdgcn_sched_barrier(0); const bf16x8 a = *(const LAS bf16x8*)(kp + s * 32); const bf16x8 qb = QLDS ? *(const LAS bf16x8*)(qp + s * 32) : Qf[s]; sc = MFMA32(a, qb, sc); }
        float mx = -1e30f;
#pragma unroll
        for (int i = 0; i < 16; ++i) {
            if (BIAS) {
                int dist = qk_delta + mr - (kt * 32 + crow(i, mh));
                dist = dist < -128 ? -128 : (dist > 128 ? 128 : dist);
                sc[i] += *(const LAS float*)(lds + AttnCfg<HD>::BIAS_OFF + (dist + 128) * 4);
            }
            mx = fmaxf(mx, sc[i]);
        }
        mx = fmaxf(mx, __shfl_xor(mx, 32));
        const float m_new = fmaxf(m_run, mx), alpha = __expf(m_run - m_new);
        float ls = 0.f;
#pragma unroll
        for (int i = 0; i < 16; ++i) { const float pv = __expf(sc[i] - m_new); sc[i] = pv; ls += pv; }
        l_run = l_run * alpha + ls; m_run = m_new;
#pragma unroll
        for (int dt = 0; dt < 4; ++dt)
#pragma unroll
            for (int i = 0; i < 16; ++i) O[dt][i] *= alpha;
#pragma unroll
        for (int s2 = 0; s2 < 2; ++s2) {
            u32x4 pk;
#pragma unroll
            for (int j = 0; j < 4; ++j) pk[j] = pack2(sc[8 * s2 + 2 * j], sc[8 * s2 + 2 * j + 1]);
            const bf16x8 pb = __builtin_bit_cast(bf16x8, pk);
#pragma unroll
            for (int dt = 0; dt < 4; ++dt) {
                const LAS unsigned char* vp = lds + AttnCfg<HD>::V_OFF + (dbase + dt * 32 + mr) * AttnCfg<HD>::VSTR + (kt * 32 + 16 * s2 + 4 * mh) * 2;
                const u32x2 lo = *(const LAS u32x2*)vp, hi = *(const LAS u32x2*)(vp + 16);
                const u32x4 va = {lo[0], lo[1], hi[0], hi[1]};
                O[dt] = MFMA32(__builtin_bit_cast(bf16x8, va), pb, O[dt]);
            }
        }
    }
}
DI void attn_store(const f32x16 (&O)[4], float l_run, const bf16_t* zrow, bf16_t* yrow, int mh) {
    const float lt = l_run + __shfl_xor(l_run, 32);
    const float inv = 1.0f / lt;
#pragma unroll
    for (int dt = 0; dt < 4; ++dt)
#pragma unroll
        for (int g = 0; g < 4; ++g) {
            const int d = dt * 32 + 8 * g + 4 * mh;
            const u32x2 zz = *(const u32x2*)(zrow + d);
            u32x2 o;
            o[0] = pack2(O[dt][4 * g] * inv * siluf_(bflo(zz[0])), O[dt][4 * g + 1] * inv * siluf_(bfhi(zz[0])));
            o[1] = pack2(O[dt][4 * g + 2] * inv * siluf_(bflo(zz[1])), O[dt][4 * g + 3] * inv * siluf_(bfhi(zz[1])));
            *(u32x2*)(yrow + d) = o;
        }
}

DI void attnA_item(const Params& p, unsigned char* smem, int item) {
    const int b = item >> 6, head = (item >> 3) & 7, cgp = item & 7;
    int tid = threadIdx.x; asm volatile("" : "+v"(tid));
    const int wid = tid >> 6, lane = tid & 63, mr = lane & 31, mh = lane >> 5;
    LAS unsigned char* lds = (LAS unsigned char*)smem;
    const bf16_t* PA = (const bf16_t*)(p.ws + OFF_PA);
    const bf16_t* VT = (const bf16_t*)(p.ws + OFF_VT);
    bf16_t* YA = (bf16_t*)((char*)p.out + OFF_YA);
    const int cw = cgp * 4 + (wid >> 1), qt = wid & 1;
    const size_t qrow = (size_t)b * SEQ + cw * 64 + qt * 32 + mr;
    if (tid < 257) *(LAS float*)(lds + AttnCfg<128>::BIAS_OFF + tid * 4) = p.in[I_RELB][head * 257 + tid];
    bf16x8 Qf[8];
    attn_load_q<128>(Qf, PA + qrow * 3072 + head * 128, p.in[I_AQG], 0.08838834764831845f, mh);
    f32x16 O[4];
#pragma unroll
    for (int dt = 0; dt < 4; ++dt)
#pragma unroll
        for (int i = 0; i < 16; ++i) O[dt][i] = 0.f;
    float m_run = -1e30f, l_run = 0.f;
    for (int kc = cgp * 4 - 8; kc <= cgp * 4 + 3; ++kc) {
        if (kc < 0) continue;
        __syncthreads();
        attn_load_k<128>(lds, PA + ((size_t)b * SEQ + kc * 64) * 3072 + 1024 + head * 128, 3072, p.in[I_AKG], tid);
        attn_load_v<128>(lds, VT + (size_t)(head * 128) * T_TOK + (size_t)b * SEQ + kc * 64, T_TOK, tid);
        __syncthreads();
        if (kc >= cw - 8 && kc <= cw)
            attn_chunk<128, true, false>(Qf, lds, O, m_run, l_run, lds, 0, mr, mh, (cw - kc) * 64 + qt * 32);
    }
    attn_store(O, l_run, PA + qrow * 3072 + 2048 + head * 128, YA + qrow * 1024 + head * 128, mh);
    __syncthreads();
}
DI void attnC_item(const Params& p, unsigned char* smem, int item) {
    const int b = item >> 6, hc = (item >> 4) & 3, qg = item & 15;
    int tid = threadIdx.x; asm volatile("" : "+v"(tid));
    const int wid = tid >> 6, lane = tid & 63, mr = lane & 31, mh = lane >> 5;
    LAS unsigned char* lds = (LAS unsigned char*)smem;
    const bf16_t* PC = (const bf16_t*)(p.ws + OFF_PC);
    const bf16_t* MK = (const bf16_t*)(p.ws + OFF_MK);
    const bf16_t* MVT = (const bf16_t*)(p.ws + OFF_MVT);
    bf16_t* YC = (bf16_t*)((char*)p.out + OFF_YC);
    const int qt = wid >> 1, dh = wid & 1;
    const size_t qrow = (size_t)b * SEQ + qg * 128 + qt * 32 + mr;
    constexpr int Q_OFF = AttnCfg<256>::V_OFF + 256 * AttnCfg<256>::VSTR;
    __syncthreads();
    {
        bf16x8 Qf[16];
        attn_load_q<256>(Qf, PC + qrow * 2048 + hc * 256, p.in[I_CQG], 0.0625f, mh);
        if (dh == 0) {
#pragma unroll
            for (int s = 0; s < 16; ++s) *(LAS bf16x8*)(lds + Q_OFF + (qt * 32 + mr) * 528 + s * 32 + mh * 16) = Qf[s];
        }
    }
    const LAS unsigned char* qp = lds + Q_OFF + (qt * 32 + mr) * 528 + mh * 16;
    bf16x8 Qd[16];
    f32x16 O[4];
#pragma unroll
    for (int dt = 0; dt < 4; ++dt)
#pragma unroll
        for (int i = 0; i < 16; ++i) O[dt][i] = 0.f;
    float m_run = -1e30f, l_run = 0.f;
    for (int kc = 0; kc < 4; ++kc) {
        __syncthreads();
        attn_load_k<256>(lds, MK + ((size_t)b * NMEM + kc * 64) * 1024 + hc * 256, 1024, p.in[I_CKG], tid);
        attn_load_v<256>(lds, MVT + (size_t)(hc * 256) * 2048 + (size_t)b * NMEM + kc * 64, 2048, tid);
        __syncthreads();
        attn_chunk<256, false, true>(Qd, qp, O, m_run, l_run, lds, dh * 128, mr, mh, 0);
    }
    attn_store(O, l_run, PC + qrow * 2048 + 1024 + hc * 256 + dh * 128, YC + qrow * 1024 + hc * 256 + dh * 128, mh);
    __syncthreads();
}
DI void phase2(const Params& p, unsigned char* smem) {
    const int c = blockIdx.x;
    if (c < 128) scan_item(p, smem, c);
    for (int it = c + p.G; it < 128 && c < 128; it += p.G) scan_item(p, smem, it);
    unsigned* ctr = (unsigned*)(p.ws + OFF_CTR);
    LAS int* sitem = (LAS int*)((LAS unsigned char*)smem + LDS_BYTES - 16);
    auto fetch = [&]() -> int {
        __syncthreads();
        if (threadIdx.x == 0) *sitem = (int)atomicAdd(ctr, 1u);
        __syncthreads();
        return *sitem;
    };
    int item = fetch();
    while (item < 512) { attnA_item(p, smem, item); item = fetch(); }
    while (item < 1024) { attnC_item(p, smem, item - 512); item = fetch(); }
}

__global__ void __launch_bounds__(NTHREADS) hybrid_fwd(Params p) {
    extern __shared__ __attribute__((aligned(16))) unsigned char smem[];
    cg::grid_group grid = cg::this_grid();
#ifndef PHMASK
#define PHMASK 31
#endif
    if (PHMASK & 1) phase0(p, smem);
    grid.sync();
    if (PHMASK & 2) gemm_phase<1>((LAS unsigned char*)smem, p);
    grid.sync();
    if (PHMASK & 4) phase2(p, smem);
    grid.sync();
    if (PHMASK & 8) gemm_phase<3>((LAS unsigned char*)smem, p);
    grid.sync();
    if (PHMASK & 16) gemm_phase<4>((LAS unsigned char*)smem, p);
}

extern "C" void kernel_launch(void* const* d_in, const int* in_sizes, int n_in, void* d_out, int out_size, void* d_ws, size_t ws_size, hipStream_t stream) {
    static int grid_blocks = 0;
    if (grid_blocks == 0) {
        if (n_in != 27 || ws_size < WS_END || out_size != T_TOK * DM) { fprintf(stderr, "kernel_launch: unexpected shapes (n_in %d ws %zu out %d)\n", n_in, ws_size, out_size); grid_blocks = -1; return; }
        int dev = 0, cus = 0, per_cu = 0;
        hipGetDevice(&dev);
        hipDeviceGetAttribute(&cus, hipDeviceAttributeMultiprocessorCount, dev);
        if (hipFuncSetAttribute((const void*)hybrid_fwd, hipFuncAttributeMaxDynamicSharedMemorySize, LDS_BYTES) != hipSuccess) { fprintf(stderr, "kernel_launch: hipFuncSetAttribute failed\n"); grid_blocks = -1; return; }
        if (hipOccupancyMaxActiveBlocksPerMultiprocessor(&per_cu, (const void*)hybrid_fwd, NTHREADS, LDS_BYTES) != hipSuccess || per_cu < 1) { fprintf(stderr, "kernel_launch: occupancy query failed (%d)\n", per_cu); grid_blocks = -1; return; }
        grid_blocks = cus * 1;
    }
    if (grid_blocks < 0) return;
    Params p{};
    for (int i = 0; i < 27; ++i) p.in[i] = (const float*)d_in[i];
    p.out = (float*)d_out; p.ws = (unsigned char*)d_ws; p.G = grid_blocks; p.pad = 0;
    void* args[] = {&p};
    hipError_t e = hipLaunchCooperativeKernel((const void*)hybrid_fwd, dim3(grid_blocks), dim3(NTHREADS), args, LDS_BYTES, stream);
    if (e != hipSuccess) fprintf(stderr, "cooperative launch failed: %s (grid %d)\n", hipGetErrorString(e), grid_blocks);
}
```

```cpp
#include <hip/hip_runtime.h>
#include <hip/hip_cooperative_groups.h>
#include <cstdio>
namespace cg = cooperative_groups;

#define DI __device__ __forceinline__
#define LAS __attribute__((address_space(3)))
typedef unsigned short bf16_t;
typedef short bf16x8 __attribute__((ext_vector_type(8)));
typedef float f32x2 __attribute__((ext_vector_type(2)));
typedef float f32x4 __attribute__((ext_vector_type(4)));
typedef float f32x16 __attribute__((ext_vector_type(16)));
typedef unsigned u32x2 __attribute__((ext_vector_type(2)));
typedef unsigned u32x4 __attribute__((ext_vector_type(4)));
typedef __bf16 bf16v2 __attribute__((ext_vector_type(2)));

constexpr int T_TOK = 16384, DM = 2048, SEQ = 2048, NB = 8, NMEM = 256;
constexpr int INC = 16512;
constexpr int NTHREADS = 512;
constexpr int LDS_BYTES = 139264;

constexpr size_t SZ_WT = (size_t)INC * DM * 2;
constexpr size_t OFF_WT = 0;
constexpr size_t OFF_WMEM = OFF_WT + SZ_WT;
constexpr size_t OFF_WUA = OFF_WMEM + (size_t)2048 * 2048 * 2;
constexpr size_t OFF_WUB = OFF_WUA + (size_t)2048 * 1024 * 2;
constexpr size_t OFF_WUC = OFF_WUB + (size_t)2048 * 1024 * 2;
constexpr size_t OFF_WO = OFF_WUC + (size_t)2048 * 1024 * 2;
constexpr size_t OFF_H = OFF_WO + (size_t)2048 * 2048 * 2;
constexpr size_t OFF_M = OFF_H + (size_t)T_TOK * 2048 * 2;
constexpr size_t OFF_PA = OFF_M + (size_t)2048 * 2048 * 2;
constexpr size_t OFF_PB = OFF_PA + (size_t)T_TOK * 3072 * 2;
constexpr size_t OFF_PL = OFF_PB + (size_t)T_TOK * 4096 * 2;
constexpr size_t OFF_PC = OFF_PL + (size_t)T_TOK * 256 * 2;
constexpr size_t OFF_VT = OFF_PC + (size_t)T_TOK * 2048 * 2;
constexpr size_t OFF_MK = OFF_VT + (size_t)1024 * T_TOK * 2;
constexpr size_t OFF_MVT = OFF_MK + (size_t)2048 * 1024 * 2;
constexpr size_t OFF_CTR = OFF_MVT + (size_t)1024 * 2048 * 2;
constexpr size_t WS_END = OFF_CTR + 256;
constexpr size_t OFF_MERGED = OFF_PA;
constexpr size_t OFF_SCR = OFF_PB;
constexpr size_t SCR_PER_WG = 2 * 131072;
constexpr size_t OFF_YA = 0, OFF_YB = (size_t)T_TOK * 1024 * 2, OFF_YC = 2 * OFF_YB;

struct Params {
    const float* in[27];
    float* out;
    unsigned char* ws;
    int G; int pad;
};
enum { I_X = 0, I_MEM, I_NORMG, I_WIN, I_AQG, I_AKG, I_RELB, I_WUPA, I_MURKV, I_MUW, I_MUA, I_W0, I_W2, I_A0, I_A2, I_KK, I_KA, I_RK, I_LNW, I_LNB, I_WUPB,
       I_MEMG, I_WMEMKV, I_CQG, I_CKG, I_WUPC, I_WO };

DI unsigned pack2(float lo, float hi) { f32x2 v = {lo, hi}; bf16v2 b = __builtin_convertvector(v, bf16v2); return __builtin_bit_cast(unsigned, b); }
DI float bflo(unsigned u) { return __uint_as_float(u << 16); }
DI float bfhi(unsigned u) { return __uint_as_float(u & 0xffff0000u); }
DI float sigmoidf_(float x) { return __builtin_amdgcn_rcpf(1.0f + __expf(-x)); }
DI float siluf_(float x) { return x * sigmoidf_(x); }
DI float wave_sum(float v) {
#pragma unroll
    for (int o = 32; o > 0; o >>= 1) v += __shfl_xor(v, o);
    return v;
}
template <int CTRL> DI float dpp_mov(float x) { return __int_as_float(__builtin_amdgcn_update_dpp(0, __float_as_int(x), CTRL, 0xf, 0xf, false)); }
DI float reduce8(float x) {
    x += dpp_mov<0xB1>(x);
    x += dpp_mov<0x4E>(x);
    x += dpp_mov<0x141>(x);
    return x;
}
DI int crow(int i, int h) { return (i & 3) + 8 * (i >> 2) + 4 * h; }
#define MFMA32(a, b, c) __builtin_amdgcn_mfma_f32_32x32x16_bf16((a), (b), (c), 0, 0, 0)

DI void transpose_tile(const float* __restrict__ src, bf16_t* __restrict__ dst, int R, int C, int tr, int tc, float* lds) {
    const int tid = threadIdx.x;
    const int r = tid >> 3, cs = (tid & 7) * 8;
    const float* sp = src + (size_t)(tr * 64 + r) * C + tc * 64 + cs;
    f32x4 v0 = *(const f32x4*)sp, v1 = *(const f32x4*)(sp + 4);
    float* lp = lds + r * 65 + cs;
    lp[0] = v0[0]; lp[1] = v0[1]; lp[2] = v0[2]; lp[3] = v0[3]; lp[4] = v1[0]; lp[5] = v1[1]; lp[6] = v1[2]; lp[7] = v1[3];
    __syncthreads();
    const int c = tid >> 3, ks = (tid & 7) * 8;
    u32x4 o;
    o[0] = pack2(lds[(ks + 0) * 65 + c], lds[(ks + 1) * 65 + c]);
    o[1] = pack2(lds[(ks + 2) * 65 + c], lds[(ks + 3) * 65 + c]);
    o[2] = pack2(lds[(ks + 4) * 65 + c], lds[(ks + 5) * 65 + c]);
    o[3] = pack2(lds[(ks + 6) * 65 + c], lds[(ks + 7) * 65 + c]);
    *(u32x4*)(dst + (size_t)(tc * 64 + c) * R + tr * 64 + ks) = o;
    __syncthreads();
}
DI void rmsnorm_row2048(const float* __restrict__ x, const float* __restrict__ g, bf16_t* __restrict__ out, int lane) {
    f32x4 v[8]; float ss = 0.f;
#pragma unroll
    for (int i = 0; i < 8; ++i) { v[i] = ((const f32x4*)x)[i * 64 + lane]; ss += v[i][0] * v[i][0] + v[i][1] * v[i][1] + v[i][2] * v[i][2] + v[i][3] * v[i][3]; }
    ss = wave_sum(ss);
    const float rstd = rsqrtf(ss * (1.0f / 2048.0f) + 1e-6f);
#pragma unroll
    for (int i = 0; i < 8; ++i) {
        const f32x4 g4 = ((const f32x4*)g)[i * 64 + lane];
        u32x2 o; o[0] = pack2(v[i][0] * rstd * g4[0], v[i][1] * rstd * g4[1]); o[1] = pack2(v[i][2] * rstd * g4[2], v[i][3] * rstd * g4[3]);
        ((u32x2*)out)[i * 64 + lane] = o;
    }
}
DI void phase0(const Params& p, unsigned char* smem) {
    float* lds = (float*)smem;
    const int G = p.G, c = blockIdx.x;
    if (c == 0 && threadIdx.x == 0) *(unsigned*)(p.ws + OFF_CTR) = 0u;
    constexpr int N_WIN = 32 * 258, N_SQ = 32 * 32, N_UP = 16 * 32;
    constexpr int NTR = N_WIN + N_SQ + 3 * N_UP + N_SQ;
    for (int u = c; u < NTR; u += G) {
        int l = u;
        if (l < N_WIN) { transpose_tile(p.in[I_WIN], (bf16_t*)(p.ws + OFF_WT), 2048, INC, l & 31, l >> 5, lds); continue; }
        l -= N_WIN;
        if (l < N_SQ) { transpose_tile(p.in[I_WMEMKV], (bf16_t*)(p.ws + OFF_WMEM), 2048, 2048, l & 31, l >> 5, lds); continue; }
        l -= N_SQ;
        if (l < 3 * N_UP) {
            const int w = l / N_UP; l -= w * N_UP;
            const float* src = w == 0 ? p.in[I_WUPA] : (w == 1 ? p.in[I_WUPB] : p.in[I_WUPC]);
            bf16_t* dst = (bf16_t*)(p.ws + (w == 0 ? OFF_WUA : (w == 1 ? OFF_WUB : OFF_WUC)));
            transpose_tile(src, dst, 1024, 2048, l & 15, l >> 4, lds); continue;
        }
        l -= 3 * N_UP;
        transpose_tile(p.in[I_WO], (bf16_t*)(p.ws + OFF_WO), 2048, 2048, l & 31, l >> 5, lds);
    }
    const int wid = threadIdx.x >> 6, lane = threadIdx.x & 63;
    for (int rg = c; rg < (T_TOK + 2048) / 8; rg += G) {
        const int row = rg * 8 + wid;
        if (row < T_TOK) rmsnorm_row2048(p.in[I_X] + (size_t)row * 2048, p.in[I_NORMG], (bf16_t*)(p.ws + OFF_H) + (size_t)row * 2048, lane);
        else rmsnorm_row2048(p.in[I_MEM] + (size_t)(row - T_TOK) * 2048, p.in[I_MEMG], (bf16_t*)(p.ws + OFF_M) + (size_t)(row - T_TOK) * 2048, lane);
    }
}

constexpr int BM = 256, BK = 64, HALF = 128, HTB = HALF * BK * 2;
DI int lds_byte(int r, int c) { const int st = (r >> 4) * 2 + (c >> 5), rr = r & 15, cc = c & 31, ob = rr * 64 + cc * 2; return st * 1024 + (ob ^ (((ob >> 9) & 1) << 5)); }
DI void stage_rc(int b, int& R, int& C) { const int st = b / 1024, sb = b % 1024, swz = sb ^ (((sb >> 9) & 1) << 5); R = (st >> 1) * 16 + swz / 64; C = (st & 1) * 32 + (swz % 64) / 2; }

enum { EPI_BF16 = 0, EPI_UP = 1, EPI_GATE = 2, EPI_OUT = 4 };
struct Unit { const char* A; const char* B; char* C; int K; int ldc; int kind; int aux; const float* X; };

DI void epilogue(const f32x4 (&acc)[2][2][4][2], const Unit& u, int wr, int wc, int fr, int fq, int tid, char* scr) {
    if (u.kind == EPI_BF16) {
#pragma unroll
        for (int ai = 0; ai < 2; ++ai)
#pragma unroll
            for (int m = 0; m < 4; ++m) {
                bf16_t* rowp = (bf16_t*)u.C + (size_t)(ai * 128 + wr * 64 + m * 16 + fr) * u.ldc + wc * 32 + 4 * fq;
#pragma unroll
                for (int bj = 0; bj < 2; ++bj)
#pragma unroll
                    for (int n = 0; n < 2; ++n) {
                        const f32x4 a = acc[ai][bj][m][n]; u32x2 o; o[0] = pack2(a[0], a[1]); o[1] = pack2(a[2], a[3]);
                        *(u32x2*)(rowp + bj * 128 + n * 16) = o;
                    }
            }
    } else if (u.kind == EPI_OUT) {
#pragma unroll
        for (int ai = 0; ai < 2; ++ai)
#pragma unroll
            for (int m = 0; m < 4; ++m) {
                const size_t ro = (size_t)(ai * 128 + wr * 64 + m * 16 + fr) * 2048 + wc * 32 + 4 * fq;
#pragma unroll
                for (int bj = 0; bj < 2; ++bj)
#pragma unroll
                    for (int n = 0; n < 2; ++n) {
                        const f32x4 xv = *(const f32x4*)(u.X + ro + bj * 128 + n * 16);
                        *(f32x4*)((float*)u.C + ro + bj * 128 + n * 16) = acc[ai][bj][m][n] + xv;
                    }
            }
    } else if (u.kind == EPI_UP) {
        u32x2* sp = (u32x2*)scr + tid;
#pragma unroll
        for (int ai = 0; ai < 2; ++ai)
#pragma unroll
            for (int m = 0; m < 4; ++m) {
                asm volatile("" : "+v"(sp) : : "memory");
#pragma unroll
                for (int bj = 0; bj < 2; ++bj)
#pragma unroll
                    for (int n = 0; n < 2; ++n) {
                        const f32x4 a = acc[ai][bj][m][n];
                        u32x2 o; o[0] = pack2(a[0], a[1]); o[1] = pack2(a[2], a[3]);
                        sp[(bj * 2 + n) * 512] = o;
                    }
                sp += 4 * 512;
            }
    } else {
        u32x2* sp = (u32x2*)scr + tid;
        const int mode = u.aux;
#pragma unroll
        for (int ai = 0; ai < 2; ++ai)
#pragma unroll
            for (int m = 0; m < 4; ++m) {
                asm volatile("" : "+v"(sp) : : "memory");
                __builtin_amdgcn_sched_barrier(0);
                bf16_t* rowp = (bf16_t*)u.C + (size_t)(ai * 128 + wr * 64 + m * 16 + fr) * u.ldc + wc * 32 + 4 * fq;
#pragma unroll
                for (int bj = 0; bj < 2; ++bj)
#pragma unroll
                    for (int n = 0; n < 2; ++n) {
                        const int idx = (bj * 2 + n) * 512;
                        const u32x2 uu = sp[idx];
                        u32x2 mm = {0u, 0u};
                        if (mode != 0) mm = sp[idx + 16384];
                        const f32x4 a = acc[ai][bj][m][n];
                        const float r0 = bflo(mm[0]) + sigmoidf_(a[0]) * bflo(uu[0]);
                        const float r1 = bfhi(mm[0]) + sigmoidf_(a[1]) * bfhi(uu[0]);
                        const float r2 = bflo(mm[1]) + sigmoidf_(a[2]) * bflo(uu[1]);
                        const float r3 = bfhi(mm[1]) + sigmoidf_(a[3]) * bfhi(uu[1]);
                        u32x2 o; o[0] = pack2(r0, r1); o[1] = pack2(r2, r3);
                        if (mode == 2) *(u32x2*)(rowp + bj * 128 + n * 16) = o; else sp[idx + 16384] = o;
                    }
                sp += 4 * 512;
            }
    }
}

DI bool p1_unit(const Params& p, int L, Unit& u) {
    if (L >= 2688) return false;
    u.K = 2048; u.kind = EPI_BF16; u.aux = 0; u.X = nullptr;
    const char* ws = (const char*)p.ws;
    if (L < 2368) {
        const int gid = L / 296, rem = L - gid * 296, pm = gid * 8 + (rem & 7), ct = rem >> 3;
        int brow, col, ldc; size_t cb;
        if (ct < 8) { brow = ct * 256; cb = OFF_PA; col = ct * 256; ldc = 3072; }
        else if (ct < 12) { brow = 3072 + (ct - 8) * 256; cb = OFF_PA; col = 2048 + (ct - 8) * 256; ldc = 3072; }
        else if (ct < 28) { brow = 4096 + (ct - 12) * 256; cb = OFF_PB; col = (ct - 12) * 256; ldc = 4096; }
        else if (ct == 28) { brow = 8192; cb = OFF_PL; col = 0; ldc = 256; }
        else { brow = 8320 + (ct - 29) * 256; cb = OFF_PC; col = (ct - 29) * 256; ldc = 2048; }
        u.A = ws + OFF_H + (size_t)pm * 256 * 4096; u.B = ws + OFF_WT + (size_t)brow * 4096;
        u.C = (char*)p.ws + cb + ((size_t)pm * 256 * ldc + col) * 2; u.ldc = ldc;
    } else if (L < 2624) {
        const int l = L - 2368, pm = l & 3, pn = l >> 2;
        u.A = ws + OFF_WT + (size_t)(2048 + pm * 256) * 4096; u.B = ws + OFF_H + (size_t)pn * 256 * 4096;
        u.C = (char*)p.ws + OFF_VT + ((size_t)pm * 256 * T_TOK + pn * 256) * 2; u.ldc = T_TOK;
    } else if (L < 2656) {
        const int l = L - 2624, pm = l & 7, pn = l >> 3;
        u.A = ws + OFF_M + (size_t)pm * 256 * 4096; u.B = ws + OFF_WMEM + (size_t)pn * 256 * 4096;
        u.C = (char*)p.ws + OFF_MK + ((size_t)pm * 256 * 1024 + pn * 256) * 2; u.ldc = 1024;
    } else {
        const int l = L - 2656, pm = l & 3, pn = l >> 2;
        u.A = ws + OFF_WMEM + (size_t)(1024 + pm * 256) * 4096; u.B = ws + OFF_M + (size_t)pn * 256 * 4096;
        u.C = (char*)p.ws + OFF_MVT + ((size_t)pm * 256 * 2048 + pn * 256) * 2; u.ldc = 2048;
    }
    return true;
}
DI void tile_pmpn(int tl, int& pm, int& pn) { pm = (tl & 7) + 8 * (tl >> 6); pn = (tl >> 3) & 7; }
DI bool p3_unit(const Params& p, int cp, int ui, Unit& u) {
    const int ti = ui / 6, sub = ui - ti * 6, tl = cp + p.G * ti;
    if (tl >= 512) return false;
    int pm, pn; tile_pmpn(tl, pm, pn);
    const char* ws = (const char*)p.ws; const char* yo = (const char*)p.out;
    u.X = nullptr; u.ldc = 2048;
    u.C = (char*)p.ws + OFF_MERGED + ((size_t)pm * 256 * 2048 + pn * 256) * 2;
    const int x = sub >> 1;
    if ((sub & 1) == 0) {
        u.K = 1024; u.kind = EPI_UP; u.aux = 0;
        u.A = yo + (size_t)x * OFF_YB + (size_t)pm * 256 * 2048;
        u.B = ws + (x == 0 ? OFF_WUA : (x == 1 ? OFF_WUB : OFF_WUC)) + (size_t)pn * 256 * 2048;
    } else {
        u.K = 2048; u.kind = EPI_GATE; u.aux = x;
        u.A = ws + OFF_H + (size_t)pm * 256 * 4096;
        u.B = ws + OFF_WT + (size_t)(10368 + 2048 * x + 256 * pn) * 4096;
    }
    return true;
}
DI bool p4_unit(const Params& p, int cp, int ui, Unit& u) {
    const int tl = cp + p.G * ui;
    if (tl >= 512) return false;
    int pm, pn; tile_pmpn(tl, pm, pn);
    const char* ws = (const char*)p.ws;
    u.K = 2048; u.kind = EPI_OUT; u.aux = 0; u.ldc = 2048;
    u.A = ws + OFF_MERGED + (size_t)pm * 256 * 4096; u.B = ws + OFF_WO + (size_t)pn * 256 * 4096;
    u.C = (char*)(p.out + (size_t)pm * 256 * 2048 + pn * 256);
    u.X = p.in[I_X] + (size_t)pm * 256 * 2048 + pn * 256;
    return true;
}
template <int PH> DI bool get_unit(const Params& p, int cp, int ui, Unit& u) {
    if (PH == 1) return p1_unit(p, ui * p.G + cp, u);
    if (PH == 3) return p3_unit(p, cp, ui, u);
    return p4_unit(p, cp, ui, u);
}

template <int PH>
DI void gemm_phase(LAS unsigned char* lds, const Params& p) {
    int tid = threadIdx.x; asm volatile("" : "+v"(tid));
    const int wid = __builtin_amdgcn_readfirstlane(tid >> 6), lane = tid & 63, wr = wid >> 2, wc = wid & 3, fr = lane & 15, fq = lane >> 4;
    const int c = blockIdx.x, cp = (p.G & 7) == 0 ? (c & 7) * (p.G >> 3) + (c >> 3) : c;
    char* scr = (char*)p.ws + OFF_SCR + (size_t)c * SCR_PER_WG;
    int sR[2], sC[2];
#pragma unroll
    for (int i = 0; i < 2; ++i) stage_rc(tid * 16 + i * 8192, sR[i], sC[i]);
    const unsigned ldsw = (unsigned)wid * 1024u;
    const int aoff = lds_byte(wr * 64 + fr, fq * 8), boff = lds_byte(wc * 32 + fr, fq * 8);
#define G_SA(b, h) (((b) * 2 + (h)) * HTB)
#define G_SB(b, h) ((4 + (b) * 2 + (h)) * HTB)
#define G_STAGE(bufoff, gbase, KK) do { _Pragma("unroll") for (int _i = 0; _i < 2; ++_i) \
        __builtin_amdgcn_global_load_lds((const unsigned*)((gbase) + (size_t)(unsigned)((sR[_i] * (KK) + sC[_i]) * 2)), (LAS unsigned*)(lds + (bufoff) + ldsw + _i * 8192), 16, 0, 0); } while (0)
#define G_LDA(dst, b, h) do { _Pragma("unroll") for (int m = 0; m < 4; ++m) _Pragma("unroll") for (int k = 0; k < 2; ++k) dst[m][k] = *(const LAS bf16x8*)(lds + G_SA(b, h) + aoff + m * 2048 + k * 1024); } while (0)
#define G_LDB(dst, b, h) do { _Pragma("unroll") for (int n = 0; n < 2; ++n) _Pragma("unroll") for (int k = 0; k < 2; ++k) dst[n][k] = *(const LAS bf16x8*)(lds + G_SB(b, h) + boff + n * 2048 + k * 1024); } while (0)
#define G_MMA(ai, bj, At, Bt) do { __builtin_amdgcn_s_setprio(1); _Pragma("unroll") for (int m = 0; m < 4; ++m) _Pragma("unroll") for (int n = 0; n < 2; ++n) _Pragma("unroll") for (int k = 0; k < 2; ++k) \
        acc[ai][bj][m][n] = __builtin_amdgcn_mfma_f32_16x16x32_bf16(Bt[n][k], At[m][k], acc[ai][bj][m][n], 0, 0, 0); __builtin_amdgcn_s_setprio(0); } while (0)
#define G_WAIT_V(n) asm volatile("s_waitcnt vmcnt(" #n ")" ::: "memory")
#define G_WAIT_L(n) asm volatile("s_waitcnt lgkmcnt(" #n ")" ::: "memory")
#define G_BAR __builtin_amdgcn_s_barrier()
#define G_SCHED __builtin_amdgcn_sched_barrier(0)
    Unit cur, nxt; int ui = 0;
    if (!get_unit<PH>(p, cp, 0, cur)) return;
    f32x4 acc[2][2][4][2];
#pragma unroll
    for (int a = 0; a < 2; ++a)
#pragma unroll
        for (int b = 0; b < 2; ++b)
#pragma unroll
            for (int m = 0; m < 4; ++m)
#pragma unroll
                for (int n = 0; n < 2; ++n) acc[a][b][m][n] = (f32x4){0.f, 0.f, 0.f, 0.f};
    bf16x8 At[4][2], B0[2][2], B1[2][2];
    const char* cA = cur.A; const char* cB = cur.B; int Kc = cur.K;
    {
        const size_t hs = (size_t)HALF * Kc * 2;
        G_STAGE(G_SB(0, 0), cB, Kc); G_STAGE(G_SA(0, 0), cA, Kc); G_STAGE(G_SB(0, 1), cB + hs, Kc); G_STAGE(G_SA(0, 1), cA + hs, Kc);
        if (wr == 1) G_BAR;
        G_WAIT_V(4); G_BAR;
        G_STAGE(G_SB(1, 0), cB + 128, Kc); G_STAGE(G_SA(1, 0), cA + 128, Kc); G_STAGE(G_SB(1, 1), cB + hs + 128, Kc);
        G_WAIT_V(6); G_BAR;
    }
    for (;;) {
        const bool has_next = get_unit<PH>(p, cp, ui + 1, nxt);
        const char* nA = has_next ? nxt.A : cA; const char* nB = has_next ? nxt.B : cB; const int Kn = has_next ? nxt.K : Kc;
        const int nt = Kc / BK;
        const size_t hsc = (size_t)HALF * Kc * 2;
        for (int t = 0; t < nt; t += 2) {
            const bool last = (t == nt - 2);
            const char* a1 = cA + (size_t)(t + 1) * 128;
            const int K2 = last ? Kn : Kc;
            const size_t hs2 = (size_t)HALF * K2 * 2;
            const char* a2 = last ? nA : cA + (size_t)(t + 2) * 128; const char* b2 = last ? nB : cB + (size_t)(t + 2) * 128;
            const char* a3 = a2 + 128; const char* b3 = b2 + 128;
            G_LDB(B0, 0, 0); G_SCHED; G_LDA(At, 0, 0); G_STAGE(G_SA(1, 1), a1 + hsc, Kc);
            G_WAIT_L(8); G_BAR; G_WAIT_L(0); G_MMA(0, 0, At, B0); G_BAR; G_SCHED;
            G_LDB(B1, 0, 1); G_STAGE(G_SB(0, 0), b2, K2);
            G_BAR; G_WAIT_L(0); G_MMA(0, 1, At, B1); G_BAR;
            G_LDA(At, 0, 1); G_STAGE(G_SA(0, 0), a2, K2);
            G_BAR; G_WAIT_L(0); G_MMA(1, 0, At, B0); G_BAR; G_SCHED;
            G_STAGE(G_SB(0, 1), b2 + hs2, K2);
            G_WAIT_V(6); G_BAR; G_MMA(1, 1, At, B1); G_BAR;
            G_LDB(B0, 1, 0); G_SCHED; G_LDA(At, 1, 0); G_STAGE(G_SA(0, 1), a2 + hs2, K2);
            G_WAIT_L(8); G_BAR; G_WAIT_L(0); G_MMA(0, 0, At, B0); G_BAR; G_SCHED;
            G_LDB(B1, 1, 1); G_STAGE(G_SB(1, 0), b3, K2);
            G_BAR; G_WAIT_L(0); G_MMA(0, 1, At, B1); G_BAR;
            G_LDA(At, 1, 1); G_STAGE(G_SA(1, 0), a3, K2);
            G_BAR; G_WAIT_L(0); G_MMA(1, 0, At, B0); G_BAR; G_SCHED;
            G_STAGE(G_SB(1, 1), b3 + hs2, K2);
            G_WAIT_V(6); G_BAR; G_MMA(1, 1, At, B1); G_BAR;
        }
        epilogue(acc, cur, wr, wc, fr, fq, tid, scr);
        if (!has_next) break;
#pragma unroll
        for (int a = 0; a < 2; ++a)
#pragma unroll
            for (int b = 0; b < 2; ++b)
#pragma unroll
                for (int m = 0; m < 4; ++m)
#pragma unroll
                    for (int n = 0; n < 2; ++n) acc[a][b][m][n] = (f32x4){0.f, 0.f, 0.f, 0.f};
        cur = nxt; cA = nA; cB = nB; Kc = Kn; ++ui;
    }
    G_WAIT_V(0);
    if (wr == 0) G_BAR;
    G_BAR;
}

constexpr int SB_W = 0, SB_KK = 8192, SB_BV = 16384, SB_KP = 24576, SB_R = 32768, SB_V = 40960, SB_O = 49152, SB_SIZE = 57344;
constexpr int SC_AWD = 114688, SC_AAD = 119296;
constexpr int SC_ASTR = 144;
DI void ld8(const bf16_t* ptr, float (&f)[8]) {
    const u32x4 v = *(const u32x4*)ptr;
#pragma unroll
    for (int i = 0; i < 4; ++i) { f[2 * i] = bflo(v[i]); f[2 * i + 1] = bfhi(v[i]); }
}
struct ScanOps { f32x4 w0, w1, a0, a1, b0, b1, k0, k1, r0, r1; f32x2 v; };
DI void scan_load(ScanOps& o, const LAS unsigned char* bp, const LAS unsigned char* vp) {
    o.w0 = *(const LAS f32x4*)(bp + SB_W); o.w1 = *(const LAS f32x4*)(bp + SB_W + 16);
    o.a0 = *(const LAS f32x4*)(bp + SB_KK); o.a1 = *(const LAS f32x4*)(bp + SB_KK + 16);
    o.b0 = *(const LAS f32x4*)(bp + SB_BV); o.b1 = *(const LAS f32x4*)(bp + SB_BV + 16);
    o.k0 = *(const LAS f32x4*)(bp + SB_KP); o.k1 = *(const LAS f32x4*)(bp + SB_KP + 16);
    o.r0 = *(const LAS f32x4*)(bp + SB_R); o.r1 = *(const LAS f32x4*)(bp + SB_R + 16);
    o.v = *(const LAS f32x2*)vp;
}
DI f32x2 lo2(f32x4 x) { return (f32x2){x[0], x[1]}; }
DI f32x2 hi2(f32x4 x) { return (f32x2){x[2], x[3]}; }
DI f32x2 splat2(float x) { return (f32x2){x, x}; }
DI void scan_step(f32x2 (&S0)[4], f32x2 (&S1)[4], const ScanOps& o, LAS unsigned char* op, bool wr) {
    const f32x2 kk[4] = {lo2(o.a0), hi2(o.a0), lo2(o.a1), hi2(o.a1)};
    f32x2 p0 = S0[0] * kk[0], p1 = S1[0] * kk[0];
#pragma unroll
    for (int q = 1; q < 4; ++q) { p0 = __builtin_elementwise_fma(S0[q], kk[q], p0); p1 = __builtin_elementwise_fma(S1[q], kk[q], p1); }
    const float sa0 = -reduce8(p0[0] + p0[1]), sa1 = -reduce8(p1[0] + p1[1]);
    const f32x2 ww[4] = {lo2(o.w0), hi2(o.w0), lo2(o.w1), hi2(o.w1)};
    const f32x2 bb[4] = {lo2(o.b0), hi2(o.b0), lo2(o.b1), hi2(o.b1)};
    const f32x2 kv[4] = {lo2(o.k0), hi2(o.k0), lo2(o.k1), hi2(o.k1)};
    const f32x2 rr[4] = {lo2(o.r0), hi2(o.r0), lo2(o.r1), hi2(o.r1)};
    const f32x2 v0 = splat2(o.v[0]), v1 = splat2(o.v[1]), s0 = splat2(sa0), s1 = splat2(sa1);
#pragma unroll
    for (int q = 0; q < 4; ++q) {
        const f32x2 t0 = __builtin_elementwise_fma(bb[q], s0, kv[q] * v0), t1 = __builtin_elementwise_fma(bb[q], s1, kv[q] * v1);
        S0[q] = __builtin_elementwise_fma(S0[q], ww[q], t0); S1[q] = __builtin_elementwise_fma(S1[q], ww[q], t1);
    }
    f32x2 q0 = S0[0] * rr[0], q1 = S1[0] * rr[0];
#pragma unroll
    for (int q = 1; q < 4; ++q) { q0 = __builtin_elementwise_fma(S0[q], rr[q], q0); q1 = __builtin_elementwise_fma(S1[q], rr[q], q1); }
    const float o0 = reduce8(q0[0] + q0[1]), o1 = reduce8(q1[0] + q1[1]);
    if (wr) *(LAS f32x2*)op = (f32x2){o0, o1};
}
DI void scan_item(const Params& p, unsigned char* smem, int item) {
    const int b = item >> 4, h = item & 15;
    int tid = threadIdx.x; asm volatile("" : "+v"(tid));
    const int wid = __builtin_amdgcn_readfirstlane(tid >> 6), lane = tid & 63;
    const bf16_t* PB = (const bf16_t*)(p.ws + OFF_PB);
    const bf16_t* PL = (const bf16_t*)(p.ws + OFF_PL);
    bf16_t* YB = (bf16_t*)((char*)p.out + OFF_YB);
    LAS unsigned char* lds = (LAS unsigned char*)smem;
    const bool helper = wid >= 4;
    const int hw = wid & 3, mat = hw >> 1, tn = hw & 1, mr = lane & 31, mh = lane >> 5;
    bf16x8 Bf[4];
    float w0c = 0.f, a0c = 0.f, kac = 0.f;
    if (helper) {
        const float* Wx = (mat == 0 ? p.in[I_W2] : p.in[I_A2]) + h * 64 + tn * 32 + mr;
#pragma unroll
        for (int s = 0; s < 4; ++s) {
            u32x4 pk;
#pragma unroll
            for (int jj = 0; jj < 4; ++jj) pk[jj] = pack2(Wx[(size_t)(16 * s + 8 * mh + 2 * jj) * 1024], Wx[(size_t)(16 * s + 8 * mh + 2 * jj + 1) * 1024]);
            Bf[s] = __builtin_bit_cast(bf16x8, pk);
        }
        const int cj = h * 64 + tn * 32 + mr;
        w0c = p.in[I_W0][cj]; a0c = p.in[I_A0][cj]; kac = p.in[I_KA][cj];
    }
    const int ht = tid & 255, et = ht >> 3, eg = ht & 7, ec = h * 64 + eg * 8;
    float muw[8], mua[8], mur[8], muk[8], muv[8], kkc[8], rkc[8], lnw[8], lnb[8];
    {
        auto ldc = [&](const float* src, float (&d)[8]) { const f32x4 a = *(const f32x4*)src, bq = *(const f32x4*)(src + 4); d[0] = a[0]; d[1] = a[1]; d[2] = a[2]; d[3] = a[3]; d[4] = bq[0]; d[5] = bq[1]; d[6] = bq[2]; d[7] = bq[3]; };
        ldc(p.in[I_MUW] + eg * 8, muw); ldc(p.in[I_MUA] + eg * 8, mua);
        ldc(p.in[I_MURKV] + ec, mur); ldc(p.in[I_MURKV] + 1024 + ec, muk); ldc(p.in[I_MURKV] + 2048 + ec, muv);
        ldc(p.in[I_KK] + ec, kkc); ldc(p.in[I_RK] + ec, rkc); ldc(p.in[I_LNW] + ec, lnw); ldc(p.in[I_LNB] + ec, lnb);
    }
    u32x4 L[10]; u32x4 Z;
#pragma unroll
    for (int i = 0; i < 10; ++i) L[i] = (u32x4){0u, 0u, 0u, 0u};
    Z = (u32x4){0u, 0u, 0u, 0u};
    auto loadA = [&](int ch) {
        const size_t row = (size_t)b * SEQ + ch * 32 + et;
        const size_t prow = (ch * 32 + et) > 0 ? row - 1 : row;
        L[0] = *(const u32x4*)(PL + row * 256 + eg * 8); L[1] = *(const u32x4*)(PL + prow * 256 + eg * 8);
        L[2] = *(const u32x4*)(PL + row * 256 + 64 + eg * 8); L[3] = *(const u32x4*)(PL + prow * 256 + 64 + eg * 8);
#pragma unroll
        for (int q = 0; q < 3; ++q) { L[4 + 2 * q] = *(const u32x4*)(PB + row * 4096 + q * 1024 + ec); L[5 + 2 * q] = *(const u32x4*)(PB + prow * 4096 + q * 1024 + ec); }
    };
    auto loadZ = [&](int ch) { Z = *(const u32x4*)(PB + ((size_t)b * SEQ + ch * 32 + et) * 4096 + 3072 + ec); };
    auto unp = [&](const u32x4& v, float (&f)[8]) {
#pragma unroll
        for (int i = 0; i < 4; ++i) { f[2 * i] = bflo(v[i]); f[2 * i + 1] = bfhi(v[i]); } };
    auto stepA = [&](int ch, int buf) {
        const float pm = (ch * 32 + et) > 0 ? 1.0f : 0.0f;
        LAS unsigned char* bb = lds + buf * SB_SIZE;
        float cur[8], prv[8], x[8];
        unp(L[0], cur); unp(L[1], prv);
        u32x4 o;
#pragma unroll
        for (int i = 0; i < 8; ++i) { const float xx = cur[i] + muw[i] * (prv[i] * pm - cur[i]); x[i] = 1.0f - 2.0f * __builtin_amdgcn_rcpf(1.0f + __expf(2.0f * xx)); }
        o[0] = pack2(x[0], x[1]); o[1] = pack2(x[2], x[3]); o[2] = pack2(x[4], x[5]); o[3] = pack2(x[6], x[7]);
        *(LAS u32x4*)(lds + SC_AWD + et * SC_ASTR + eg * 16) = o;
        unp(L[2], cur); unp(L[3], prv);
#pragma unroll
        for (int i = 0; i < 8; ++i) x[i] = cur[i] + mua[i] * (prv[i] * pm - cur[i]);
        o[0] = pack2(x[0], x[1]); o[1] = pack2(x[2], x[3]); o[2] = pack2(x[4], x[5]); o[3] = pack2(x[6], x[7]);
        *(LAS u32x4*)(lds + SC_AAD + et * SC_ASTR + eg * 16) = o;
#pragma unroll
        for (int q = 0; q < 3; ++q) {
            unp(L[4 + 2 * q], cur); unp(L[5 + 2 * q], prv);
#pragma unroll
            for (int i = 0; i < 8; ++i) { const float m = q == 0 ? mur[i] : (q == 1 ? muk[i] : muv[i]); x[i] = cur[i] + m * (prv[i] * pm - cur[i]); }
            const int dsto = (q == 0 ? SB_R : (q == 1 ? SB_KP : SB_V)) + et * 256 + eg * 32;
            *(LAS f32x4*)(bb + dsto) = (f32x4){x[0], x[1], x[2], x[3]};
            *(LAS f32x4*)(bb + dsto + 16) = (f32x4){x[4], x[5], x[6], x[7]};
            if (q == 1) {
                float kk[8]; float ss = 0.f;
#pragma unroll
                for (int i = 0; i < 8; ++i) { kk[i] = x[i] * kkc[i]; ss += kk[i] * kk[i]; }
                ss = reduce8(ss);
                const float rn = rsqrtf(fmaxf(ss, 1e-24f));
                *(LAS f32x4*)(bb + SB_KK + et * 256 + eg * 32) = (f32x4){kk[0] * rn, kk[1] * rn, kk[2] * rn, kk[3] * rn};
                *(LAS f32x4*)(bb + SB_KK + et * 256 + eg * 32 + 16) = (f32x4){kk[4] * rn, kk[5] * rn, kk[6] * rn, kk[7] * rn};
            }
        }
    };
    auto stepB = [&](int buf) {
        LAS unsigned char* bb = lds + buf * SB_SIZE;
        f32x16 acc;
#pragma unroll
        for (int i = 0; i < 16; ++i) acc[i] = 0.f;
        const int abase = (mat == 0 ? SC_AWD : SC_AAD) + mr * SC_ASTR + mh * 16;
#pragma unroll
        for (int s = 0; s < 4; ++s) { const bf16x8 a = *(const LAS bf16x8*)(lds + abase + s * 32); acc = MFMA32(a, Bf[s], acc); }
        const int jcol = tn * 32 + mr;
#pragma unroll
        for (int i = 0; i < 16; ++i) {
            const int t = crow(i, mh);
            if (mat == 0) {
                const float y = -(w0c + acc[i]);
                const float sp = fmaxf(y, 0.f) + __logf(1.0f + __expf(-fabsf(y)));
                const float w = -sp - 0.5f;
                *(LAS float*)(bb + SB_W + t * 256 + jcol * 4) = __expf(-__expf(w));
            } else {
                const float a = sigmoidf_(a0c + acc[i]);
                const float kl = *(LAS float*)(bb + SB_KP + t * 256 + jcol * 4);
                const float kk = *(LAS float*)(bb + SB_KK + t * 256 + jcol * 4);
                *(LAS float*)(bb + SB_KP + t * 256 + jcol * 4) = kl * (1.0f + (a - 1.0f) * kac);
                *(LAS float*)(bb + SB_BV + t * 256 + jcol * 4) = kk * a;
            }
        }
    };
    auto epi = [&](int ch, int buf) {
        const size_t row = (size_t)b * SEQ + ch * 32 + et;
        LAS unsigned char* bb = lds + buf * SB_SIZE;
        const f32x4 o0 = *(const LAS f32x4*)(bb + SB_O + et * 256 + eg * 32), o1 = *(const LAS f32x4*)(bb + SB_O + et * 256 + eg * 32 + 16);
        float o[8] = {o0[0], o0[1], o0[2], o0[3], o1[0], o1[1], o1[2], o1[3]};
        float sm = 0.f;
#pragma unroll
        for (int i = 0; i < 8; ++i) sm += o[i];
        const float mean = reduce8(sm) * (1.0f / 64.0f);
        float sv = 0.f;
#pragma unroll
        for (int i = 0; i < 8; ++i) { const float d = o[i] - mean; sv += d * d; }
        const float rstd = rsqrtf(reduce8(sv) * (1.0f / 64.0f) + 64e-5f);
        const f32x4 r0 = *(const LAS f32x4*)(bb + SB_R + et * 256 + eg * 32), r1 = *(const LAS f32x4*)(bb + SB_R + et * 256 + eg * 32 + 16);
        const f32x4 k0 = *(const LAS f32x4*)(bb + SB_KP + et * 256 + eg * 32), k1 = *(const LAS f32x4*)(bb + SB_KP + et * 256 + eg * 32 + 16);
        float bs = r0[0] * k0[0] * rkc[0] + r0[1] * k0[1] * rkc[1] + r0[2] * k0[2] * rkc[2] + r0[3] * k0[3] * rkc[3]
                 + r1[0] * k1[0] * rkc[4] + r1[1] * k1[1] * rkc[5] + r1[2] * k1[2] * rkc[6] + r1[3] * k1[3] * rkc[7];
        bs = reduce8(bs);
        const f32x4 v0 = *(const LAS f32x4*)(bb + SB_V + et * 256 + eg * 32), v1 = *(const LAS f32x4*)(bb + SB_V + et * 256 + eg * 32 + 16);
        float z[8]; unp(Z, z);
        float y[8];
#pragma unroll
        for (int i = 0; i < 8; ++i) {
            const float vv = i < 4 ? v0[i] : v1[i - 4];
            y[i] = ((o[i] - mean) * rstd * lnw[i] + lnb[i] + bs * vv) * siluf_(z[i]);
        }
        u32x4 ov; ov[0] = pack2(y[0], y[1]); ov[1] = pack2(y[2], y[3]); ov[2] = pack2(y[4], y[5]); ov[3] = pack2(y[6], y[7]);
        *(u32x4*)(YB + row * 1024 + ec) = ov;
    };

    if (helper) {
        loadA(0); stepA(0, 0); loadA(1);
        __syncthreads();
        stepB(0);
        __syncthreads();
#pragma unroll 1
        for (int ch = 0; ch < SEQ / 32; ++ch) {
            const int buf = ch & 1;
            if (ch > 0) epi(ch - 1, buf ^ 1);
            if (ch + 1 < SEQ / 32) stepA(ch + 1, buf ^ 1);
            if (ch + 2 < SEQ / 32) loadA(ch + 2);
            __syncthreads();
            if (ch + 1 < SEQ / 32) stepB(buf ^ 1);
            loadZ(ch);
            __syncthreads();
        }
        epi(SEQ / 32 - 1, 1);
        __syncthreads();
    } else {
        const int il = lane >> 3, jl = lane & 7, row0 = (wid & 3) * 16 + il * 2;
        f32x2 S0[4], S1[4];
#pragma unroll
        for (int q = 0; q < 4; ++q) { S0[q] = (f32x2){0.f, 0.f}; S1[q] = (f32x2){0.f, 0.f}; }
        __syncthreads();
        __syncthreads();
#pragma unroll 1
        for (int ch = 0; ch < SEQ / 32; ++ch) {
            const int buf = ch & 1;
            const LAS unsigned char* bp = lds + buf * SB_SIZE + jl * 32;
            const LAS unsigned char* vp = lds + buf * SB_SIZE + SB_V + row0 * 4;
            LAS unsigned char* op = lds + buf * SB_SIZE + SB_O + row0 * 4;
#pragma unroll 1
            for (int half = 0; half < 2; ++half) {
                ScanOps oa, ob;
                scan_load(oa, bp + half * 16 * 256, vp + half * 16 * 256);
#pragma unroll 1
                for (int t = half * 16; t < half * 16 + 16; t += 2) {
                    scan_load(ob, bp + (t + 1) * 256, vp + (t + 1) * 256);
                    scan_step(S0, S1, oa, op + t * 256, jl == 0);
                    scan_load(oa, bp + (t + 2) * 256, vp + (t + 2) * 256);
                    scan_step(S0, S1, ob, op + (t + 1) * 256, jl == 0);
                }
                __syncthreads();
            }
        }
        __syncthreads();
    }
}

template <int HD> struct AttnCfg { static constexpr int KSTR = HD * 2 + 16, VSTR = 136, VROWS = HD, K_OFF = 0, V_OFF = 64 * KSTR, BIAS_OFF = V_OFF + VROWS * VSTR; };

template <int HD>
DI void attn_load_q(bf16x8 (&Qf)[HD / 16], const bf16_t* qrow, const float* g, float scale, int mh) {
    u32x4 raw[HD / 16]; float ss = 0.f;
#pragma unroll
    for (int s = 0; s < HD / 16; ++s) {
        raw[s] = *(const u32x4*)(qrow + 16 * s + 8 * mh);
#pragma unroll
        for (int i = 0; i < 4; ++i) { const float a = bflo(raw[s][i]), bb = bfhi(raw[s][i]); ss += a * a + bb * bb; }
    }
    ss += __shfl_xor(ss, 32);
    const float rstd = rsqrtf(ss * (1.0f / HD) + 1e-6f) * scale;
#pragma unroll
    for (int s = 0; s < HD / 16; ++s) {
        const f32x4 g0 = *(const f32x4*)(g + 16 * s + 8 * mh), g1 = *(const f32x4*)(g + 16 * s + 8 * mh + 4);
        u32x4 o;
        o[0] = pack2(bflo(raw[s][0]) * rstd * g0[0], bfhi(raw[s][0]) * rstd * g0[1]);
        o[1] = pack2(bflo(raw[s][1]) * rstd * g0[2], bfhi(raw[s][1]) * rstd * g0[3]);
        o[2] = pack2(bflo(raw[s][2]) * rstd * g1[0], bfhi(raw[s][2]) * rstd * g1[1]);
        o[3] = pack2(bflo(raw[s][3]) * rstd * g1[2], bfhi(raw[s][3]) * rstd * g1[3]);
        Qf[s] = __builtin_bit_cast(bf16x8, o);
    }
}
template <int HD>
DI void attn_load_k(LAS unsigned char* lds, const bf16_t* ksrc, size_t ldk, const float* gk, int tid) {
    constexpr int EPT = HD / 8;
    const int key = tid >> 3, part = tid & 7;
    const bf16_t* src = ksrc + (size_t)key * ldk + part * EPT;
    u32x4 raw[EPT / 8]; float ss = 0.f;
#pragma unroll
    for (int v = 0; v < EPT / 8; ++v) {
        raw[v] = *(const u32x4*)(src + v * 8);
#pragma unroll
        for (int i = 0; i < 4; ++i) { const float a = bflo(raw[v][i]), bb = bfhi(raw[v][i]); ss += a * a + bb * bb; }
    }
    ss = reduce8(ss);
    const float rstd = rsqrtf(ss * (1.0f / HD) + 1e-6f);
#pragma unroll
    for (int v = 0; v < EPT / 8; ++v) {
        const float* gp = gk + part * EPT + v * 8;
        const f32x4 g0 = *(const f32x4*)gp, g1 = *(const f32x4*)(gp + 4);
        u32x4 o;
        o[0] = pack2(bflo(raw[v][0]) * rstd * g0[0], bfhi(raw[v][0]) * rstd * g0[1]);
        o[1] = pack2(bflo(raw[v][1]) * rstd * g0[2], bfhi(raw[v][1]) * rstd * g0[3]);
        o[2] = pack2(bflo(raw[v][2]) * rstd * g1[0], bfhi(raw[v][2]) * rstd * g1[1]);
        o[3] = pack2(bflo(raw[v][3]) * rstd * g1[2], bfhi(raw[v][3]) * rstd * g1[3]);
        *(LAS u32x4*)(lds + AttnCfg<HD>::K_OFF + key * AttnCfg<HD>::KSTR + (part * EPT + v * 8) * 2) = o;
    }
}
template <int HD>
DI void attn_load_v(LAS unsigned char* lds, const bf16_t* vsrc, size_t ldv, int tid) {
    constexpr int TPR = 512 / HD, KPT = 64 / TPR;
    const int d = tid / TPR, part = tid % TPR;
    const bf16_t* src = vsrc + (size_t)d * ldv + part * KPT;
#pragma unroll
    for (int v = 0; v < KPT / 8; ++v) {
        const u32x4 raw = *(const u32x4*)(src + v * 8);
        LAS unsigned char* dp = lds + AttnCfg<HD>::V_OFF + d * AttnCfg<HD>::VSTR + (part * KPT + v * 8) * 2;
        *(LAS u32x2*)dp = (u32x2){raw[0], raw[1]};
        *(LAS u32x2*)(dp + 8) = (u32x2){raw[2], raw[3]};
    }
}
template <int HD, bool BIAS, bool QLDS>
DI void attn_chunk(const bf16x8 (&Qf)[HD / 16], const LAS unsigned char* qp, f32x16 (&O)[4], float& m_run, float& l_run, const LAS unsigned char* lds, int dbase, int mr, int mh, int qk_delta) {
#pragma unroll 1
    for (int kt = 0; kt < 2; ++kt) {
        f32x16 sc;
#pragma unroll
        for (int i = 0; i < 16; ++i) sc[i] = 0.f;
        const LAS unsigned char* kp = lds + AttnCfg<HD>::K_OFF + (kt * 32 + mr) * AttnCfg<HD>::KSTR + mh * 16;
#pragma unroll
        for (int s = 0; s < HD / 16; ++s) { if ((s & 3) == 0) __builtin_amdgcn_sched_barrier(0); const bf16x8 a = *(const LAS bf16x8*)(kp + s * 32); const bf16x8 qb = QLDS ? *(const LAS bf16x8*)(qp + s * 32) : Qf[s]; sc = MFMA32(a, qb, sc); }
        float mx = -1e30f;
#pragma unroll
        for (int i = 0; i < 16; ++i) {
            if (BIAS) {
                int dist = qk_delta + mr - (kt * 32 + crow(i, mh));
                dist = dist < -128 ? -128 : (dist > 128 ? 128 : dist);
                sc[i] += *(const LAS float*)(lds + AttnCfg<HD>::BIAS_OFF + (dist + 128) * 4);
            }
            mx = fmaxf(mx, sc[i]);
        }
        mx = fmaxf(mx, __shfl_xor(mx, 32));
        const float m_new = fmaxf(m_run, mx), alpha = __expf(m_run - m_new);
        float ls = 0.f;
#pragma unroll
        for (int i = 0; i < 16; ++i) { const float pv = __expf(sc[i] - m_new); sc[i] = pv; ls += pv; }
        l_run = l_run * alpha + ls; m_run = m_new;
#pragma unroll
        for (int dt = 0; dt < 4; ++dt)
#pragma unroll
            for (int i = 0; i < 16; ++i) O[dt][i] *= alpha;
#pragma unroll
        for (int s2 = 0; s2 < 2; ++s2) {
            u32x4 pk;
#pragma unroll
            for (int j = 0; j < 4; ++j) pk[j] = pack2(sc[8 * s2 + 2 * j], sc[8 * s2 + 2 * j + 1]);
            const bf16x8 pb = __builtin_bit_cast(bf16x8, pk);
#pragma unroll
            for (int dt = 0; dt < 4; ++dt) {
                const LAS unsigned char* vp = lds + AttnCfg<HD>::V_OFF + (dbase + dt * 32 + mr) * AttnCfg<HD>::VSTR + (kt * 32 + 16 * s2 + 4 * mh) * 2;
                const u32x2 lo = *(const LAS u32x2*)vp, hi = *(const LAS u32x2*)(vp + 16);
                const u32x4 va = {lo[0], lo[1], hi[0], hi[1]};
                O[dt] = MFMA32(__builtin_bit_cast(bf16x8, va), pb, O[dt]);
            }
        }
    }
}
DI void attn_store(const f32x16 (&O)[4], float l_run, const bf16_t* zrow, bf16_t* yrow, int mh) {
    const float lt = l_run + __shfl_xor(l_run, 32);
    const float inv = 1.0f / lt;
#pragma unroll
    for (int dt = 0; dt < 4; ++dt)
#pragma unroll
        for (int g = 0; g < 4; ++g) {
            const int d = dt * 32 + 8 * g + 4 * mh;
            const u32x2 zz = *(const u32x2*)(zrow + d);
            u32x2 o;
            o[0] = pack2(O[dt][4 * g] * inv * siluf_(bflo(zz[0])), O[dt][4 * g + 1] * inv * siluf_(bfhi(zz[0])));
            o[1] = pack2(O[dt][4 * g + 2] * inv * siluf_(bflo(zz[1])), O[dt][4 * g + 3] * inv * siluf_(bfhi(zz[1])));
            *(u32x2*)(yrow + d) = o;
        }
}

DI void attnA_item(const Params& p, unsigned char* smem, int item) {
    const int b = item >> 6, head = (item >> 3) & 7, cgp = item & 7;
    int tid = threadIdx.x; asm volatile("" : "+v"(tid));
    const int wid = tid >> 6, lane = tid & 63, mr = lane & 31, mh = lane >> 5;
    LAS unsigned char* lds = (LAS unsigned char*)smem;
    const bf16_t* PA = (const bf16_t*)(p.ws + OFF_PA);
    const bf16_t* VT = (const bf16_t*)(p.ws + OFF_VT);
    bf16_t* YA = (bf16_t*)((char*)p.out + OFF_YA);
    const int cw = cgp * 4 + (wid >> 1), qt = wid & 1;
    const size_t qrow = (size_t)b * SEQ + cw * 64 + qt * 32 + mr;
    if (tid < 257) *(LAS float*)(lds + AttnCfg<128>::BIAS_OFF + tid * 4) = p.in[I_RELB][head * 257 + tid];
    bf16x8 Qf[8];
    attn_load_q<128>(Qf, PA + qrow * 3072 + head * 128, p.in[I_AQG], 0.08838834764831845f, mh);
    f32x16 O[4];
#pragma unroll
    for (int dt = 0; dt < 4; ++dt)
#pragma unroll
        for (int i = 0; i < 16; ++i) O[dt][i] = 0.f;
    float m_run = -1e30f, l_run = 0.f;
    for (int kc = cgp * 4 - 8; kc <= cgp * 4 + 3; ++kc) {
        if (kc < 0) continue;
        __syncthreads();
        attn_load_k<128>(lds, PA + ((size_t)b * SEQ + kc * 64) * 3072 + 1024 + head * 128, 3072, p.in[I_AKG], tid);
        attn_load_v<128>(lds, VT + (size_t)(head * 128) * T_TOK + (size_t)b * SEQ + kc * 64, T_TOK, tid);
        __syncthreads();
        if (kc >= cw - 8 && kc <= cw)
            attn_chunk<128, true, false>(Qf, lds, O, m_run, l_run, lds, 0, mr, mh, (cw - kc) * 64 + qt * 32);
    }
    attn_store(O, l_run, PA + qrow * 3072 + 2048 + head * 128, YA + qrow * 1024 + head * 128, mh);
    __syncthreads();
}
DI void attnC_item(const Params& p, unsigned char* smem, int item) {
    const int b = item >> 6, hc = (item >> 4) & 3, qg = item & 15;
    int tid = threadIdx.x; asm volatile("" : "+v"(tid));
    const int wid = tid >> 6, lane = tid & 63, mr = lane & 31, mh = lane >> 5;
    LAS unsigned char* lds = (LAS unsigned char*)smem;
    const bf16_t* PC = (const bf16_t*)(p.ws + OFF_PC);
    const bf16_t* MK = (const bf16_t*)(p.ws + OFF_MK);
    const bf16_t* MVT = (const bf16_t*)(p.ws + OFF_MVT);
    bf16_t* YC = (bf16_t*)((char*)p.out + OFF_YC);
    const int qt = wid >> 1, dh = wid & 1;
    const size_t qrow = (size_t)b * SEQ + qg * 128 + qt * 32 + mr;
    constexpr int Q_OFF = AttnCfg<256>::V_OFF + 256 * AttnCfg<256>::VSTR;
    __syncthreads();
    {
        bf16x8 Qf[16];
        attn_load_q<256>(Qf, PC + qrow * 2048 + hc * 256, p.in[I_CQG], 0.0625f, mh);
        if (dh == 0) {
#pragma unroll
            for (int s = 0; s < 16; ++s) *(LAS bf16x8*)(lds + Q_OFF + (qt * 32 + mr) * 528 + s * 32 + mh * 16) = Qf[s];
        }
    }
    const LAS unsigned char* qp = lds + Q_OFF + (qt * 32 + mr) * 528 + mh * 16;
    bf16x8 Qd[16];
    f32x16 O[4];
#pragma unroll
    for (int dt = 0; dt < 4; ++dt)
#pragma unroll
        for (int i = 0; i < 16; ++i) O[dt][i] = 0.f;
    float m_run = -1e30f, l_run = 0.f;
    for (int kc = 0; kc < 4; ++kc) {
        __syncthreads();
        attn_load_k<256>(lds, MK + ((size_t)b * NMEM + kc * 64) * 1024 + hc * 256, 1024, p.in[I_CKG], tid);
        attn_load_v<256>(lds, MVT + (size_t)(hc * 256) * 2048 + (size_t)b * NMEM + kc * 64, 2048, tid);
        __syncthreads();
        attn_chunk<256, false, true>(Qd, qp, O, m_run, l_run, lds, dh * 128, mr, mh, 0);
    }
    attn_store(O, l_run, PC + qrow * 2048 + 1024 + hc * 256 + dh * 128, YC + qrow * 1024 + hc * 256 + dh * 128, mh);
    __syncthreads();
}
DI void phase2(const Params& p, unsigned char* smem) {
    const int c = blockIdx.x;
    if (c < 128) scan_item(p, smem, c);
    for (int it = c + p.G; it < 128 && c < 128; it += p.G) scan_item(p, smem, it);
    unsigned* ctr = (unsigned*)(p.ws + OFF_CTR);
    LAS int* sitem = (LAS int*)((LAS unsigned char*)smem + LDS_BYTES - 16);
    auto fetch = [&]() -> int {
        __syncthreads();
        if (threadIdx.x == 0) *sitem = (int)atomicAdd(ctr, 1u);
        __syncthreads();
        return *sitem;
    };
    int item = fetch();
    while (item < 512) { attnA_item(p, smem, item); item = fetch(); }
    while (item < 1024) { attnC_item(p, smem, item - 512); item = fetch(); }
}

__global__ void __launch_bounds__(NTHREADS) hybrid_fwd(Params p) {
    extern __shared__ __attribute__((aligned(16))) unsigned char smem[];
    cg::grid_group grid = cg::this_grid();
#ifndef PHMASK
#define PHMASK 31
#endif
    if (PHMASK & 1) phase0(p, smem);
    grid.sync();
    if (PHMASK & 2) gemm_phase<1>((LAS unsigned char*)smem, p);
    grid.sync();
    if (PHMASK & 4) phase2(p, smem);
    grid.sync();
    if (PHMASK & 8) gemm_phase<3>((LAS unsigned char*)smem, p);
    grid.sync();
    if (PHMASK & 16) gemm_phase<4>((LAS unsigned char*)smem, p);
}

extern "C" void kernel_launch(void* const* d_in, const int* in_sizes, int n_in, void* d_out, int out_size, void* d_ws, size_t ws_size, hipStream_t stream) {
    static int grid_blocks = 0;
    if (grid_blocks == 0) {
        if (n_in != 27 || ws_size < WS_END || out_size != T_TOK * DM) { fprintf(stderr, "kernel_launch: unexpected shapes (n_in %d ws %zu out %d)\n", n_in, ws_size, out_size); grid_blocks = -1; return; }
        int dev = 0, cus = 0, per_cu = 0;
        hipGetDevice(&dev);
        hipDeviceGetAttribute(&cus, hipDeviceAttributeMultiprocessorCount, dev);
        if (hipFuncSetAttribute((const void*)hybrid_fwd, hipFuncAttributeMaxDynamicSharedMemorySize, LDS_BYTES) != hipSuccess) { fprintf(stderr, "kernel_launch: hipFuncSetAttribute failed\n"); grid_blocks = -1; return; }
        if (hipOccupancyMaxActiveBlocksPerMultiprocessor(&per_cu, (const void*)hybrid_fwd, NTHREADS, LDS_BYTES) != hipSuccess || per_cu < 1) { fprintf(stderr, "kernel_launch: occupancy query failed (%d)\n", per_cu); grid_blocks = -1; return; }
        grid_blocks = cus * 1;
    }
    if (grid_blocks < 0) return;
    Params p{};
    for (int i = 0; i < 27; ++i) p.in[i] = (const float*)d_in[i];
    p.out = (float*)d_out; p.ws = (unsigned char*)d_ws; p.G = grid_blocks; p.pad = 0;
    void* args[] = {&p};
    hipError_t e = hipLaunchCooperativeKernel((const void*)hybrid_fwd, dim3(grid_blocks), dim3(NTHREADS), args, LDS_BYTES, stream);
    if (e != hipSuccess) fprintf(stderr, "cooperative launch failed: %s (grid %d)\n", hipGetErrorString(e), grid_blocks);
}
```

```cpp
#include <hip/hip_runtime.h>
#include <hip/hip_cooperative_groups.h>
#include <cstdio>
namespace cg = cooperative_groups;

#define DI __device__ __forceinline__
#define LAS __attribute__((address_space(3)))
typedef unsigned short bf16_t;
typedef short bf16x8 __attribute__((ext_vector_type(8)));
typedef float f32x2 __attribute__((ext_vector_type(2)));
typedef float f32x4 __attribute__((ext_vector_type(4)));
typedef float f32x16 __attribute__((ext_vector_type(16)));
typedef unsigned u32x2 __attribute__((ext_vector_type(2)));
typedef unsigned u32x4 __attribute__((ext_vector_type(4)));
typedef __bf16 bf16v2 __attribute__((ext_vector_type(2)));

constexpr int T_TOK = 16384, DM = 2048, SEQ = 2048, NB = 8, NMEM = 256;
constexpr int INC = 16512;
constexpr int NTHREADS = 512;
constexpr int LDS_BYTES = 139264;

constexpr size_t SZ_WT = (size_t)INC * DM * 2;
constexpr size_t OFF_WT = 0;
constexpr size_t OFF_WMEM = OFF_WT + SZ_WT;
constexpr size_t OFF_WUA = OFF_WMEM + (size_t)2048 * 2048 * 2;
constexpr size_t OFF_WUB = OFF_WUA + (size_t)2048 * 1024 * 2;
constexpr size_t OFF_WUC = OFF_WUB + (size_t)2048 * 1024 * 2;
constexpr size_t OFF_WO = OFF_WUC + (size_t)2048 * 1024 * 2;
constexpr size_t OFF_H = OFF_WO + (size_t)2048 * 2048 * 2;
constexpr size_t OFF_M = OFF_H + (size_t)T_TOK * 2048 * 2;
constexpr size_t OFF_PA = OFF_M + (size_t)2048 * 2048 * 2;
constexpr size_t OFF_PB = OFF_PA + (size_t)T_TOK * 3072 * 2;
constexpr size_t OFF_PL = OFF_PB + (size_t)T_TOK * 4096 * 2;
constexpr size_t OFF_PC = OFF_PL + (size_t)T_TOK * 256 * 2;
constexpr size_t OFF_VT = OFF_PC + (size_t)T_TOK * 2048 * 2;
constexpr size_t OFF_MK = OFF_VT + (size_t)1024 * T_TOK * 2;
constexpr size_t OFF_MVT = OFF_MK + (size_t)2048 * 1024 * 2;
constexpr size_t OFF_CTR = OFF_MVT + (size_t)1024 * 2048 * 2;
constexpr size_t WS_END = OFF_CTR + 256;
constexpr size_t OFF_MERGED = OFF_PB;
constexpr size_t OFF_SCR = OFF_PB + (size_t)T_TOK * 2048 * 2;
constexpr size_t OFF_G = OFF_PA;
constexpr size_t SCR_PER_WG = 2 * 131072;
constexpr size_t OFF_YA = 0, OFF_YB = (size_t)T_TOK * 1024 * 2, OFF_YC = 2 * OFF_YB;

struct Params {
    const float* in[27];
    float* out;
    unsigned char* ws;
    int G; int pad;
};
enum { I_X = 0, I_MEM, I_NORMG, I_WIN, I_AQG, I_AKG, I_RELB, I_WUPA, I_MURKV, I_MUW, I_MUA, I_W0, I_W2, I_A0, I_A2, I_KK, I_KA, I_RK, I_LNW, I_LNB, I_WUPB,
       I_MEMG, I_WMEMKV, I_CQG, I_CKG, I_WUPC, I_WO };

DI unsigned pack2(float lo, float hi) { f32x2 v = {lo, hi}; bf16v2 b = __builtin_convertvector(v, bf16v2); return __builtin_bit_cast(unsigned, b); }
DI float bflo(unsigned u) { return __uint_as_float(u << 16); }
DI float bfhi(unsigned u) { return __uint_as_float(u & 0xffff0000u); }
DI float sigmoidf_(float x) { return __builtin_amdgcn_rcpf(1.0f + __expf(-x)); }
DI float siluf_(float x) { return x * sigmoidf_(x); }
DI float wave_sum(float v) {
#pragma unroll
    for (int o = 32; o > 0; o >>= 1) v += __shfl_xor(v, o);
    return v;
}
template <int CTRL> DI float dpp_mov(float x) { return __int_as_float(__builtin_amdgcn_update_dpp(0, __float_as_int(x), CTRL, 0xf, 0xf, false)); }
DI float reduce8(float x) {
    x += dpp_mov<0xB1>(x);
    x += dpp_mov<0x4E>(x);
    x += dpp_mov<0x141>(x);
    return x;
}
DI int crow(int i, int h) { return (i & 3) + 8 * (i >> 2) + 4 * h; }
#define MFMA32(a, b, c) __builtin_amdgcn_mfma_f32_32x32x16_bf16((a), (b), (c), 0, 0, 0)

DI void transpose_tile(const float* __restrict__ src, bf16_t* __restrict__ dst, int R, int C, int tr, int tc, float* lds) {
    const int tid = threadIdx.x;
    const int r = tid >> 3, cs = (tid & 7) * 8;
    const float* sp = src + (size_t)(tr * 64 + r) * C + tc * 64 + cs;
    f32x4 v0 = *(const f32x4*)sp, v1 = *(const f32x4*)(sp + 4);
    float* lp = lds + r * 65 + cs;
    lp[0] = v0[0]; lp[1] = v0[1]; lp[2] = v0[2]; lp[3] = v0[3]; lp[4] = v1[0]; lp[5] = v1[1]; lp[6] = v1[2]; lp[7] = v1[3];
    __syncthreads();
    const int c = tid >> 3, ks = (tid & 7) * 8;
    u32x4 o;
    o[0] = pack2(lds[(ks + 0) * 65 + c], lds[(ks + 1) * 65 + c]);
    o[1] = pack2(lds[(ks + 2) * 65 + c], lds[(ks + 3) * 65 + c]);
    o[2] = pack2(lds[(ks + 4) * 65 + c], lds[(ks + 5) * 65 + c]);
    o[3] = pack2(lds[(ks + 6) * 65 + c], lds[(ks + 7) * 65 + c]);
    *(u32x4*)(dst + (size_t)(tc * 64 + c) * R + tr * 64 + ks) = o;
    __syncthreads();
}
DI void rmsnorm_row2048(const float* __restrict__ x, const float* __restrict__ g, bf16_t* __restrict__ out, int lane) {
    f32x4 v[8]; float ss = 0.f;
#pragma unroll
    for (int i = 0; i < 8; ++i) { v[i] = ((const f32x4*)x)[i * 64 + lane]; ss += v[i][0] * v[i][0] + v[i][1] * v[i][1] + v[i][2] * v[i][2] + v[i][3] * v[i][3]; }
    ss = wave_sum(ss);
    const float rstd = rsqrtf(ss * (1.0f / 2048.0f) + 1e-6f);
#pragma unroll
    for (int i = 0; i < 8; ++i) {
        const f32x4 g4 = ((const f32x4*)g)[i * 64 + lane];
        u32x2 o; o[0] = pack2(v[i][0] * rstd * g4[0], v[i][1] * rstd * g4[1]); o[1] = pack2(v[i][2] * rstd * g4[2], v[i][3] * rstd * g4[3]);
        ((u32x2*)out)[i * 64 + lane] = o;
    }
}
DI void phase0(const Params& p, unsigned char* smem) {
    float* lds = (float*)smem;
    const int G = p.G, c = blockIdx.x;
    if (c == 0 && threadIdx.x == 0) { *(unsigned*)(p.ws + OFF_CTR) = 0u; *(unsigned*)(p.ws + OFF_CTR + 64) = 0u; }
    constexpr int N_WIN = 32 * 258, N_SQ = 32 * 32, N_UP = 16 * 32;
    constexpr int NTR = N_WIN + N_SQ + 3 * N_UP + N_SQ;
    for (int u = c; u < NTR; u += G) {
        int l = u;
        if (l < N_WIN) { transpose_tile(p.in[I_WIN], (bf16_t*)(p.ws + OFF_WT), 2048, INC, l & 31, l >> 5, lds); continue; }
        l -= N_WIN;
        if (l < N_SQ) { transpose_tile(p.in[I_WMEMKV], (bf16_t*)(p.ws + OFF_WMEM), 2048, 2048, l & 31, l >> 5, lds); continue; }
        l -= N_SQ;
        if (l < 3 * N_UP) {
            const int w = l / N_UP; l -= w * N_UP;
            const float* src = w == 0 ? p.in[I_WUPA] : (w == 1 ? p.in[I_WUPB] : p.in[I_WUPC]);
            bf16_t* dst = (bf16_t*)(p.ws + (w == 0 ? OFF_WUA : (w == 1 ? OFF_WUB : OFF_WUC)));
            transpose_tile(src, dst, 1024, 2048, l & 15, l >> 4, lds); continue;
        }
        l -= 3 * N_UP;
        transpose_tile(p.in[I_WO], (bf16_t*)(p.ws + OFF_WO), 2048, 2048, l & 31, l >> 5, lds);
    }
    const int wid = threadIdx.x >> 6, lane = threadIdx.x & 63;
    for (int rg = c; rg < (T_TOK + 2048) / 8; rg += G) {
        const int row = rg * 8 + wid;
        if (row < T_TOK) rmsnorm_row2048(p.in[I_X] + (size_t)row * 2048, p.in[I_NORMG], (bf16_t*)(p.ws + OFF_H) + (size_t)row * 2048, lane);
        else rmsnorm_row2048(p.in[I_MEM] + (size_t)(row - T_TOK) * 2048, p.in[I_MEMG], (bf16_t*)(p.ws + OFF_M) + (size_t)(row - T_TOK) * 2048, lane);
    }
}

constexpr int BM = 256, BK = 64, HALF = 128, HTB = HALF * BK * 2;
DI int lds_byte(int r, int c) { const int st = (r >> 4) * 2 + (c >> 5), rr = r & 15, cc = c & 31, ob = rr * 64 + cc * 2; return st * 1024 + (ob ^ (((ob >> 9) & 1) << 5)); }
DI void stage_rc(int b, int& R, int& C) { const int st = b / 1024, sb = b % 1024, swz = sb ^ (((sb >> 9) & 1) << 5); R = (st >> 1) * 16 + swz / 64; C = (st & 1) * 32 + (swz % 64) / 2; }

enum { EPI_BF16 = 0, EPI_UP = 1, EPI_GATE = 2, EPI_SIG = 3, EPI_OUT = 4, EPI_UPG = 5 };
struct Unit { const char* A; const char* B; char* C; int K; int ldc; int kind; int aux; const float* X; const char* Gp; };

DI void epilogue(const f32x4 (&acc)[2][2][4][2], const Unit& u, int wr, int wc, int fr, int fq, int tid, char* scr) {
    if (u.kind == EPI_BF16) {
#pragma unroll
        for (int ai = 0; ai < 2; ++ai)
#pragma unroll
            for (int m = 0; m < 4; ++m) {
                bf16_t* rowp = (bf16_t*)u.C + (size_t)(ai * 128 + wr * 64 + m * 16 + fr) * u.ldc + wc * 32 + 4 * fq;
#pragma unroll
                for (int bj = 0; bj < 2; ++bj)
#pragma unroll
                    for (int n = 0; n < 2; ++n) {
                        const f32x4 a = acc[ai][bj][m][n]; u32x2 o; o[0] = pack2(a[0], a[1]); o[1] = pack2(a[2], a[3]);
                        *(u32x2*)(rowp + bj * 128 + n * 16) = o;
                    }
            }
    } else if (u.kind == EPI_OUT) {
#pragma unroll
        for (int ai = 0; ai < 2; ++ai)
#pragma unroll
            for (int m = 0; m < 4; ++m) {
                const size_t ro = (size_t)(ai * 128 + wr * 64 + m * 16 + fr) * 2048 + wc * 32 + 4 * fq;
#pragma unroll
                for (int bj = 0; bj < 2; ++bj)
#pragma unroll
                    for (int n = 0; n < 2; ++n) {
                        const f32x4 xv = *(const f32x4*)(u.X + ro + bj * 128 + n * 16);
                        *(f32x4*)((float*)u.C + ro + bj * 128 + n * 16) = acc[ai][bj][m][n] + xv;
                    }
            }
    } else if (u.kind == EPI_UP || u.kind == EPI_SIG) {
        const bool sg = u.kind == EPI_SIG;
        u32x2* sp = (u32x2*)(sg ? u.C : scr) + tid;
#pragma unroll
        for (int ai = 0; ai < 2; ++ai)
#pragma unroll
            for (int m = 0; m < 4; ++m) {
                asm volatile("" : "+v"(sp) : : "memory");
#pragma unroll
                for (int bj = 0; bj < 2; ++bj)
#pragma unroll
                    for (int n = 0; n < 2; ++n) {
                        f32x4 a = acc[ai][bj][m][n];
                        if (sg) { a[0] = sigmoidf_(a[0]); a[1] = sigmoidf_(a[1]); a[2] = sigmoidf_(a[2]); a[3] = sigmoidf_(a[3]); }
                        u32x2 o; o[0] = pack2(a[0], a[1]); o[1] = pack2(a[2], a[3]);
                        sp[(bj * 2 + n) * 512] = o;
                    }
                sp += 4 * 512;
            }
    } else {
        u32x2* sp = (u32x2*)scr + tid;
        const bool isg = u.kind == EPI_GATE;
        const u32x2* gp = isg ? (const u32x2*)scr + tid : (const u32x2*)u.Gp + tid;
        const int mode = u.aux;
#pragma unroll
        for (int ai = 0; ai < 2; ++ai)
#pragma unroll
            for (int m = 0; m < 4; ++m) {
                asm volatile("" : "+v"(sp), "+v"(gp) : : "memory");
                __builtin_amdgcn_sched_barrier(0);
                bf16_t* rowp = (bf16_t*)u.C + (size_t)(ai * 128 + wr * 64 + m * 16 + fr) * u.ldc + wc * 32 + 4 * fq;
#pragma unroll
                for (int bj = 0; bj < 2; ++bj)
#pragma unroll
                    for (int n = 0; n < 2; ++n) {
                        const int idx = (bj * 2 + n) * 512;
                        const u32x2 uu = gp[idx];
                        u32x2 mm = {0u, 0u};
                        if (mode != 0) mm = sp[idx + 16384];
                        f32x4 a = acc[ai][bj][m][n];
                        if (isg) { a[0] = sigmoidf_(a[0]); a[1] = sigmoidf_(a[1]); a[2] = sigmoidf_(a[2]); a[3] = sigmoidf_(a[3]); }
                        const float r0 = bflo(mm[0]) + a[0] * bflo(uu[0]);
                        const float r1 = bfhi(mm[0]) + a[1] * bfhi(uu[0]);
                        const float r2 = bflo(mm[1]) + a[2] * bflo(uu[1]);
                        const float r3 = bfhi(mm[1]) + a[3] * bfhi(uu[1]);
                        u32x2 o; o[0] = pack2(r0, r1); o[1] = pack2(r2, r3);
                        if (mode == 2) *(u32x2*)(rowp + bj * 128 + n * 16) = o; else sp[idx + 16384] = o;
                    }
                sp += 4 * 512; gp += 4 * 512;
            }
    }
}

DI bool p1_unit(const Params& p, int L, Unit& u) {
    if (L >= 2688) return false;
    u.K = 2048; u.kind = EPI_BF16; u.aux = 0; u.X = nullptr; u.Gp = nullptr;
    const char* ws = (const char*)p.ws;
    if (L < 2368) {
        const int gid = L / 296, rem = L - gid * 296, pm = gid * 8 + (rem & 7), ct = rem >> 3;
        int brow, col, ldc; size_t cb;
        if (ct < 8) { brow = ct * 256; cb = OFF_PA; col = ct * 256; ldc = 3072; }
        else if (ct < 12) { brow = 3072 + (ct - 8) * 256; cb = OFF_PA; col = 2048 + (ct - 8) * 256; ldc = 3072; }
        else if (ct < 28) { brow = 4096 + (ct - 12) * 256; cb = OFF_PB; col = (ct - 12) * 256; ldc = 4096; }
        else if (ct == 28) { brow = 8192; cb = OFF_PL; col = 0; ldc = 256; }
        else { brow = 8320 + (ct - 29) * 256; cb = OFF_PC; col = (ct - 29) * 256; ldc = 2048; }
        u.A = ws + OFF_H + (size_t)pm * 256 * 4096; u.B = ws + OFF_WT + (size_t)brow * 4096;
        u.C = (char*)p.ws + cb + ((size_t)pm * 256 * ldc + col) * 2; u.ldc = ldc;
    } else if (L < 2624) {
        const int l = L - 2368, pm = l & 3, pn = l >> 2;
        u.A = ws + OFF_WT + (size_t)(2048 + pm * 256) * 4096; u.B = ws + OFF_H + (size_t)pn * 256 * 4096;
        u.C = (char*)p.ws + OFF_VT + ((size_t)pm * 256 * T_TOK + pn * 256) * 2; u.ldc = T_TOK;
    } else if (L < 2656) {
        const int l = L - 2624, pm = l & 7, pn = l >> 3;
        u.A = ws + OFF_M + (size_t)pm * 256 * 4096; u.B = ws + OFF_WMEM + (size_t)pn * 256 * 4096;
        u.C = (char*)p.ws + OFF_MK + ((size_t)pm * 256 * 1024 + pn * 256) * 2; u.ldc = 1024;
    } else {
        const int l = L - 2656, pm = l & 3, pn = l >> 2;
        u.A = ws + OFF_WMEM + (size_t)(1024 + pm * 256) * 4096; u.B = ws + OFF_M + (size_t)pn * 256 * 4096;
        u.C = (char*)p.ws + OFF_MVT + ((size_t)pm * 256 * 2048 + pn * 256) * 2; u.ldc = 2048;
    }
    return true;
}
DI void tile_pmpn(int tl, int& pm, int& pn) { pm = (tl & 7) + 8 * (tl >> 6); pn = (tl >> 3) & 7; }
constexpr int PG_N = 1;
DI bool p3_unit(const Params& p, int cp, int ui, Unit& u) {
    if (ui >= 12 - PG_N) return false;
    const bool light = ui >= 6;
    int x, isgate; bool pre = false;
    if (!light) { x = ui >> 1; isgate = ui & 1; }
    else { const int li = ui - 6; if (li < PG_N) { x = li; isgate = 0; pre = true; } else { const int r = li - PG_N; x = PG_N + (r >> 1); isgate = r & 1; } }
    const int tl = light ? 256 + cp : cp;
    int pm, pn; tile_pmpn(tl, pm, pn);
    const char* ws = (const char*)p.ws; const char* yo = (const char*)p.out;
    u.X = nullptr; u.ldc = 2048; u.Gp = nullptr;
    u.C = (char*)p.ws + OFF_MERGED + ((size_t)pm * 256 * 2048 + pn * 256) * 2;
    if (!isgate) {
        u.K = 1024; u.kind = pre ? EPI_UPG : EPI_UP; u.aux = pre ? x : 0;
        u.A = yo + (size_t)x * OFF_YB + (size_t)pm * 256 * 2048;
        u.B = ws + (x == 0 ? OFF_WUA : (x == 1 ? OFF_WUB : OFF_WUC)) + (size_t)pn * 256 * 2048;
        if (pre) u.Gp = ws + OFF_G + (size_t)(cp * 3 + x) * 131072;
    } else {
        u.K = 2048; u.kind = EPI_GATE; u.aux = x;
        u.A = ws + OFF_H + (size_t)pm * 256 * 4096;
        u.B = ws + OFF_WT + (size_t)(10368 + 2048 * x + 256 * pn) * 4096;
    }
    return true;
}
DI bool pg_unit(const Params& p, int ui, Unit& u) {
    if (ui >= 2 * PG_N) return false;
    const int lt = 2 * ((int)blockIdx.x - 128) + ui / PG_N, x = ui % PG_N;
    int pm, pn; tile_pmpn(256 + lt, pm, pn);
    const char* ws = (const char*)p.ws;
    u.X = nullptr; u.ldc = 0; u.Gp = nullptr; u.aux = 0;
    u.K = 2048; u.kind = EPI_SIG;
    u.A = ws + OFF_H + (size_t)pm * 256 * 4096;
    u.B = ws + OFF_WT + (size_t)(10368 + 2048 * x + 256 * pn) * 4096;
    u.C = (char*)p.ws + OFF_G + (size_t)(lt * 3 + x) * 131072;
    return true;
}
DI bool p4_unit(const Params& p, int cp, int ui, Unit& u) {
    const int tl = cp + p.G * ui;
    if (tl >= 512) return false;
    int pm, pn; tile_pmpn(tl, pm, pn);
    const char* ws = (const char*)p.ws;
    u.K = 2048; u.kind = EPI_OUT; u.aux = 0; u.ldc = 2048; u.Gp = nullptr;
    u.A = ws + OFF_MERGED + (size_t)pm * 256 * 4096; u.B = ws + OFF_WO + (size_t)pn * 256 * 4096;
    u.C = (char*)(p.out + (size_t)pm * 256 * 2048 + pn * 256);
    u.X = p.in[I_X] + (size_t)pm * 256 * 2048 + pn * 256;
    return true;
}
template <int PH> DI bool get_unit(const Params& p, int cp, int ui, Unit& u) {
    if (PH == 1) return p1_unit(p, ui * p.G + cp, u);
    if (PH == 3) return p3_unit(p, cp, ui, u);
    if (PH == 5) return pg_unit(p, ui, u);
    return p4_unit(p, cp, ui, u);
}

template <int PH>
DI void gemm_phase(LAS unsigned char* lds, const Params& p) {
    int tid = threadIdx.x; asm volatile("" : "+v"(tid));
    const int wid = __builtin_amdgcn_readfirstlane(tid >> 6), lane = tid & 63, wr = wid >> 2, wc = wid & 3, fr = lane & 15, fq = lane >> 4;
    const int c = blockIdx.x, cp = (p.G & 7) == 0 ? (c & 7) * (p.G >> 3) + (c >> 3) : c;
    char* scr = (char*)p.ws + OFF_SCR + (size_t)c * SCR_PER_WG;
    int sR[2], sC[2];
#pragma unroll
    for (int i = 0; i < 2; ++i) stage_rc(tid * 16 + i * 8192, sR[i], sC[i]);
    const unsigned ldsw = (unsigned)wid * 1024u;
    const int aoff = lds_byte(wr * 64 + fr, fq * 8), boff = lds_byte(wc * 32 + fr, fq * 8);
#define G_SA(b, h) (((b) * 2 + (h)) * HTB)
#define G_SB(b, h) ((4 + (b) * 2 + (h)) * HTB)
#define G_STAGE(bufoff, gbase, KK) do { _Pragma("unroll") for (int _i = 0; _i < 2; ++_i) \
        __builtin_amdgcn_global_load_lds((const unsigned*)((gbase) + (size_t)(unsigned)((sR[_i] * (KK) + sC[_i]) * 2)), (LAS unsigned*)(lds + (bufoff) + ldsw + _i * 8192), 16, 0, 0); } while (0)
#define G_LDA(dst, b, h) do { _Pragma("unroll") for (int m = 0; m < 4; ++m) _Pragma("unroll") for (int k = 0; k < 2; ++k) dst[m][k] = *(const LAS bf16x8*)(lds + G_SA(b, h) + aoff + m * 2048 + k * 1024); } while (0)
#define G_LDB(dst, b, h) do { _Pragma("unroll") for (int n = 0; n < 2; ++n) _Pragma("unroll") for (int k = 0; k < 2; ++k) dst[n][k] = *(const LAS bf16x8*)(lds + G_SB(b, h) + boff + n * 2048 + k * 1024); } while (0)
#define G_MMA(ai, bj, At, Bt) do { __builtin_amdgcn_s_setprio(1); _Pragma("unroll") for (int m = 0; m < 4; ++m) _Pragma("unroll") for (int n = 0; n < 2; ++n) _Pragma("unroll") for (int k = 0; k < 2; ++k) \
        acc[ai][bj][m][n] = __builtin_amdgcn_mfma_f32_16x16x32_bf16(Bt[n][k], At[m][k], acc[ai][bj][m][n], 0, 0, 0); __builtin_amdgcn_s_setprio(0); } while (0)
#define G_WAIT_V(n) asm volatile("s_waitcnt vmcnt(" #n ")" ::: "memory")
#define G_WAIT_L(n) asm volatile("s_waitcnt lgkmcnt(" #n ")" ::: "memory")
#define G_BAR __builtin_amdgcn_s_barrier()
#define G_SCHED __builtin_amdgcn_sched_barrier(0)
    Unit cur, nxt; int ui = 0;
    if (!get_unit<PH>(p, cp, 0, cur)) return;
    f32x4 acc[2][2][4][2];
#pragma unroll
    for (int a = 0; a < 2; ++a)
#pragma unroll
        for (int b = 0; b < 2; ++b)
#pragma unroll
            for (int m = 0; m < 4; ++m)
#pragma unroll
                for (int n = 0; n < 2; ++n) acc[a][b][m][n] = (f32x4){0.f, 0.f, 0.f, 0.f};
    bf16x8 At[4][2], B0[2][2], B1[2][2];
    const char* cA = cur.A; const char* cB = cur.B; int Kc = cur.K;
    {
        const size_t hs = (size_t)HALF * Kc * 2;
        G_STAGE(G_SB(0, 0), cB, Kc); G_STAGE(G_SA(0, 0), cA, Kc); G_STAGE(G_SB(0, 1), cB + hs, Kc); G_STAGE(G_SA(0, 1), cA + hs, Kc);
        if (wr == 1) G_BAR;
        G_WAIT_V(4); G_BAR;
        G_STAGE(G_SB(1, 0), cB + 128, Kc); G_STAGE(G_SA(1, 0), cA + 128, Kc); G_STAGE(G_SB(1, 1), cB + hs + 128, Kc);
        G_WAIT_V(6); G_BAR;
    }
    for (;;) {
        const bool has_next = get_unit<PH>(p, cp, ui + 1, nxt);
        const char* nA = has_next ? nxt.A : cA; const char* nB = has_next ? nxt.B : cB; const int Kn = has_next ? nxt.K : Kc;
        const int nt = Kc / BK;
        const size_t hsc = (size_t)HALF * Kc * 2;
        for (int t = 0; t < nt; t += 2) {
            const bool last = (t == nt - 2);
            const char* a1 = cA + (size_t)(t + 1) * 128;
            const int K2 = last ? Kn : Kc;
            const size_t hs2 = (size_t)HALF * K2 * 2;
            const char* a2 = last ? nA : cA + (size_t)(t + 2) * 128; const char* b2 = last ? nB : cB + (size_t)(t + 2) * 128;
            const char* a3 = a2 + 128; const char* b3 = b2 + 128;
            G_LDB(B0, 0, 0); G_SCHED; G_LDA(At, 0, 0); G_STAGE(G_SA(1, 1), a1 + hsc, Kc);
            G_WAIT_L(8); G_BAR; G_WAIT_L(0); G_MMA(0, 0, At, B0); G_BAR; G_SCHED;
            G_LDB(B1, 0, 1); G_STAGE(G_SB(0, 0), b2, K2);
            G_BAR; G_WAIT_L(0); G_MMA(0, 1, At, B1); G_BAR;
            G_LDA(At, 0, 1); G_STAGE(G_SA(0, 0), a2, K2);
            G_BAR; G_WAIT_L(0); G_MMA(1, 0, At, B0); G_BAR; G_SCHED;
            G_STAGE(G_SB(0, 1), b2 + hs2, K2);
            G_WAIT_V(6); G_BAR; G_MMA(1, 1, At, B1); G_BAR;
            G_LDB(B0, 1, 0); G_SCHED; G_LDA(At, 1, 0); G_STAGE(G_SA(0, 1), a2 + hs2, K2);
            G_WAIT_L(8); G_BAR; G_WAIT_L(0); G_MMA(0, 0, At, B0); G_BAR; G_SCHED;
            G_LDB(B1, 1, 1); G_STAGE(G_SB(1, 0), b3, K2);
            G_BAR; G_WAIT_L(0); G_MMA(0, 1, At, B1); G_BAR;
            G_LDA(At, 1, 1); G_STAGE(G_SA(1, 0), a3, K2);
            G_BAR; G_WAIT_L(0); G_MMA(1, 0, At, B0); G_BAR; G_SCHED;
            G_STAGE(G_SB(1, 1), b3 + hs2, K2);
            G_WAIT_V(6); G_BAR; G_MMA(1, 1, At, B1); G_BAR;
        }
        epilogue(acc, cur, wr, wc, fr, fq, tid, scr);
        if (!has_next) break;
#pragma unroll
        for (int a = 0; a < 2; ++a)
#pragma unroll
            for (int b = 0; b < 2; ++b)
#pragma unroll
                for (int m = 0; m < 4; ++m)
#pragma unroll
                    for (int n = 0; n < 2; ++n) acc[a][b][m][n] = (f32x4){0.f, 0.f, 0.f, 0.f};
        cur = nxt; cA = nA; cB = nB; Kc = Kn; ++ui;
    }
    G_WAIT_V(0);
    if (wr == 0) G_BAR;
    G_BAR;
}

constexpr int SB_W = 0, SB_KK = 8192, SB_BV = 16384, SB_KP = 24576, SB_R = 32768, SB_V = 40960, SB_O = 49152, SB_SIZE = 57344;
constexpr int SC_AWD = 114688, SC_AAD = 119296;
constexpr int SC_ASTR = 144;
DI void ld8(const bf16_t* ptr, float (&f)[8]) {
    const u32x4 v = *(const u32x4*)ptr;
#pragma unroll
    for (int i = 0; i < 4; ++i) { f[2 * i] = bflo(v[i]); f[2 * i + 1] = bfhi(v[i]); }
}
struct ScanOps { f32x4 w0, w1, a0, a1, b0, b1, k0, k1, r0, r1; f32x2 v; };
DI void scan_load(ScanOps& o, const LAS unsigned char* bp, const LAS unsigned char* vp) {
    o.w0 = *(const LAS f32x4*)(bp + SB_W); o.w1 = *(const LAS f32x4*)(bp + SB_W + 16);
    o.a0 = *(const LAS f32x4*)(bp + SB_KK); o.a1 = *(const LAS f32x4*)(bp + SB_KK + 16);
    o.b0 = *(const LAS f32x4*)(bp + SB_BV); o.b1 = *(const LAS f32x4*)(bp + SB_BV + 16);
    o.k0 = *(const LAS f32x4*)(bp + SB_KP); o.k1 = *(const LAS f32x4*)(bp + SB_KP + 16);
    o.r0 = *(const LAS f32x4*)(bp + SB_R); o.r1 = *(const LAS f32x4*)(bp + SB_R + 16);
    o.v = *(const LAS f32x2*)vp;
}
DI f32x2 lo2(f32x4 x) { return (f32x2){x[0], x[1]}; }
DI f32x2 hi2(f32x4 x) { return (f32x2){x[2], x[3]}; }
DI f32x2 splat2(float x) { return (f32x2){x, x}; }
DI void scan_step(f32x2 (&S0)[4], f32x2 (&S1)[4], const ScanOps& o, LAS unsigned char* op, bool wr) {
    const f32x2 kk[4] = {lo2(o.a0), hi2(o.a0), lo2(o.a1), hi2(o.a1)};
    f32x2 p0 = S0[0] * kk[0], p1 = S1[0] * kk[0];
#pragma unroll
    for (int q = 1; q < 4; ++q) { p0 = __builtin_elementwise_fma(S0[q], kk[q], p0); p1 = __builtin_elementwise_fma(S1[q], kk[q], p1); }
    const float sa0 = -reduce8(p0[0] + p0[1]), sa1 = -reduce8(p1[0] + p1[1]);
    const f32x2 ww[4] = {lo2(o.w0), hi2(o.w0), lo2(o.w1), hi2(o.w1)};
    const f32x2 bb[4] = {lo2(o.b0), hi2(o.b0), lo2(o.b1), hi2(o.b1)};
    const f32x2 kv[4] = {lo2(o.k0), hi2(o.k0), lo2(o.k1), hi2(o.k1)};
    const f32x2 rr[4] = {lo2(o.r0), hi2(o.r0), lo2(o.r1), hi2(o.r1)};
    const f32x2 v0 = splat2(o.v[0]), v1 = splat2(o.v[1]), s0 = splat2(sa0), s1 = splat2(sa1);
#pragma unroll
    for (int q = 0; q < 4; ++q) {
        const f32x2 t0 = __builtin_elementwise_fma(bb[q], s0, kv[q] * v0), t1 = __builtin_elementwise_fma(bb[q], s1, kv[q] * v1);
        S0[q] = __builtin_elementwise_fma(S0[q], ww[q], t0); S1[q] = __builtin_elementwise_fma(S1[q], ww[q], t1);
    }
    f32x2 q0 = S0[0] * rr[0], q1 = S1[0] * rr[0];
#pragma unroll
    for (int q = 1; q < 4; ++q) { q0 = __builtin_elementwise_fma(S0[q], rr[q], q0); q1 = __builtin_elementwise_fma(S1[q], rr[q], q1); }
    const float o0 = reduce8(q0[0] + q0[1]), o1 = reduce8(q1[0] + q1[1]);
    if (wr) *(LAS f32x2*)op = (f32x2){o0, o1};
}
DI void scan_item(const Params& p, unsigned char* smem, int item) {
    const int b = item >> 4, h = item & 15;
    int tid = threadIdx.x; asm volatile("" : "+v"(tid));
    const int wid = __builtin_amdgcn_readfirstlane(tid >> 6), lane = tid & 63;
    const bf16_t* PB = (const bf16_t*)(p.ws + OFF_PB);
    const bf16_t* PL = (const bf16_t*)(p.ws + OFF_PL);
    bf16_t* YB = (bf16_t*)((char*)p.out + OFF_YB);
    LAS unsigned char* lds = (LAS unsigned char*)smem;
    const bool helper = wid >= 4;
    const int hw = wid & 3, mat = hw >> 1, tn = hw & 1, mr = lane & 31, mh = lane >> 5;
    bf16x8 Bf[4];
    float w0c = 0.f, a0c = 0.f, kac = 0.f;
    if (helper) {
        const float* Wx = (mat == 0 ? p.in[I_W2] : p.in[I_A2]) + h * 64 + tn * 32 + mr;
#pragma unroll
        for (int s = 0; s < 4; ++s) {
            u32x4 pk;
#pragma unroll
            for (int jj = 0; jj < 4; ++jj) pk[jj] = pack2(Wx[(size_t)(16 * s + 8 * mh + 2 * jj) * 1024], Wx[(size_t)(16 * s + 8 * mh + 2 * jj + 1) * 1024]);
            Bf[s] = __builtin_bit_cast(bf16x8, pk);
        }
        const int cj = h * 64 + tn * 32 + mr;
        w0c = p.in[I_W0][cj]; a0c = p.in[I_A0][cj]; kac = p.in[I_KA][cj];
    }
    const int ht = tid & 255, et = ht >> 3, eg = ht & 7, ec = h * 64 + eg * 8;
    float muw[8], mua[8], mur[8], muk[8], muv[8], kkc[8], rkc[8], lnw[8], lnb[8];
    {
        auto ldc = [&](const float* src, float (&d)[8]) { const f32x4 a = *(const f32x4*)src, bq = *(const f32x4*)(src + 4); d[0] = a[0]; d[1] = a[1]; d[2] = a[2]; d[3] = a[3]; d[4] = bq[0]; d[5] = bq[1]; d[6] = bq[2]; d[7] = bq[3]; };
        ldc(p.in[I_MUW] + eg * 8, muw); ldc(p.in[I_MUA] + eg * 8, mua);
        ldc(p.in[I_MURKV] + ec, mur); ldc(p.in[I_MURKV] + 1024 + ec, muk); ldc(p.in[I_MURKV] + 2048 + ec, muv);
        ldc(p.in[I_KK] + ec, kkc); ldc(p.in[I_RK] + ec, rkc); ldc(p.in[I_LNW] + ec, lnw); ldc(p.in[I_LNB] + ec, lnb);
    }
    u32x4 L[10]; u32x4 Z;
#pragma unroll
    for (int i = 0; i < 10; ++i) L[i] = (u32x4){0u, 0u, 0u, 0u};
    Z = (u32x4){0u, 0u, 0u, 0u};
    auto loadA = [&](int ch) {
        const size_t row = (size_t)b * SEQ + ch * 32 + et;
        const size_t prow = (ch * 32 + et) > 0 ? row - 1 : row;
        L[0] = *(const u32x4*)(PL + row * 256 + eg * 8); L[1] = *(const u32x4*)(PL + prow * 256 + eg * 8);
        L[2] = *(const u32x4*)(PL + row * 256 + 64 + eg * 8); L[3] = *(const u32x4*)(PL + prow * 256 + 64 + eg * 8);
#pragma unroll
        for (int q = 0; q < 3; ++q) { L[4 + 2 * q] = *(const u32x4*)(PB + row * 4096 + q * 1024 + ec); L[5 + 2 * q] = *(const u32x4*)(PB + prow * 4096 + q * 1024 + ec); }
    };
    auto loadZ = [&](int ch) { Z = *(const u32x4*)(PB + ((size_t)b * SEQ + ch * 32 + et) * 4096 + 3072 + ec); };
    auto unp = [&](const u32x4& v, float (&f)[8]) {
#pragma unroll
        for (int i = 0; i < 4; ++i) { f[2 * i] = bflo(v[i]); f[2 * i + 1] = bfhi(v[i]); } };
    auto stepA = [&](int ch, int buf) {
        const float pm = (ch * 32 + et) > 0 ? 1.0f : 0.0f;
        LAS unsigned char* bb = lds + buf * SB_SIZE;
        float cur[8], prv[8], x[8];
        unp(L[0], cur); unp(L[1], prv);
        u32x4 o;
#pragma unroll
        for (int i = 0; i < 8; ++i) { const float xx = cur[i] + muw[i] * (prv[i] * pm - cur[i]); x[i] = 1.0f - 2.0f * __builtin_amdgcn_rcpf(1.0f + __expf(2.0f * xx)); }
        o[0] = pack2(x[0], x[1]); o[1] = pack2(x[2], x[3]); o[2] = pack2(x[4], x[5]); o[3] = pack2(x[6], x[7]);
        *(LAS u32x4*)(lds + SC_AWD + et * SC_ASTR + eg * 16) = o;
        unp(L[2], cur); unp(L[3], prv);
#pragma unroll
        for (int i = 0; i < 8; ++i) x[i] = cur[i] + mua[i] * (prv[i] * pm - cur[i]);
        o[0] = pack2(x[0], x[1]); o[1] = pack2(x[2], x[3]); o[2] = pack2(x[4], x[5]); o[3] = pack2(x[6], x[7]);
        *(LAS u32x4*)(lds + SC_AAD + et * SC_ASTR + eg * 16) = o;
#pragma unroll
        for (int q = 0; q < 3; ++q) {
            unp(L[4 + 2 * q], cur); unp(L[5 + 2 * q], prv);
#pragma unroll
            for (int i = 0; i < 8; ++i) { const float m = q == 0 ? mur[i] : (q == 1 ? muk[i] : muv[i]); x[i] = cur[i] + m * (prv[i] * pm - cur[i]); }
            const int dsto = (q == 0 ? SB_R : (q == 1 ? SB_KP : SB_V)) + et * 256 + eg * 32;
            *(LAS f32x4*)(bb + dsto) = (f32x4){x[0], x[1], x[2], x[3]};
            *(LAS f32x4*)(bb + dsto + 16) = (f32x4){x[4], x[5], x[6], x[7]};
            if (q == 1) {
                float kk[8]; float ss = 0.f;
#pragma unroll
                for (int i = 0; i < 8; ++i) { kk[i] = x[i] * kkc[i]; ss += kk[i] * kk[i]; }
                ss = reduce8(ss);
                const float rn = rsqrtf(fmaxf(ss, 1e-24f));
                *(LAS f32x4*)(bb + SB_KK + et * 256 + eg * 32) = (f32x4){kk[0] * rn, kk[1] * rn, kk[2] * rn, kk[3] * rn};
                *(LAS f32x4*)(bb + SB_KK + et * 256 + eg * 32 + 16) = (f32x4){kk[4] * rn, kk[5] * rn, kk[6] * rn, kk[7] * rn};
            }
        }
    };
    auto stepB = [&](int buf) {
        LAS unsigned char* bb = lds + buf * SB_SIZE;
        f32x16 acc;
#pragma unroll
        for (int i = 0; i < 16; ++i) acc[i] = 0.f;
        const int abase = (mat == 0 ? SC_AWD : SC_AAD) + mr * SC_ASTR + mh * 16;
#pragma unroll
        for (int s = 0; s < 4; ++s) { const bf16x8 a = *(const LAS bf16x8*)(lds + abase + s * 32); acc = MFMA32(a, Bf[s], acc); }
        const int jcol = tn * 32 + mr;
#pragma unroll
        for (int i = 0; i < 16; ++i) {
            const int t = crow(i, mh);
            if (mat == 0) {
                const float y = -(w0c + acc[i]);
                const float sp = fmaxf(y, 0.f) + __logf(1.0f + __expf(-fabsf(y)));
                const float w = -sp - 0.5f;
                *(LAS float*)(bb + SB_W + t * 256 + jcol * 4) = __expf(-__expf(w));
            } else {
                const float a = sigmoidf_(a0c + acc[i]);
                const float kl = *(LAS float*)(bb + SB_KP + t * 256 + jcol * 4);
                const float kk = *(LAS float*)(bb + SB_KK + t * 256 + jcol * 4);
                *(LAS float*)(bb + SB_KP + t * 256 + jcol * 4) = kl * (1.0f + (a - 1.0f) * kac);
                *(LAS float*)(bb + SB_BV + t * 256 + jcol * 4) = kk * a;
            }
        }
    };
    auto epi = [&](int ch, int buf) {
        const size_t row = (size_t)b * SEQ + ch * 32 + et;
        LAS unsigned char* bb = lds + buf * SB_SIZE;
        const f32x4 o0 = *(const LAS f32x4*)(bb + SB_O + et * 256 + eg * 32), o1 = *(const LAS f32x4*)(bb + SB_O + et * 256 + eg * 32 + 16);
        float o[8] = {o0[0], o0[1], o0[2], o0[3], o1[0], o1[1], o1[2], o1[3]};
        float sm = 0.f;
#pragma unroll
        for (int i = 0; i < 8; ++i) sm += o[i];
        const float mean = reduce8(sm) * (1.0f / 64.0f);
        float sv = 0.f;
#pragma unroll
        for (int i = 0; i < 8; ++i) { const float d = o[i] - mean; sv += d * d; }
        const float rstd = rsqrtf(reduce8(sv) * (1.0f / 64.0f) + 64e-5f);
        const f32x4 r0 = *(const LAS f32x4*)(bb + SB_R + et * 256 + eg * 32), r1 = *(const LAS f32x4*)(bb + SB_R + et * 256 + eg * 32 + 16);
        const f32x4 k0 = *(const LAS f32x4*)(bb + SB_KP + et * 256 + eg * 32), k1 = *(const LAS f32x4*)(bb + SB_KP + et * 256 + eg * 32 + 16);
        float bs = r0[0] * k0[0] * rkc[0] + r0[1] * k0[1] * rkc[1] + r0[2] * k0[2] * rkc[2] + r0[3] * k0[3] * rkc[3]
                 + r1[0] * k1[0] * rkc[4] + r1[1] * k1[1] * rkc[5] + r1[2] * k1[2] * rkc[6] + r1[3] * k1[3] * rkc[7];
        bs = reduce8(bs);
        const f32x4 v0 = *(const LAS f32x4*)(bb + SB_V + et * 256 + eg * 32), v1 = *(const LAS f32x4*)(bb + SB_V + et * 256 + eg * 32 + 16);
        float z[8]; unp(Z, z);
        float y[8];
#pragma unroll
        for (int i = 0; i < 8; ++i) {
            const float vv = i < 4 ? v0[i] : v1[i - 4];
            y[i] = ((o[i] - mean) * rstd * lnw[i] + lnb[i] + bs * vv) * siluf_(z[i]);
        }
        u32x4 ov; ov[0] = pack2(y[0], y[1]); ov[1] = pack2(y[2], y[3]); ov[2] = pack2(y[4], y[5]); ov[3] = pack2(y[6], y[7]);
        *(u32x4*)(YB + row * 1024 + ec) = ov;
    };

    if (helper) {
        loadA(0); stepA(0, 0); loadA(1);
        __syncthreads();
        stepB(0);
        __syncthreads();
#pragma unroll 1
        for (int ch = 0; ch < SEQ / 32; ++ch) {
            const int buf = ch & 1;
            if (ch > 0) epi(ch - 1, buf ^ 1);
            if (ch + 1 < SEQ / 32) stepA(ch + 1, buf ^ 1);
            if (ch + 2 < SEQ / 32) loadA(ch + 2);
            __syncthreads();
            if (ch + 1 < SEQ / 32) stepB(buf ^ 1);
            loadZ(ch);
            __syncthreads();
        }
        epi(SEQ / 32 - 1, 1);
        __syncthreads();
    } else {
        const int il = lane >> 3, jl = lane & 7, row0 = (wid & 3) * 16 + il * 2;
        f32x2 S0[4], S1[4];
#pragma unroll
        for (int q = 0; q < 4; ++q) { S0[q] = (f32x2){0.f, 0.f}; S1[q] = (f32x2){0.f, 0.f}; }
        __syncthreads();
        __syncthreads();
#pragma unroll 1
        for (int ch = 0; ch < SEQ / 32; ++ch) {
            const int buf = ch & 1;
            const LAS unsigned char* bp = lds + buf * SB_SIZE + jl * 32;
            const LAS unsigned char* vp = lds + buf * SB_SIZE + SB_V + row0 * 4;
            LAS unsigned char* op = lds + buf * SB_SIZE + SB_O + row0 * 4;
#pragma unroll 1
            for (int half = 0; half < 2; ++half) {
                ScanOps oa, ob;
                scan_load(oa, bp + half * 16 * 256, vp + half * 16 * 256);
#pragma unroll 1
                for (int t = half * 16; t < half * 16 + 16; t += 2) {
                    scan_load(ob, bp + (t + 1) * 256, vp + (t + 1) * 256);
                    scan_step(S0, S1, oa, op + t * 256, jl == 0);
                    scan_load(oa, bp + (t + 2) * 256, vp + (t + 2) * 256);
                    scan_step(S0, S1, ob, op + (t + 1) * 256, jl == 0);
                }
                __syncthreads();
            }
        }
        __syncthreads();
    }
}

template <int HD> struct AttnCfg { static constexpr int KSTR = HD * 2 + 16, VSTR = 136, VROWS = HD, K_OFF = 0, V_OFF = 64 * KSTR, BIAS_OFF = V_OFF + VROWS * VSTR; };

template <int HD>
DI void attn_load_q(bf16x8 (&Qf)[HD / 16], const bf16_t* qrow, const float* g, float scale, int mh) {
    u32x4 raw[HD / 16]; float ss = 0.f;
#pragma unroll
    for (int s = 0; s < HD / 16; ++s) {
        raw[s] = *(const u32x4*)(qrow + 16 * s + 8 * mh);
#pragma unroll
        for (int i = 0; i < 4; ++i) { const float a = bflo(raw[s][i]), bb = bfhi(raw[s][i]); ss += a * a + bb * bb; }
    }
    ss += __shfl_xor(ss, 32);
    const float rstd = rsqrtf(ss * (1.0f / HD) + 1e-6f) * scale;
#pragma unroll
    for (int s = 0; s < HD / 16; ++s) {
        const f32x4 g0 = *(const f32x4*)(g + 16 * s + 8 * mh), g1 = *(const f32x4*)(g + 16 * s + 8 * mh + 4);
        u32x4 o;
        o[0] = pack2(bflo(raw[s][0]) * rstd * g0[0], bfhi(raw[s][0]) * rstd * g0[1]);
        o[1] = pack2(bflo(raw[s][1]) * rstd * g0[2], bfhi(raw[s][1]) * rstd * g0[3]);
        o[2] = pack2(bflo(raw[s][2]) * rstd * g1[0], bfhi(raw[s][2]) * rstd * g1[1]);
        o[3] = pack2(bflo(raw[s][3]) * rstd * g1[2], bfhi(raw[s][3]) * rstd * g1[3]);
        Qf[s] = __builtin_bit_cast(bf16x8, o);
    }
}
template <int HD>
DI void attn_load_k(LAS unsigned char* lds, const bf16_t* ksrc, size_t ldk, const float* gk, int tid) {
    constexpr int EPT = HD / 8;
    const int key = tid >> 3, part = tid & 7;
    const bf16_t* src = ksrc + (size_t)key * ldk + part * EPT;
    u32x4 raw[EPT / 8]; float ss = 0.f;
#pragma unroll
    for (int v = 0; v < EPT / 8; ++v) {
        raw[v] = *(const u32x4*)(src + v * 8);
#pragma unroll
        for (int i = 0; i < 4; ++i) { const float a = bflo(raw[v][i]), bb = bfhi(raw[v][i]); ss += a * a + bb * bb; }
    }
    ss = reduce8(ss);
    const float rstd = rsqrtf(ss * (1.0f / HD) + 1e-6f);
#pragma unroll
    for (int v = 0; v < EPT / 8; ++v) {
        const float* gp = gk + part * EPT + v * 8;
        const f32x4 g0 = *(const f32x4*)gp, g1 = *(const f32x4*)(gp + 4);
        u32x4 o;
        o[0] = pack2(bflo(raw[v][0]) * rstd * g0[0], bfhi(raw[v][0]) * rstd * g0[1]);
        o[1] = pack2(bflo(raw[v][1]) * rstd * g0[2], bfhi(raw[v][1]) * rstd * g0[3]);
        o[2] = pack2(bflo(raw[v][2]) * rstd * g1[0], bfhi(raw[v][2]) * rstd * g1[1]);
        o[3] = pack2(bflo(raw[v][3]) * rstd * g1[2], bfhi(raw[v][3]) * rstd * g1[3]);
        *(LAS u32x4*)(lds + AttnCfg<HD>::K_OFF + key * AttnCfg<HD>::KSTR + (part * EPT + v * 8) * 2) = o;
    }
}
template <int HD>
DI void attn_load_v(LAS unsigned char* lds, const bf16_t* vsrc, size_t ldv, int tid) {
    constexpr int TPR = 512 / HD, KPT = 64 / TPR;
    const int d = tid / TPR, part = tid % TPR;
    const bf16_t* src = vsrc + (size_t)d * ldv + part * KPT;
#pragma unroll
    for (int v = 0; v < KPT / 8; ++v) {
        const u32x4 raw = *(const u32x4*)(src + v * 8);
        LAS unsigned char* dp = lds + AttnCfg<HD>::V_OFF + d * AttnCfg<HD>::VSTR + (part * KPT + v * 8) * 2;
        *(LAS u32x2*)dp = (u32x2){raw[0], raw[1]};
        *(LAS u32x2*)(dp + 8) = (u32x2){raw[2], raw[3]};
    }
}
template <int HD, bool BIAS, bool QLDS>
DI void attn_chunk(const bf16x8 (&Qf)[HD / 16], const LAS unsigned char* qp, f32x16 (&O)[4], float& m_run, float& l_run, const LAS unsigned char* lds, int dbase, int mr, int mh, int qk_delta) {
#pragma unroll 1
    for (int kt = 0; kt < 2; ++kt) {
        f32x16 sc;
#pragma unroll
        for (int i = 0; i < 16; ++i) sc[i] = 0.f;
        const LAS unsigned char* kp = lds + AttnCfg<HD>::K_OFF + (kt * 32 + mr) * AttnCfg<HD>::KSTR + mh * 16;
#pragma unroll
        for (int s = 0; s < HD / 16; ++s) { if ((s & 3) == 0) __builtin_amdgcn_sched_barrier(0); const bf16x8 a = *(const LAS bf16x8*)(kp + s * 32); const bf16x8 qb = QLDS ? *(const LAS bf16x8*)(qp + s * 32) : Qf[s]; sc = MFMA32(a, qb, sc); }
        float mx = -1e30f;
#pragma unroll
        for (int i = 0; i < 16; ++i) {
            if (BIAS) {
                int dist = qk_delta + mr - (kt * 32 + crow(i, mh));
                dist = dist < -128 ? -128 : (dist > 128 ? 128 : dist);
                sc[i] += *(const LAS float*)(lds + AttnCfg<HD>::BIAS_OFF + (dist + 128) * 4);
            }
            mx = fmaxf(mx, sc[i]);
        }
        mx = fmaxf(mx, __shfl_xor(mx, 32));
        const float m_new = fmaxf(m_run, mx), alpha = __expf(m_run - m_new);
        float ls = 0.f;
#pragma unroll
        for (int i = 0; i < 16; ++i) { const float pv = __expf(sc[i] - m_new); sc[i] = pv; ls += pv; }
        l_run = l_run * alpha + ls; m_run = m_new;
#pragma unroll
        for (int dt = 0; dt < 4; ++dt)
#pragma unroll
            for (int i = 0; i < 16; ++i) O[dt][i] *= alpha;
#pragma unroll
        for (int s2 = 0; s2 < 2; ++s2) {
            u32x4 pk;
#pragma unroll
            for (int j = 0; j < 4; ++j) pk[j] = pack2(sc[8 * s2 + 2 * j], sc[8 * s2 + 2 * j + 1]);
            const bf16x8 pb = __builtin_bit_cast(bf16x8, pk);
#pragma unroll
            for (int dt = 0; dt < 4; ++dt) {
                const LAS unsigned char* vp = lds + AttnCfg<HD>::V_OFF + (dbase + dt * 32 + mr) * AttnCfg<HD>::VSTR + (kt * 32 + 16 * s2 + 4 * mh) * 2;
                const u32x2 lo = *(const LAS u32x2*)vp, hi = *(const LAS u32x2*)(vp + 16);
                const u32x4 va = {lo[0], lo[1], hi[0], hi[1]};
                O[dt] = MFMA32(__builtin_bit_cast(bf16x8, va), pb, O[dt]);
            }
        }
    }
}
DI void attn_store(const f32x16 (&O)[4], float l_run, const bf16_t* zrow, bf16_t* yrow, int mh) {
    const float lt = l_run + __shfl_xor(l_run, 32);
    const float inv = 1.0f / lt;
#pragma unroll
    for (int dt = 0; dt < 4; ++dt)
#pragma unroll
        for (int g = 0; g < 4; ++g) {
            const int d = dt * 32 + 8 * g + 4 * mh;
            const u32x2 zz = *(const u32x2*)(zrow + d);
            u32x2 o;
            o[0] = pack2(O[dt][4 * g] * inv * siluf_(bflo(zz[0])), O[dt][4 * g + 1] * inv * siluf_(bfhi(zz[0])));
            o[1] = pack2(O[dt][4 * g + 2] * inv * siluf_(bflo(zz[1])), O[dt][4 * g + 3] * inv * siluf_(bfhi(zz[1])));
            *(u32x2*)(yrow + d) = o;
        }
}

DI void attnA_item(const Params& p, unsigned char* smem, int item) {
    const int b = item >> 6, head = (item >> 3) & 7, cgp = item & 7;
    int tid = threadIdx.x; asm volatile("" : "+v"(tid));
    const int wid = tid >> 6, lane = tid & 63, mr = lane & 31, mh = lane >> 5;
    LAS unsigned char* lds = (LAS unsigned char*)smem;
    const bf16_t* PA = (const bf16_t*)(p.ws + OFF_PA);
    const bf16_t* VT = (const bf16_t*)(p.ws + OFF_VT);
    bf16_t* YA = (bf16_t*)((char*)p.out + OFF_YA);
    const int cw = cgp * 4 + (wid >> 1), qt = wid & 1;
    const size_t qrow = (size_t)b * SEQ + cw * 64 + qt * 32 + mr;
    if (tid < 257) *(LAS float*)(lds + AttnCfg<128>::BIAS_OFF + tid * 4) = p.in[I_RELB][head * 257 + tid];
    bf16x8 Qf[8];
    attn_load_q<128>(Qf, PA + qrow * 3072 + head * 128, p.in[I_AQG], 0.08838834764831845f, mh);
    f32x16 O[4];
#pragma unroll
    for (int dt = 0; dt < 4; ++dt)
#pragma unroll
        for (int i = 0; i < 16; ++i) O[dt][i] = 0.f;
    float m_run = -1e30f, l_run = 0.f;
    for (int kc = cgp * 4 - 8; kc <= cgp * 4 + 3; ++kc) {
        if (kc < 0) continue;
        __syncthreads();
        attn_load_k<128>(lds, PA + ((size_t)b * SEQ + kc * 64) * 3072 + 1024 + head * 128, 3072, p.in[I_AKG], tid);
        attn_load_v<128>(lds, VT + (size_t)(head * 128) * T_TOK + (size_t)b * SEQ + kc * 64, T_TOK, tid);
        __syncthreads();
        if (kc >= cw - 8 && kc <= cw)
            attn_chunk<128, true, false>(Qf, lds, O, m_run, l_run, lds, 0, mr, mh, (cw - kc) * 64 + qt * 32);
    }
    attn_store(O, l_run, PA + qrow * 3072 + 2048 + head * 128, YA + qrow * 1024 + head * 128, mh);
    __syncthreads();
    if (tid == 0) __hip_atomic_fetch_add((unsigned*)(p.ws + OFF_CTR + 64), 1u, __ATOMIC_RELAXED, __HIP_MEMORY_SCOPE_AGENT);
}
DI void attnC_item(const Params& p, unsigned char* smem, int item) {
    const int b = item >> 6, hc = (item >> 4) & 3, qg = item & 15;
    int tid = threadIdx.x; asm volatile("" : "+v"(tid));
    const int wid = tid >> 6, lane = tid & 63, mr = lane & 31, mh = lane >> 5;
    LAS unsigned char* lds = (LAS unsigned char*)smem;
    const bf16_t* PC = (const bf16_t*)(p.ws + OFF_PC);
    const bf16_t* MK = (const bf16_t*)(p.ws + OFF_MK);
    const bf16_t* MVT = (const bf16_t*)(p.ws + OFF_MVT);
    bf16_t* YC = (bf16_t*)((char*)p.out + OFF_YC);
    const int qt = wid >> 1, dh = wid & 1;
    const size_t qrow = (size_t)b * SEQ + qg * 128 + qt * 32 + mr;
    constexpr int Q_OFF = AttnCfg<256>::V_OFF + 256 * AttnCfg<256>::VSTR;
    __syncthreads();
    {
        bf16x8 Qf[16];
        attn_load_q<256>(Qf, PC + qrow * 2048 + hc * 256, p.in[I_CQG], 0.0625f, mh);
        if (dh == 0) {
#pragma unroll
            for (int s = 0; s < 16; ++s) *(LAS bf16x8*)(lds + Q_OFF + (qt * 32 + mr) * 528 + s * 32 + mh * 16) = Qf[s];
        }
    }
    const LAS unsigned char* qp = lds + Q_OFF + (qt * 32 + mr) * 528 + mh * 16;
    bf16x8 Qd[16];
    f32x16 O[4];
#pragma unroll
    for (int dt = 0; dt < 4; ++dt)
#pragma unroll
        for (int i = 0; i < 16; ++i) O[dt][i] = 0.f;
    float m_run = -1e30f, l_run = 0.f;
    for (int kc = 0; kc < 4; ++kc) {
        __syncthreads();
        attn_load_k<256>(lds, MK + ((size_t)b * NMEM + kc * 64) * 1024 + hc * 256, 1024, p.in[I_CKG], tid);
        attn_load_v<256>(lds, MVT + (size_t)(hc * 256) * 2048 + (size_t)b * NMEM + kc * 64, 2048, tid);
        __syncthreads();
        attn_chunk<256, false, true>(Qd, qp, O, m_run, l_run, lds, dh * 128, mr, mh, 0);
    }
    attn_store(O, l_run, PC + qrow * 2048 + 1024 + hc * 256 + dh * 128, YC + qrow * 1024 + hc * 256 + dh * 128, mh);
    __syncthreads();
}
DI void phase2(const Params& p, unsigned char* smem) {
    const int c = blockIdx.x;
    if (c < 128) scan_item(p, smem, c);
    for (int it = c + p.G; it < 128 && c < 128; it += p.G) scan_item(p, smem, it);
    unsigned* ctr = (unsigned*)(p.ws + OFF_CTR);
    LAS int* sitem = (LAS int*)((LAS unsigned char*)smem + LDS_BYTES - 16);
    auto fetch = [&]() -> int {
        __syncthreads();
        if (threadIdx.x == 0) *sitem = (int)atomicAdd(ctr, 1u);
        __syncthreads();
        return *sitem;
    };
    int item = fetch();
    while (item < 512) { attnA_item(p, smem, item); item = fetch(); }
    while (item < 1024) { attnC_item(p, smem, item - 512); item = fetch(); }
    if (blockIdx.x >= 128 && p.G == 256) {
        if (threadIdx.x == 0) { while (__hip_atomic_load((unsigned*)(p.ws + OFF_CTR + 64), __ATOMIC_RELAXED, __HIP_MEMORY_SCOPE_AGENT) < 512u) __builtin_amdgcn_s_sleep(8); }
        __syncthreads();
        gemm_phase<5>((LAS unsigned char*)smem, p);
    }
}

__global__ void __launch_bounds__(NTHREADS) hybrid_fwd(Params p) {
    extern __shared__ __attribute__((aligned(16))) unsigned char smem[];
    cg::grid_group grid = cg::this_grid();
#ifndef PHMASK
#define PHMASK 31
#endif
    if (PHMASK & 1) phase0(p, smem);
    grid.sync();
    if (PHMASK & 2) gemm_phase<1>((LAS unsigned char*)smem, p);
    grid.sync();
    if (PHMASK & 4) phase2(p, smem);
    grid.sync();
    if (PHMASK & 8) gemm_phase<3>((LAS unsigned char*)smem, p);
    grid.sync();
    if (PHMASK & 16) gemm_phase<4>((LAS unsigned char*)smem, p);
}

extern "C" void kernel_launch(void* const* d_in, const int* in_sizes, int n_in, void* d_out, int out_size, void* d_ws, size_t ws_size, hipStream_t stream) {
    static int grid_blocks = 0;
    if (grid_blocks == 0) {
        if (n_in != 27 || ws_size < WS_END || out_size != T_TOK * DM) { fprintf(stderr, "kernel_launch: unexpected shapes (n_in %d ws %zu out %d)\n", n_in, ws_size, out_size); grid_blocks = -1; return; }
        int dev = 0, cus = 0, per_cu = 0;
        hipGetDevice(&dev);
        hipDeviceGetAttribute(&cus, hipDeviceAttributeMultiprocessorCount, dev);
        if (hipFuncSetAttribute((const void*)hybrid_fwd, hipFuncAttributeMaxDynamicSharedMemorySize, LDS_BYTES) != hipSuccess) { fprintf(stderr, "kernel_launch: hipFuncSetAttribute failed\n"); grid_blocks = -1; return; }
        if (hipOccupancyMaxActiveBlocksPerMultiprocessor(&per_cu, (const void*)hybrid_fwd, NTHREADS, LDS_BYTES) != hipSuccess || per_cu < 1) { fprintf(stderr, "kernel_launch: occupancy query failed (%d)\n", per_cu); grid_blocks = -1; return; }
        grid_blocks = cus * 1;
        if (grid_blocks != 256) { fprintf(stderr, "kernel_launch: built for 256 CUs, found %d\n", cus); grid_blocks = -1; return; }
    }
    if (grid_blocks < 0) return;
    Params p{};
    for (int i = 0; i < 27; ++i) p.in[i] = (const float*)d_in[i];
    p.out = (float*)d_out; p.ws = (unsigned char*)d_ws; p.G = grid_blocks; p.pad = 0;
    void* args[] = {&p};
    hipError_t e = hipLaunchCooperativeKernel((const void*)hybrid_fwd, dim3(grid_blocks), dim3(NTHREADS), args, LDS_BYTES, stream);
    if (e != hipSuccess) fprintf(stderr, "cooperative launch failed: %s (grid %d)\n", hipGetErrorString(e), grid_blocks);
}
```

```cpp
#include <hip/hip_runtime.h>
#include <hip/hip_cooperative_groups.h>
#include <cstdio>
namespace cg = cooperative_groups;

#define DI __device__ __forceinline__
#define LAS __attribute__((address_space(3)))
typedef unsigned short bf16_t;
typedef short bf16x8 __attribute__((ext_vector_type(8)));
typedef float f32x2 __attribute__((ext_vector_type(2)));
typedef float f32x4 __attribute__((ext_vector_type(4)));
typedef float f32x16 __attribute__((ext_vector_type(16)));
typedef unsigned u32x2 __attribute__((ext_vector_type(2)));
typedef unsigned u32x4 __attribute__((ext_vector_type(4)));
typedef __bf16 bf16v2 __attribute__((ext_vector_type(2)));

constexpr int T_TOK = 16384, DM = 2048, SEQ = 2048, NB = 8, NMEM = 256;
constexpr int INC = 16512;
constexpr int NTHREADS = 512;
constexpr int LDS_BYTES = 139264;

constexpr size_t SZ_WT = (size_t)INC * DM * 2;
constexpr size_t OFF_WT = 0;
constexpr size_t OFF_WMEM = OFF_WT + SZ_WT;
constexpr size_t OFF_WUA = OFF_WMEM + (size_t)2048 * 2048 * 2;
constexpr size_t OFF_WUB = OFF_WUA + (size_t)2048 * 1024 * 2;
constexpr size_t OFF_WUC = OFF_WUB + (size_t)2048 * 1024 * 2;
constexpr size_t OFF_WO = OFF_WUC + (size_t)2048 * 1024 * 2;
constexpr size_t OFF_H = OFF_WO + (size_t)2048 * 2048 * 2;
constexpr size_t OFF_M = OFF_H + (size_t)T_TOK * 2048 * 2;
constexpr size_t OFF_PA = OFF_M + (size_t)2048 * 2048 * 2;
constexpr size_t OFF_PB = OFF_PA + (size_t)T_TOK * 3072 * 2;
constexpr size_t OFF_PL = OFF_PB + (size_t)T_TOK * 4096 * 2;
constexpr size_t OFF_PC = OFF_PL + (size_t)T_TOK * 256 * 2;
constexpr size_t OFF_VT = OFF_PC + (size_t)T_TOK * 2048 * 2;
constexpr size_t OFF_MK = OFF_VT + (size_t)1024 * T_TOK * 2;
constexpr size_t OFF_MVT = OFF_MK + (size_t)2048 * 1024 * 2;
constexpr size_t OFF_CTR = OFF_MVT + (size_t)1024 * 2048 * 2;
constexpr size_t WS_END = OFF_CTR + 256;
constexpr size_t OFF_MERGED = OFF_PB;
constexpr size_t OFF_SCR = OFF_PB + (size_t)T_TOK * 2048 * 2;
constexpr size_t OFF_G = OFF_PA;
constexpr size_t SCR_PER_WG = 2 * 131072;
constexpr size_t OFF_YA = 0, OFF_YB = (size_t)T_TOK * 1024 * 2, OFF_YC = 2 * OFF_YB;

struct Params {
    const float* in[27];
    float* out;
    unsigned char* ws;
    int G; int pad;
};
enum { I_X = 0, I_MEM, I_NORMG, I_WIN, I_AQG, I_AKG, I_RELB, I_WUPA, I_MURKV, I_MUW, I_MUA, I_W0, I_W2, I_A0, I_A2, I_KK, I_KA, I_RK, I_LNW, I_LNB, I_WUPB,
       I_MEMG, I_WMEMKV, I_CQG, I_CKG, I_WUPC, I_WO };

DI unsigned pack2(float lo, float hi) { f32x2 v = {lo, hi}; bf16v2 b = __builtin_convertvector(v, bf16v2); return __builtin_bit_cast(unsigned, b); }
DI float bflo(unsigned u) { return __uint_as_float(u << 16); }
DI float bfhi(unsigned u) { return __uint_as_float(u & 0xffff0000u); }
DI float sigmoidf_(float x) { return __builtin_amdgcn_rcpf(1.0f + __expf(-x)); }
DI float siluf_(float x) { return x * sigmoidf_(x); }
DI float wave_sum(float v) {
#pragma unroll
    for (int o = 32; o > 0; o >>= 1) v += __shfl_xor(v, o);
    return v;
}
template <int CTRL> DI float dpp_mov(float x) { return __int_as_float(__builtin_amdgcn_update_dpp(0, __float_as_int(x), CTRL, 0xf, 0xf, false)); }
DI float reduce8(float x) {
    x += dpp_mov<0xB1>(x);
    x += dpp_mov<0x4E>(x);
    x += dpp_mov<0x141>(x);
    return x;
}
DI int crow(int i, int h) { return (i & 3) + 8 * (i >> 2) + 4 * h; }
#define MFMA32(a, b, c) __builtin_amdgcn_mfma_f32_32x32x16_bf16((a), (b), (c), 0, 0, 0)

struct TrTile { const float* src; bf16_t* dst; int R, C, tr, tc; };
DI void tr_load(const TrTile& t, f32x4& v0, f32x4& v1, int tid) {
    const int r = tid >> 3, cs = (tid & 7) * 8;
    const float* sp = t.src + (size_t)(t.tr * 64 + r) * t.C + t.tc * 64 + cs;
    v0 = *(const f32x4*)sp; v1 = *(const f32x4*)(sp + 4);
}
DI void tr_to_lds(const f32x4& v0, const f32x4& v1, float* lds, int tid) {
    const int r = tid >> 3, cs = (tid & 7) * 8;
    float* lp = lds + r * 65 + cs;
    lp[0] = v0[0]; lp[1] = v0[1]; lp[2] = v0[2]; lp[3] = v0[3]; lp[4] = v1[0]; lp[5] = v1[1]; lp[6] = v1[2]; lp[7] = v1[3];
}
DI void tr_store(const TrTile& t, const float* lds, int tid) {
    const int c = tid >> 3, ks = (tid & 7) * 8;
    u32x4 o;
    o[0] = pack2(lds[(ks + 0) * 65 + c], lds[(ks + 1) * 65 + c]);
    o[1] = pack2(lds[(ks + 2) * 65 + c], lds[(ks + 3) * 65 + c]);
    o[2] = pack2(lds[(ks + 4) * 65 + c], lds[(ks + 5) * 65 + c]);
    o[3] = pack2(lds[(ks + 6) * 65 + c], lds[(ks + 7) * 65 + c]);
    *(u32x4*)(t.dst + (size_t)(t.tc * 64 + c) * t.R + t.tr * 64 + ks) = o;
}
DI void rms_load(f32x4 (&v)[8], const float* __restrict__ x, int lane) {
#pragma unroll
    for (int i = 0; i < 8; ++i) v[i] = ((const f32x4*)x)[i * 64 + lane];
}
DI void rms_finish(const f32x4 (&v)[8], const float* __restrict__ g, bf16_t* __restrict__ out, int lane) {
    float ss = 0.f;
#pragma unroll
    for (int i = 0; i < 8; ++i) ss += v[i][0] * v[i][0] + v[i][1] * v[i][1] + v[i][2] * v[i][2] + v[i][3] * v[i][3];
    ss = wave_sum(ss);
    const float rstd = rsqrtf(ss * (1.0f / 2048.0f) + 1e-6f);
#pragma unroll
    for (int i = 0; i < 8; ++i) {
        const f32x4 g4 = ((const f32x4*)g)[i * 64 + lane];
        u32x2 o; o[0] = pack2(v[i][0] * rstd * g4[0], v[i][1] * rstd * g4[1]); o[1] = pack2(v[i][2] * rstd * g4[2], v[i][3] * rstd * g4[3]);
        ((u32x2*)out)[i * 64 + lane] = o;
    }
}
DI void phase0(const Params& p, unsigned char* smem) {
    float* lds = (float*)smem;
    const int G = p.G, c = blockIdx.x;
    if (c == 0 && threadIdx.x == 0) { *(unsigned*)(p.ws + OFF_CTR) = 0u; *(unsigned*)(p.ws + OFF_CTR + 64) = 0u; }
    constexpr int N_WIN = 32 * 258, N_SQ = 32 * 32, N_UP = 16 * 32;
    constexpr int NTR = N_WIN + N_SQ + 3 * N_UP + N_SQ;
    const int tid = threadIdx.x;
    auto tile_of = [&](int u, TrTile& t) {
        int l = u;
        if (l < N_WIN) { t = {p.in[I_WIN], (bf16_t*)(p.ws + OFF_WT), 2048, INC, l & 31, l >> 5}; return; }
        l -= N_WIN;
        if (l < N_SQ) { t = {p.in[I_WMEMKV], (bf16_t*)(p.ws + OFF_WMEM), 2048, 2048, l & 31, l >> 5}; return; }
        l -= N_SQ;
        if (l < 3 * N_UP) {
            const int w = l / N_UP; l -= w * N_UP;
            t = {w == 0 ? p.in[I_WUPA] : (w == 1 ? p.in[I_WUPB] : p.in[I_WUPC]), (bf16_t*)(p.ws + (w == 0 ? OFF_WUA : (w == 1 ? OFF_WUB : OFF_WUC))), 1024, 2048, l & 15, l >> 4}; return;
        }
        l -= 3 * N_UP;
        t = {p.in[I_WO], (bf16_t*)(p.ws + OFF_WO), 2048, 2048, l & 31, l >> 5};
    };
    {
        TrTile cur, nxt; f32x4 v0, v1;
        int u = c, par = 0;
        if (u < NTR) { tile_of(u, cur); tr_load(cur, v0, v1, tid); }
        for (; u < NTR; u += G) {
            float* buf = lds + par * (64 * 65);
            tr_to_lds(v0, v1, buf, tid);
            const bool more = u + G < NTR;
            if (more) { tile_of(u + G, nxt); tr_load(nxt, v0, v1, tid); }
            __syncthreads();
            tr_store(cur, buf, tid);
            cur = nxt; par ^= 1;
        }
    }
    {
        const int wid = tid >> 6, lane = tid & 63;
        auto row_ptrs = [&](int row, const float*& x, const float*& g, bf16_t*& o) {
            if (row < T_TOK) { x = p.in[I_X] + (size_t)row * 2048; g = p.in[I_NORMG]; o = (bf16_t*)(p.ws + OFF_H) + (size_t)row * 2048; }
            else { x = p.in[I_MEM] + (size_t)(row - T_TOK) * 2048; g = p.in[I_MEMG]; o = (bf16_t*)(p.ws + OFF_M) + (size_t)(row - T_TOK) * 2048; }
        };
        constexpr int NRG = (T_TOK + 2048) / 8;
        f32x4 va[8], vb[8];
        const float* x; const float* g; bf16_t* o;
        int rg = c;
        if (rg < NRG) { row_ptrs(rg * 8 + wid, x, g, o); rms_load(va, x, lane); }
        for (; rg < NRG; rg += 2 * G) {
            const float* x2; const float* g2; bf16_t* o2;
            const bool m1 = rg + G < NRG;
            if (m1) { row_ptrs((rg + G) * 8 + wid, x2, g2, o2); rms_load(vb, x2, lane); }
            rms_finish(va, g, o, lane);
            const bool m2 = rg + 2 * G < NRG;
            if (m2) { row_ptrs((rg + 2 * G) * 8 + wid, x, g, o); rms_load(va, x, lane); }
            if (m1) rms_finish(vb, g2, o2, lane);
        }
    }
    __syncthreads();
}

constexpr int BM = 256, BK = 64, HALF = 128, HTB = HALF * BK * 2;
DI int lds_byte(int r, int c) { const int st = (r >> 4) * 2 + (c >> 5), rr = r & 15, cc = c & 31, ob = rr * 64 + cc * 2; return st * 1024 + (ob ^ (((ob >> 9) & 1) << 5)); }
DI void stage_rc(int b, int& R, int& C) { const int st = b / 1024, sb = b % 1024, swz = sb ^ (((sb >> 9) & 1) << 5); R = (st >> 1) * 16 + swz / 64; C = (st & 1) * 32 + (swz % 64) / 2; }

enum { EPI_BF16 = 0, EPI_UP = 1, EPI_GATE = 2, EPI_SIG = 3, EPI_OUT = 4, EPI_UPG = 5 };
struct Unit { const char* A; const char* B; char* C; int K; int ldc; int kind; int aux; const float* X; const char* Gp; };

DI void epilogue(const f32x4 (&acc)[2][2][4][2], const Unit& u, int wr, int wc, int fr, int fq, int tid, char* scr) {
    if (u.kind == EPI_BF16) {
#pragma unroll
        for (int ai = 0; ai < 2; ++ai)
#pragma unroll
            for (int m = 0; m < 4; ++m) {
                bf16_t* rowp = (bf16_t*)u.C + (size_t)(ai * 128 + wr * 64 + m * 16 + fr) * u.ldc + wc * 32 + 4 * fq;
#pragma unroll
                for (int bj = 0; bj < 2; ++bj)
#pragma unroll
                    for (int n = 0; n < 2; ++n) {
                        const f32x4 a = acc[ai][bj][m][n]; u32x2 o; o[0] = pack2(a[0], a[1]); o[1] = pack2(a[2], a[3]);
                        *(u32x2*)(rowp + bj * 128 + n * 16) = o;
                    }
            }
    } else if (u.kind == EPI_OUT) {
#pragma unroll
        for (int ai = 0; ai < 2; ++ai)
#pragma unroll
            for (int m = 0; m < 4; ++m) {
                const size_t ro = (size_t)(ai * 128 + wr * 64 + m * 16 + fr) * 2048 + wc * 32 + 4 * fq;
#pragma unroll
                for (int bj = 0; bj < 2; ++bj)
#pragma unroll
                    for (int n = 0; n < 2; ++n) {
                        const f32x4 xv = *(const f32x4*)(u.X + ro + bj * 128 + n * 16);
                        *(f32x4*)((float*)u.C + ro + bj * 128 + n * 16) = acc[ai][bj][m][n] + xv;
                    }
            }
    } else if (u.kind == EPI_UP || u.kind == EPI_SIG) {
        const bool sg = u.kind == EPI_SIG;
        u32x2* sp = (u32x2*)(sg ? u.C : scr) + tid;
#pragma unroll
        for (int ai = 0; ai < 2; ++ai)
#pragma unroll
            for (int m = 0; m < 4; ++m) {
                asm volatile("" : "+v"(sp) : : "memory");
#pragma unroll
                for (int bj = 0; bj < 2; ++bj)
#pragma unroll
                    for (int n = 0; n < 2; ++n) {
                        f32x4 a = acc[ai][bj][m][n];
                        if (sg) { a[0] = sigmoidf_(a[0]); a[1] = sigmoidf_(a[1]); a[2] = sigmoidf_(a[2]); a[3] = sigmoidf_(a[3]); }
                        u32x2 o; o[0] = pack2(a[0], a[1]); o[1] = pack2(a[2], a[3]);
                        sp[(bj * 2 + n) * 512] = o;
                    }
                sp += 4 * 512;
            }
    } else {
        u32x2* sp = (u32x2*)scr + tid;
        const bool isg = u.kind == EPI_GATE;
        const u32x2* gp = isg ? (const u32x2*)scr + tid : (const u32x2*)u.Gp + tid;
        const int mode = u.aux;
#pragma unroll
        for (int ai = 0; ai < 2; ++ai)
#pragma unroll
            for (int m = 0; m < 4; ++m) {
                asm volatile("" : "+v"(sp), "+v"(gp) : : "memory");
                __builtin_amdgcn_sched_barrier(0);
                bf16_t* rowp = (bf16_t*)u.C + (size_t)(ai * 128 + wr * 64 + m * 16 + fr) * u.ldc + wc * 32 + 4 * fq;
#pragma unroll
                for (int bj = 0; bj < 2; ++bj)
#pragma unroll
                    for (int n = 0; n < 2; ++n) {
                        const int idx = (bj * 2 + n) * 512;
                        const u32x2 uu = gp[idx];
                        u32x2 mm = {0u, 0u};
                        if (mode != 0) mm = sp[idx + 16384];
                        f32x4 a = acc[ai][bj][m][n];
                        if (isg) { a[0] = sigmoidf_(a[0]); a[1] = sigmoidf_(a[1]); a[2] = sigmoidf_(a[2]); a[3] = sigmoidf_(a[3]); }
                        const float r0 = bflo(mm[0]) + a[0] * bflo(uu[0]);
                        const float r1 = bfhi(mm[0]) + a[1] * bfhi(uu[0]);
                        const float r2 = bflo(mm[1]) + a[2] * bflo(uu[1]);
                        const float r3 = bfhi(mm[1]) + a[3] * bfhi(uu[1]);
                        u32x2 o; o[0] = pack2(r0, r1); o[1] = pack2(r2, r3);
                        if (mode == 2) *(u32x2*)(rowp + bj * 128 + n * 16) = o; else sp[idx + 16384] = o;
                    }
                sp += 4 * 512; gp += 4 * 512;
            }
    }
}

DI bool p1_unit(const Params& p, int L, Unit& u) {
    if (L >= 2688) return false;
    u.K = 2048; u.kind = EPI_BF16; u.aux = 0; u.X = nullptr; u.Gp = nullptr;
    const char* ws = (const char*)p.ws;
    if (L < 2368) {
        const int gid = L / 296, rem = L - gid * 296, pm = gid * 8 + (rem & 7), ct = rem >> 3;
        int brow, col, ldc; size_t cb;
        if (ct < 8) { brow = ct * 256; cb = OFF_PA; col = ct * 256; ldc = 3072; }
        else if (ct < 12) { brow = 3072 + (ct - 8) * 256; cb = OFF_PA; col = 2048 + (ct - 8) * 256; ldc = 3072; }
        else if (ct < 28) { brow = 4096 + (ct - 12) * 256; cb = OFF_PB; col = (ct - 12) * 256; ldc = 4096; }
        else if (ct == 28) { brow = 8192; cb = OFF_PL; col = 0; ldc = 256; }
        else { brow = 8320 + (ct - 29) * 256; cb = OFF_PC; col = (ct - 29) * 256; ldc = 2048; }
        u.A = ws + OFF_H + (size_t)pm * 256 * 4096; u.B = ws + OFF_WT + (size_t)brow * 4096;
        u.C = (char*)p.ws + cb + ((size_t)pm * 256 * ldc + col) * 2; u.ldc = ldc;
    } else if (L < 2624) {
        const int l = L - 2368, pm = l & 3, pn = l >> 2;
        u.A = ws + OFF_WT + (size_t)(2048 + pm * 256) * 4096; u.B = ws + OFF_H + (size_t)pn * 256 * 4096;
        u.C = (char*)p.ws + OFF_VT + ((size_t)pm * 256 * T_TOK + pn * 256) * 2; u.ldc = T_TOK;
    } else if (L < 2656) {
        const int l = L - 2624, pm = l & 7, pn = l >> 3;
        u.A = ws + OFF_M + (size_t)pm * 256 * 4096; u.B = ws + OFF_WMEM + (size_t)pn * 256 * 4096;
        u.C = (char*)p.ws + OFF_MK + ((size_t)pm * 256 * 1024 + pn * 256) * 2; u.ldc = 1024;
    } else {
        const int l = L - 2656, pm = l & 3, pn = l >> 2;
        u.A = ws + OFF_WMEM + (size_t)(1024 + pm * 256) * 4096; u.B = ws + OFF_M + (size_t)pn * 256 * 4096;
        u.C = (char*)p.ws + OFF_MVT + ((size_t)pm * 256 * 2048 + pn * 256) * 2; u.ldc = 2048;
    }
    return true;
}
DI void tile_pmpn(int tl, int& pm, int& pn) { pm = (tl & 7) + 8 * (tl >> 6); pn = (tl >> 3) & 7; }
constexpr int PG_N = 1;
DI bool p3_unit(const Params& p, int cp, int ui, Unit& u) {
    if (ui >= 12 - PG_N) return false;
    const bool light = ui >= 6;
    int x, isgate; bool pre = false;
    if (!light) { x = ui >> 1; isgate = ui & 1; }
    else { const int li = ui - 6; if (li < PG_N) { x = li; isgate = 0; pre = true; } else { const int r = li - PG_N; x = PG_N + (r >> 1); isgate = r & 1; } }
    const int tl = light ? 256 + cp : cp;
    int pm, pn; tile_pmpn(tl, pm, pn);
    const char* ws = (const char*)p.ws; const char* yo = (const char*)p.out;
    u.X = nullptr; u.ldc = 2048; u.Gp = nullptr;
    u.C = (char*)p.ws + OFF_MERGED + ((size_t)pm * 256 * 2048 + pn * 256) * 2;
    if (!isgate) {
        u.K = 1024; u.kind = pre ? EPI_UPG : EPI_UP; u.aux = pre ? x : 0;
        u.A = yo + (size_t)x * OFF_YB + (size_t)pm * 256 * 2048;
        u.B = ws + (x == 0 ? OFF_WUA : (x == 1 ? OFF_WUB : OFF_WUC)) + (size_t)pn * 256 * 2048;
        if (pre) u.Gp = ws + OFF_G + (size_t)(cp * 3 + x) * 131072;
    } else {
        u.K = 2048; u.kind = EPI_GATE; u.aux = x;
        u.A = ws + OFF_H + (size_t)pm * 256 * 4096;
        u.B = ws + OFF_WT + (size_t)(10368 + 2048 * x + 256 * pn) * 4096;
    }
    return true;
}
DI bool pg_unit(const Params& p, int ui, Unit& u) {
    if (ui >= 2 * PG_N) return false;
    const int lt = 2 * ((int)blockIdx.x - 128) + ui / PG_N, x = ui % PG_N;
    int pm, pn; tile_pmpn(256 + lt, pm, pn);
    const char* ws = (const char*)p.ws;
    u.X = nullptr; u.ldc = 0; u.Gp = nullptr; u.aux = 0;
    u.K = 2048; u.kind = EPI_SIG;
    u.A = ws + OFF_H + (size_t)pm * 256 * 4096;
    u.B = ws + OFF_WT + (size_t)(10368 + 2048 * x + 256 * pn) * 4096;
    u.C = (char*)p.ws + OFF_G + (size_t)(lt * 3 + x) * 131072;
    return true;
}
DI bool p4_unit(const Params& p, int cp, int ui, Unit& u) {
    const int tl = cp + p.G * ui;
    if (tl >= 512) return false;
    int pm, pn; tile_pmpn(tl, pm, pn);
    const char* ws = (const char*)p.ws;
    u.K = 2048; u.kind = EPI_OUT; u.aux = 0; u.ldc = 2048; u.Gp = nullptr;
    u.A = ws + OFF_MERGED + (size_t)pm * 256 * 4096; u.B = ws + OFF_WO + (size_t)pn * 256 * 4096;
    u.C = (char*)(p.out + (size_t)pm * 256 * 2048 + pn * 256);
    u.X = p.in[I_X] + (size_t)pm * 256 * 2048 + pn * 256;
    return true;
}
template <int PH> DI bool get_unit(const Params& p, int cp, int ui, Unit& u) {
    if (PH == 1) return p1_unit(p, ui * p.G + cp, u);
    if (PH == 3) return p3_unit(p, cp, ui, u);
    if (PH == 5) return pg_unit(p, ui, u);
    return p4_unit(p, cp, ui, u);
}

template <int PH>
DI void gemm_phase(LAS unsigned char* lds, const Params& p) {
    int tid = threadIdx.x; asm volatile("" : "+v"(tid));
    const int wid = __builtin_amdgcn_readfirstlane(tid >> 6), lane = tid & 63, wr = wid >> 2, wc = wid & 3, fr = lane & 15, fq = lane >> 4;
    const int c = blockIdx.x, cp = (p.G & 7) == 0 ? (c & 7) * (p.G >> 3) + (c >> 3) : c;
    char* scr = (char*)p.ws + OFF_SCR + (size_t)c * SCR_PER_WG;
    int sR[2], sC[2];
#pragma unroll
    for (int i = 0; i < 2; ++i) stage_rc(tid * 16 + i * 8192, sR[i], sC[i]);
    const unsigned ldsw = (unsigned)wid * 1024u;
    const int aoff = lds_byte(wr * 64 + fr, fq * 8), boff = lds_byte(wc * 32 + fr, fq * 8);
#define G_SA(b, h) (((b) * 2 + (h)) * HTB)
#define G_SB(b, h) ((4 + (b) * 2 + (h)) * HTB)
#define G_STAGE(bufoff, gbase, KK) do { _Pragma("unroll") for (int _i = 0; _i < 2; ++_i) \
        __builtin_amdgcn_global_load_lds((const unsigned*)((gbase) + (size_t)(unsigned)((sR[_i] * (KK) + sC[_i]) * 2)), (LAS unsigned*)(lds + (bufoff) + ldsw + _i * 8192), 16, 0, 0); } while (0)
#define G_LDA(dst, b, h) do { _Pragma("unroll") for (int m = 0; m < 4; ++m) _Pragma("unroll") for (int k = 0; k < 2; ++k) dst[m][k] = *(const LAS bf16x8*)(lds + G_SA(b, h) + aoff + m * 2048 + k * 1024); } while (0)
#define G_LDB(dst, b, h) do { _Pragma("unroll") for (int n = 0; n < 2; ++n) _Pragma("unroll") for (int k = 0; k < 2; ++k) dst[n][k] = *(const LAS bf16x8*)(lds + G_SB(b, h) + boff + n * 2048 + k * 1024); } while (0)
#define G_MMA(ai, bj, At, Bt) do { __builtin_amdgcn_s_setprio(1); _Pragma("unroll") for (int m = 0; m < 4; ++m) _Pragma("unroll") for (int n = 0; n < 2; ++n) _Pragma("unroll") for (int k = 0; k < 2; ++k) \
        acc[ai][bj][m][n] = __builtin_amdgcn_mfma_f32_16x16x32_bf16(Bt[n][k], At[m][k], acc[ai][bj][m][n], 0, 0, 0); __builtin_amdgcn_s_setprio(0); } while (0)
#define G_WAIT_V(n) asm volatile("s_waitcnt vmcnt(" #n ")" ::: "memory")
#define G_WAIT_L(n) asm volatile("s_waitcnt lgkmcnt(" #n ")" ::: "memory")
#define G_BAR __builtin_amdgcn_s_barrier()
#define G_SCHED __builtin_amdgcn_sched_barrier(0)
    Unit cur, nxt; int ui = 0;
    if (!get_unit<PH>(p, cp, 0, cur)) return;
    f32x4 acc[2][2][4][2];
#pragma unroll
    for (int a = 0; a < 2; ++a)
#pragma unroll
        for (int b = 0; b < 2; ++b)
#pragma unroll
            for (int m = 0; m < 4; ++m)
#pragma unroll
                for (int n = 0; n < 2; ++n) acc[a][b][m][n] = (f32x4){0.f, 0.f, 0.f, 0.f};
    bf16x8 At[4][2], B0[2][2], B1[2][2];
    const char* cA = cur.A; const char* cB = cur.B; int Kc = cur.K;
    {
        const size_t hs = (size_t)HALF * Kc * 2;
        G_STAGE(G_SB(0, 0), cB, Kc); G_STAGE(G_SA(0, 0), cA, Kc); G_STAGE(G_SB(0, 1), cB + hs, Kc); G_STAGE(G_SA(0, 1), cA + hs, Kc);
        if (wr == 1) G_BAR;
        G_WAIT_V(4); G_BAR;
        G_STAGE(G_SB(1, 0), cB + 128, Kc); G_STAGE(G_SA(1, 0), cA + 128, Kc); G_STAGE(G_SB(1, 1), cB + hs + 128, Kc);
        G_WAIT_V(6); G_BAR;
    }
    for (;;) {
        const bool has_next = get_unit<PH>(p, cp, ui + 1, nxt);
        const char* nA = has_next ? nxt.A : cA; const char* nB = has_next ? nxt.B : cB; const int Kn = has_next ? nxt.K : Kc;
        const int nt = Kc / BK;
        const size_t hsc = (size_t)HALF * Kc * 2;
        for (int t = 0; t < nt; t += 2) {
            const bool last = (t == nt - 2);
            const char* a1 = cA + (size_t)(t + 1) * 128;
            const int K2 = last ? Kn : Kc;
            const size_t hs2 = (size_t)HALF * K2 * 2;
            const char* a2 = last ? nA : cA + (size_t)(t + 2) * 128; const char* b2 = last ? nB : cB + (size_t)(t + 2) * 128;
            const char* a3 = a2 + 128; const char* b3 = b2 + 128;
            G_LDB(B0, 0, 0); G_SCHED; G_LDA(At, 0, 0); G_STAGE(G_SA(1, 1), a1 + hsc, Kc);
            G_WAIT_L(8); G_BAR; G_WAIT_L(0); G_MMA(0, 0, At, B0); G_BAR; G_SCHED;
            G_LDB(B1, 0, 1); G_STAGE(G_SB(0, 0), b2, K2);
            G_BAR; G_WAIT_L(0); G_MMA(0, 1, At, B1); G_BAR;
            G_LDA(At, 0, 1); G_STAGE(G_SA(0, 0), a2, K2);
            G_BAR; G_WAIT_L(0); G_MMA(1, 0, At, B0); G_BAR; G_SCHED;
            G_STAGE(G_SB(0, 1), b2 + hs2, K2);
            G_WAIT_V(6); G_BAR; G_MMA(1, 1, At, B1); G_BAR;
            G_LDB(B0, 1, 0); G_SCHED; G_LDA(At, 1, 0); G_STAGE(G_SA(0, 1), a2 + hs2, K2);
            G_WAIT_L(8); G_BAR; G_WAIT_L(0); G_MMA(0, 0, At, B0); G_BAR; G_SCHED;
            G_LDB(B1, 1, 1); G_STAGE(G_SB(1, 0), b3, K2);
            G_BAR; G_WAIT_L(0); G_MMA(0, 1, At, B1); G_BAR;
            G_LDA(At, 1, 1); G_STAGE(G_SA(1, 0), a3, K2);
            G_BAR; G_WAIT_L(0); G_MMA(1, 0, At, B0); G_BAR; G_SCHED;
            G_STAGE(G_SB(1, 1), b3 + hs2, K2);
            G_WAIT_V(6); G_BAR; G_MMA(1, 1, At, B1); G_BAR;
        }
        epilogue(acc, cur, wr, wc, fr, fq, tid, scr);
        if (!has_next) break;
#pragma unroll
        for (int a = 0; a < 2; ++a)
#pragma unroll
            for (int b = 0; b < 2; ++b)
#pragma unroll
                for (int m = 0; m < 4; ++m)
#pragma unroll
                    for (int n = 0; n < 2; ++n) acc[a][b][m][n] = (f32x4){0.f, 0.f, 0.f, 0.f};
        cur = nxt; cA = nA; cB = nB; Kc = Kn; ++ui;
    }
    G_WAIT_V(0);
    if (wr == 0) G_BAR;
    G_BAR;
}

constexpr int SB_W = 0, SB_KK = 8192, SB_BV = 16384, SB_KP = 24576, SB_R = 32768, SB_V = 40960, SB_O = 49152, SB_SIZE = 57344;
constexpr int SC_AWD = 114688, SC_AAD = 119296;
constexpr int SC_ASTR = 144;
DI void ld8(const bf16_t* ptr, float (&f)[8]) {
    const u32x4 v = *(const u32x4*)ptr;
#pragma unroll
    for (int i = 0; i < 4; ++i) { f[2 * i] = bflo(v[i]); f[2 * i + 1] = bfhi(v[i]); }
}
struct ScanOps { f32x4 w0, w1, a0, a1, b0, b1, k0, k1, r0, r1; f32x2 v; };
DI void scan_load(ScanOps& o, const LAS unsigned char* bp, const LAS unsigned char* vp) {
    o.w0 = *(const LAS f32x4*)(bp + SB_W); o.w1 = *(const LAS f32x4*)(bp + SB_W + 16);
    o.a0 = *(const LAS f32x4*)(bp + SB_KK); o.a1 = *(const LAS f32x4*)(bp + SB_KK + 16);
    o.b0 = *(const LAS f32x4*)(bp + SB_BV); o.b1 = *(const LAS f32x4*)(bp + SB_BV + 16);
    o.k0 = *(const LAS f32x4*)(bp + SB_KP); o.k1 = *(const LAS f32x4*)(bp + SB_KP + 16);
    o.r0 = *(const LAS f32x4*)(bp + SB_R); o.r1 = *(const LAS f32x4*)(bp + SB_R + 16);
    o.v = *(const LAS f32x2*)vp;
}
DI f32x2 lo2(f32x4 x) { return (f32x2){x[0], x[1]}; }
DI f32x2 hi2(f32x4 x) { return (f32x2){x[2], x[3]}; }
DI f32x2 splat2(float x) { return (f32x2){x, x}; }
DI void scan_step(f32x2 (&S0)[4], f32x2 (&S1)[4], const ScanOps& o, LAS unsigned char* op, bool wr) {
    const f32x2 kk[4] = {lo2(o.a0), hi2(o.a0), lo2(o.a1), hi2(o.a1)};
    f32x2 p0 = S0[0] * kk[0], p1 = S1[0] * kk[0];
#pragma unroll
    for (int q = 1; q < 4; ++q) { p0 = __builtin_elementwise_fma(S0[q], kk[q], p0); p1 = __builtin_elementwise_fma(S1[q], kk[q], p1); }
    const float sa0 = -reduce8(p0[0] + p0[1]), sa1 = -reduce8(p1[0] + p1[1]);
    const f32x2 ww[4] = {lo2(o.w0), hi2(o.w0), lo2(o.w1), hi2(o.w1)};
    const f32x2 bb[4] = {lo2(o.b0), hi2(o.b0), lo2(o.b1), hi2(o.b1)};
    const f32x2 kv[4] = {lo2(o.k0), hi2(o.k0), lo2(o.k1), hi2(o.k1)};
    const f32x2 rr[4] = {lo2(o.r0), hi2(o.r0), lo2(o.r1), hi2(o.r1)};
    const f32x2 v0 = splat2(o.v[0]), v1 = splat2(o.v[1]), s0 = splat2(sa0), s1 = splat2(sa1);
#pragma unroll
    for (int q = 0; q < 4; ++q) {
        const f32x2 t0 = __builtin_elementwise_fma(bb[q], s0, kv[q] * v0), t1 = __builtin_elementwise_fma(bb[q], s1, kv[q] * v1);
        S0[q] = __builtin_elementwise_fma(S0[q], ww[q], t0); S1[q] = __builtin_elementwise_fma(S1[q], ww[q], t1);
    }
    f32x2 q0 = S0[0] * rr[0], q1 = S1[0] * rr[0];
#pragma unroll
    for (int q = 1; q < 4; ++q) { q0 = __builtin_elementwise_fma(S0[q], rr[q], q0); q1 = __builtin_elementwise_fma(S1[q], rr[q], q1); }
    const float o0 = reduce8(q0[0] + q0[1]), o1 = reduce8(q1[0] + q1[1]);
    if (wr) *(LAS f32x2*)op = (f32x2){o0, o1};
}
DI void scan_item(const Params& p, unsigned char* smem, int item) {
    const int b = item >> 4, h = item & 15;
    int tid = threadIdx.x; asm volatile("" : "+v"(tid));
    const int wid = __builtin_amdgcn_readfirstlane(tid >> 6), lane = tid & 63;
    const bf16_t* PB = (const bf16_t*)(p.ws + OFF_PB);
    const bf16_t* PL = (const bf16_t*)(p.ws + OFF_PL);
    bf16_t* YB = (bf16_t*)((char*)p.out + OFF_YB);
    LAS unsigned char* lds = (LAS unsigned char*)smem;
    const bool helper = wid >= 4;
    const int hw = wid & 3, mat = hw >> 1, tn = hw & 1, mr = lane & 31, mh = lane >> 5;
    bf16x8 Bf[4];
    float w0c = 0.f, a0c = 0.f, kac = 0.f;
    if (helper) {
        const float* Wx = (mat == 0 ? p.in[I_W2] : p.in[I_A2]) + h * 64 + tn * 32 + mr;
#pragma unroll
        for (int s = 0; s < 4; ++s) {
            u32x4 pk;
#pragma unroll
            for (int jj = 0; jj < 4; ++jj) pk[jj] = pack2(Wx[(size_t)(16 * s + 8 * mh + 2 * jj) * 1024], Wx[(size_t)(16 * s + 8 * mh + 2 * jj + 1) * 1024]);
            Bf[s] = __builtin_bit_cast(bf16x8, pk);
        }
        const int cj = h * 64 + tn * 32 + mr;
        w0c = p.in[I_W0][cj]; a0c = p.in[I_A0][cj]; kac = p.in[I_KA][cj];
    }
    const int ht = tid & 255, et = ht >> 3, eg = ht & 7, ec = h * 64 + eg * 8;
    float muw[8], mua[8], mur[8], muk[8], muv[8], kkc[8], rkc[8], lnw[8], lnb[8];
    {
        auto ldc = [&](const float* src, float (&d)[8]) { const f32x4 a = *(const f32x4*)src, bq = *(const f32x4*)(src + 4); d[0] = a[0]; d[1] = a[1]; d[2] = a[2]; d[3] = a[3]; d[4] = bq[0]; d[5] = bq[1]; d[6] = bq[2]; d[7] = bq[3]; };
        ldc(p.in[I_MUW] + eg * 8, muw); ldc(p.in[I_MUA] + eg * 8, mua);
        ldc(p.in[I_MURKV] + ec, mur); ldc(p.in[I_MURKV] + 1024 + ec, muk); ldc(p.in[I_MURKV] + 2048 + ec, muv);
        ldc(p.in[I_KK] + ec, kkc); ldc(p.in[I_RK] + ec, rkc); ldc(p.in[I_LNW] + ec, lnw); ldc(p.in[I_LNB] + ec, lnb);
    }
    u32x4 L[10]; u32x4 Z;
#pragma unroll
    for (int i = 0; i < 10; ++i) L[i] = (u32x4){0u, 0u, 0u, 0u};
    Z = (u32x4){0u, 0u, 0u, 0u};
    auto loadA = [&](int ch) {
        const size_t row = (size_t)b * SEQ + ch * 32 + et;
        const size_t prow = (ch * 32 + et) > 0 ? row - 1 : row;
        L[0] = *(const u32x4*)(PL + row * 256 + eg * 8); L[1] = *(const u32x4*)(PL + prow * 256 + eg * 8);
        L[2] = *(const u32x4*)(PL + row * 256 + 64 + eg * 8); L[3] = *(const u32x4*)(PL + prow * 256 + 64 + eg * 8);
#pragma unroll
        for (int q = 0; q < 3; ++q) { L[4 + 2 * q] = *(const u32x4*)(PB + row * 4096 + q * 1024 + ec); L[5 + 2 * q] = *(const u32x4*)(PB + prow * 4096 + q * 1024 + ec); }
    };
    auto loadZ = [&](int ch) { Z = *(const u32x4*)(PB + ((size_t)b * SEQ + ch * 32 + et) * 4096 + 3072 + ec); };
    auto unp = [&](const u32x4& v, float (&f)[8]) {
#pragma unroll
        for (int i = 0; i < 4; ++i) { f[2 * i] = bflo(v[i]); f[2 * i + 1] = bfhi(v[i]); } };
    auto stepA = [&](int ch, int buf) {
        const float pm = (ch * 32 + et) > 0 ? 1.0f : 0.0f;
        LAS unsigned char* bb = lds + buf * SB_SIZE;
        float cur[8], prv[8], x[8];
        unp(L[0], cur); unp(L[1], prv);
        u32x4 o;
#pragma unroll
        for (int i = 0; i < 8; ++i) { const float xx = cur[i] + muw[i] * (prv[i] * pm - cur[i]); x[i] = 1.0f - 2.0f * __builtin_amdgcn_rcpf(1.0f + __expf(2.0f * xx)); }
        o[0] = pack2(x[0], x[1]); o[1] = pack2(x[2], x[3]); o[2] = pack2(x[4], x[5]); o[3] = pack2(x[6], x[7]);
        *(LAS u32x4*)(lds + SC_AWD + et * SC_ASTR + eg * 16) = o;
        unp(L[2], cur); unp(L[3], prv);
#pragma unroll
        for (int i = 0; i < 8; ++i) x[i] = cur[i] + mua[i] * (prv[i] * pm - cur[i]);
        o[0] = pack2(x[0], x[1]); o[1] = pack2(x[2], x[3]); o[2] = pack2(x[4], x[5]); o[3] = pack2(x[6], x[7]);
        *(LAS u32x4*)(lds + SC_AAD + et * SC_ASTR + eg * 16) = o;
#pragma unroll
        for (int q = 0; q < 3; ++q) {
            unp(L[4 + 2 * q], cur); unp(L[5 + 2 * q], prv);
#pragma unroll
            for (int i = 0; i < 8; ++i) { const float m = q == 0 ? mur[i] : (q == 1 ? muk[i] : muv[i]); x[i] = cur[i] + m * (prv[i] * pm - cur[i]); }
            const int dsto = (q == 0 ? SB_R : (q == 1 ? SB_KP : SB_V)) + et * 256 + eg * 32;
            *(LAS f32x4*)(bb + dsto) = (f32x4){x[0], x[1], x[2], x[3]};
            *(LAS f32x4*)(bb + dsto + 16) = (f32x4){x[4], x[5], x[6], x[7]};
            if (q == 1) {
                float kk[8]; float ss = 0.f;
#pragma unroll
                for (int i = 0; i < 8; ++i) { kk[i] = x[i] * kkc[i]; ss += kk[i] * kk[i]; }
                ss = reduce8(ss);
                const float rn = rsqrtf(fmaxf(ss, 1e-24f));
                *(LAS f32x4*)(bb + SB_KK + et * 256 + eg * 32) = (f32x4){kk[0] * rn, kk[1] * rn, kk[2] * rn, kk[3] * rn};
                *(LAS f32x4*)(bb + SB_KK + et * 256 + eg * 32 + 16) = (f32x4){kk[4] * rn, kk[5] * rn, kk[6] * rn, kk[7] * rn};
            }
        }
    };
    auto stepB = [&](int buf) {
        LAS unsigned char* bb = lds + buf * SB_SIZE;
        f32x16 acc;
#pragma unroll
        for (int i = 0; i < 16; ++i) acc[i] = 0.f;
        const int abase = (mat == 0 ? SC_AWD : SC_AAD) + mr * SC_ASTR + mh * 16;
#pragma unroll
        for (int s = 0; s < 4; ++s) { const bf16x8 a = *(const LAS bf16x8*)(lds + abase + s * 32); acc = MFMA32(a, Bf[s], acc); }
        const int jcol = tn * 32 + mr;
#pragma unroll
        for (int i = 0; i < 16; ++i) {
            const int t = crow(i, mh);
            if (mat == 0) {
                const float y = -(w0c + acc[i]);
                const float sp = fmaxf(y, 0.f) + __logf(1.0f + __expf(-fabsf(y)));
                const float w = -sp - 0.5f;
                *(LAS float*)(bb + SB_W + t * 256 + jcol * 4) = __expf(-__expf(w));
            } else {
                const float a = sigmoidf_(a0c + acc[i]);
                const float kl = *(LAS float*)(bb + SB_KP + t * 256 + jcol * 4);
                const float kk = *(LAS float*)(bb + SB_KK + t * 256 + jcol * 4);
                *(LAS float*)(bb + SB_KP + t * 256 + jcol * 4) = kl * (1.0f + (a - 1.0f) * kac);
                *(LAS float*)(bb + SB_BV + t * 256 + jcol * 4) = kk * a;
            }
        }
    };
    auto epi = [&](int ch, int buf) {
        const size_t row = (size_t)b * SEQ + ch * 32 + et;
        LAS unsigned char* bb = lds + buf * SB_SIZE;
        const f32x4 o0 = *(const LAS f32x4*)(bb + SB_O + et * 256 + eg * 32), o1 = *(const LAS f32x4*)(bb + SB_O + et * 256 + eg * 32 + 16);
        float o[8] = {o0[0], o0[1], o0[2], o0[3], o1[0], o1[1], o1[2], o1[3]};
        float sm = 0.f;
#pragma unroll
        for (int i = 0; i < 8; ++i) sm += o[i];
        const float mean = reduce8(sm) * (1.0f / 64.0f);
        float sv = 0.f;
#pragma unroll
        for (int i = 0; i < 8; ++i) { const float d = o[i] - mean; sv += d * d; }
        const float rstd = rsqrtf(reduce8(sv) * (1.0f / 64.0f) + 64e-5f);
        const f32x4 r0 = *(const LAS f32x4*)(bb + SB_R + et * 256 + eg * 32), r1 = *(const LAS f32x4*)(bb + SB_R + et * 256 + eg * 32 + 16);
        const f32x4 k0 = *(const LAS f32x4*)(bb + SB_KP + et * 256 + eg * 32), k1 = *(const LAS f32x4*)(bb + SB_KP + et * 256 + eg * 32 + 16);
        float bs = r0[0] * k0[0] * rkc[0] + r0[1] * k0[1] * rkc[1] + r0[2] * k0[2] * rkc[2] + r0[3] * k0[3] * rkc[3]
                 + r1[0] * k1[0] * rkc[4] + r1[1] * k1[1] * rkc[5] + r1[2] * k1[2] * rkc[6] + r1[3] * k1[3] * rkc[7];
        bs = reduce8(bs);
        const f32x4 v0 = *(const LAS f32x4*)(bb + SB_V + et * 256 + eg * 32), v1 = *(const LAS f32x4*)(bb + SB_V + et * 256 + eg * 32 + 16);
        float z[8]; unp(Z, z);
        float y[8];
#pragma unroll
        for (int i = 0; i < 8; ++i) {
            const float vv = i < 4 ? v0[i] : v1[i - 4];
            y[i] = ((o[i] - mean) * rstd * lnw[i] + lnb[i] + bs * vv) * siluf_(z[i]);
        }
        u32x4 ov; ov[0] = pack2(y[0], y[1]); ov[1] = pack2(y[2], y[3]); ov[2] = pack2(y[4], y[5]); ov[3] = pack2(y[6], y[7]);
        *(u32x4*)(YB + row * 1024 + ec) = ov;
    };

    if (helper) {
        loadA(0); stepA(0, 0); loadA(1);
        __syncthreads();
        stepB(0);
        __syncthreads();
#pragma unroll 1
        for (int ch = 0; ch < SEQ / 32; ++ch) {
            const int buf = ch & 1;
            if (ch > 0) epi(ch - 1, buf ^ 1);
            if (ch + 1 < SEQ / 32) stepA(ch + 1, buf ^ 1);
            if (ch + 2 < SEQ / 32) loadA(ch + 2);
            __syncthreads();
            if (ch + 1 < SEQ / 32) stepB(buf ^ 1);
            loadZ(ch);
            __syncthreads();
        }
        epi(SEQ / 32 - 1, 1);
        __syncthreads();
    } else {
        const int il = lane >> 3, jl = lane & 7, row0 = (wid & 3) * 16 + il * 2;
        f32x2 S0[4], S1[4];
#pragma unroll
        for (int q = 0; q < 4; ++q) { S0[q] = (f32x2){0.f, 0.f}; S1[q] = (f32x2){0.f, 0.f}; }
        __syncthreads();
        __syncthreads();
#pragma unroll 1
        for (int ch = 0; ch < SEQ / 32; ++ch) {
            const int buf = ch & 1;
            const LAS unsigned char* bp = lds + buf * SB_SIZE + jl * 32;
            const LAS unsigned char* vp = lds + buf * SB_SIZE + SB_V + row0 * 4;
            LAS unsigned char* op = lds + buf * SB_SIZE + SB_O + row0 * 4;
#pragma unroll 1
            for (int half = 0; half < 2; ++half) {
                ScanOps oa, ob;
                scan_load(oa, bp + half * 16 * 256, vp + half * 16 * 256);
#pragma unroll 1
                for (int t = half * 16; t < half * 16 + 16; t += 2) {
                    scan_load(ob, bp + (t + 1) * 256, vp + (t + 1) * 256);
                    scan_step(S0, S1, oa, op + t * 256, jl == 0);
                    scan_load(oa, bp + (t + 2) * 256, vp + (t + 2) * 256);
                    scan_step(S0, S1, ob, op + (t + 1) * 256, jl == 0);
                }
                __syncthreads();
            }
        }
        __syncthreads();
    }
}

template <int HD> struct AttnCfg { static constexpr int KSTR = HD * 2 + 16, VSTR = 136, VROWS = HD, K_OFF = 0, V_OFF = 64 * KSTR, BIAS_OFF = V_OFF + VROWS * VSTR; };

template <int HD>
DI void attn_load_q(bf16x8 (&Qf)[HD / 16], const bf16_t* qrow, const float* g, float scale, int mh) {
    u32x4 raw[HD / 16]; float ss = 0.f;
#pragma unroll
    for (int s = 0; s < HD / 16; ++s) {
        raw[s] = *(const u32x4*)(qrow + 16 * s + 8 * mh);
#pragma unroll
        for (int i = 0; i < 4; ++i) { const float a = bflo(raw[s][i]), bb = bfhi(raw[s][i]); ss += a * a + bb * bb; }
    }
    ss += __shfl_xor(ss, 32);
    const float rstd = rsqrtf(ss * (1.0f / HD) + 1e-6f) * scale;
#pragma unroll
    for (int s = 0; s < HD / 16; ++s) {
        const f32x4 g0 = *(const f32x4*)(g + 16 * s + 8 * mh), g1 = *(const f32x4*)(g + 16 * s + 8 * mh + 4);
        u32x4 o;
        o[0] = pack2(bflo(raw[s][0]) * rstd * g0[0], bfhi(raw[s][0]) * rstd * g0[1]);
        o[1] = pack2(bflo(raw[s][1]) * rstd * g0[2], bfhi(raw[s][1]) * rstd * g0[3]);
        o[2] = pack2(bflo(raw[s][2]) * rstd * g1[0], bfhi(raw[s][2]) * rstd * g1[1]);
        o[3] = pack2(bflo(raw[s][3]) * rstd * g1[2], bfhi(raw[s][3]) * rstd * g1[3]);
        Qf[s] = __builtin_bit_cast(bf16x8, o);
    }
}
template <int HD> struct KVRegs { u32x4 k[HD / 64]; u32x4 v[HD == 128 ? 2 : 4]; };
template <int HD>
DI void attn_fetch(KVRegs<HD>& R, const bf16_t* ksrc, size_t ldk, const bf16_t* vsrc, size_t ldv, int tid) {
    constexpr int EPT = HD / 8;
    const int key = tid >> 3, part = tid & 7;
    const bf16_t* src = ksrc + (size_t)key * ldk + part * EPT;
#pragma unroll
    for (int v = 0; v < EPT / 8; ++v) R.k[v] = *(const u32x4*)(src + v * 8);
    constexpr int TPR = 512 / HD, KPT = 64 / TPR;
    const int d = tid / TPR, vpart = tid % TPR;
    const bf16_t* vs = vsrc + (size_t)d * ldv + vpart * KPT;
#pragma unroll
    for (int v = 0; v < KPT / 8; ++v) R.v[v] = *(const u32x4*)(vs + v * 8);
}
template <int HD>
DI void attn_commit(const KVRegs<HD>& R, LAS unsigned char* lds, const float* gk, int tid) {
    constexpr int EPT = HD / 8;
    const int key = tid >> 3, part = tid & 7;
    float ss = 0.f;
#pragma unroll
    for (int v = 0; v < EPT / 8; ++v)
#pragma unroll
        for (int i = 0; i < 4; ++i) { const float a = bflo(R.k[v][i]), bb = bfhi(R.k[v][i]); ss += a * a + bb * bb; }
    ss = reduce8(ss);
    const float rstd = rsqrtf(ss * (1.0f / HD) + 1e-6f);
#pragma unroll
    for (int v = 0; v < EPT / 8; ++v) {
        const float* gp = gk + part * EPT + v * 8;
        const f32x4 g0 = *(const f32x4*)gp, g1 = *(const f32x4*)(gp + 4);
        u32x4 o;
        o[0] = pack2(bflo(R.k[v][0]) * rstd * g0[0], bfhi(R.k[v][0]) * rstd * g0[1]);
        o[1] = pack2(bflo(R.k[v][1]) * rstd * g0[2], bfhi(R.k[v][1]) * rstd * g0[3]);
        o[2] = pack2(bflo(R.k[v][2]) * rstd * g1[0], bfhi(R.k[v][2]) * rstd * g1[1]);
        o[3] = pack2(bflo(R.k[v][3]) * rstd * g1[2], bfhi(R.k[v][3]) * rstd * g1[3]);
        *(LAS u32x4*)(lds + AttnCfg<HD>::K_OFF + key * AttnCfg<HD>::KSTR + (part * EPT + v * 8) * 2) = o;
    }
    constexpr int TPR = 512 / HD, KPT = 64 / TPR;
    const int d = tid / TPR, vpart = tid % TPR;
#pragma unroll
    for (int v = 0; v < KPT / 8; ++v) {
        LAS unsigned char* dp = lds + AttnCfg<HD>::V_OFF + d * AttnCfg<HD>::VSTR + (vpart * KPT + v * 8) * 2;
        *(LAS u32x2*)dp = (u32x2){R.v[v][0], R.v[v][1]};
        *(LAS u32x2*)(dp + 8) = (u32x2){R.v[v][2], R.v[v][3]};
    }
}
template <int HD, bool BIAS, bool QLDS>
DI void attn_chunk(const bf16x8 (&Qf)[HD / 16], const LAS unsigned char* qp, f32x16 (&O)[4], float& m_run, float& l_run, const LAS unsigned char* lds, int dbase, int mr, int mh, int qk_delta) {
#pragma unroll 1
    for (int kt = 0; kt < 2; ++kt) {
        f32x16 sc;
#pragma unroll
        for (int i = 0; i < 16; ++i) sc[i] = 0.f;
        const LAS unsigned char* kp = lds + AttnCfg<HD>::K_OFF + (kt * 32 + mr) * AttnCfg<HD>::KSTR + mh * 16;
#pragma unroll
        for (int s = 0; s < HD / 16; ++s) { if ((s & 3) == 0) __builtin_amdgcn_sched_barrier(0); const bf16x8 a = *(const LAS bf16x8*)(kp + s * 32); const bf16x8 qb = QLDS ? *(const LAS bf16x8*)(qp + s * 32) : Qf[s]; sc = MFMA32(a, qb, sc); }
        float mx = -1e30f;
        if (BIAS) {
            if (qk_delta >= 192) {
                const float cb = *(const LAS float*)(lds + AttnCfg<HD>::BIAS_OFF + 256 * 4);
#pragma unroll
                for (int i = 0; i < 16; ++i) sc[i] += cb;
            } else {
#pragma unroll
                for (int i = 0; i < 16; ++i) {
                    int dist = qk_delta + mr - (kt * 32 + crow(i, mh));
                    dist = dist < -128 ? -128 : (dist > 128 ? 128 : dist);
                    sc[i] += *(const LAS float*)(lds + AttnCfg<HD>::BIAS_OFF + (dist + 128) * 4);
                }
            }
        }
#pragma unroll
        for (int i = 0; i < 16; ++i) mx = fmaxf(mx, sc[i]);
        mx = fmaxf(mx, __shfl_xor(mx, 32));
        const float m_new = fmaxf(m_run, mx), alpha = __builtin_amdgcn_exp2f(m_run - m_new);
        float ls = 0.f;
#pragma unroll
        for (int i = 0; i < 16; ++i) { const float pv = __builtin_amdgcn_exp2f(sc[i] - m_new); sc[i] = pv; ls += pv; }
        l_run = l_run * alpha + ls;
        if (__builtin_amdgcn_ballot_w64(m_new > m_run) != 0ull) {
#pragma unroll
            for (int dt = 0; dt < 4; ++dt)
#pragma unroll
                for (int i = 0; i < 16; ++i) O[dt][i] *= alpha;
        }
        m_run = m_new;
#pragma unroll
        for (int s2 = 0; s2 < 2; ++s2) {
            u32x4 pk;
#pragma unroll
            for (int j = 0; j < 4; ++j) pk[j] = pack2(sc[8 * s2 + 2 * j], sc[8 * s2 + 2 * j + 1]);
            const bf16x8 pb = __builtin_bit_cast(bf16x8, pk);
#pragma unroll
            for (int dt = 0; dt < 4; ++dt) {
                const LAS unsigned char* vp = lds + AttnCfg<HD>::V_OFF + (dbase + dt * 32 + mr) * AttnCfg<HD>::VSTR + (kt * 32 + 16 * s2 + 4 * mh) * 2;
                const u32x2 lo = *(const LAS u32x2*)vp, hi = *(const LAS u32x2*)(vp + 16);
                const u32x4 va = {lo[0], lo[1], hi[0], hi[1]};
                O[dt] = MFMA32(__builtin_bit_cast(bf16x8, va), pb, O[dt]);
            }
        }
    }
}
DI void attn_store(const f32x16 (&O)[4], float l_run, const bf16_t* zrow, bf16_t* yrow, int mh) {
    const float lt = l_run + __shfl_xor(l_run, 32);
    const float inv = 1.0f / lt;
#pragma unroll
    for (int dt = 0; dt < 4; ++dt)
#pragma unroll
        for (int g = 0; g < 4; ++g) {
            const int d = dt * 32 + 8 * g + 4 * mh;
            const u32x2 zz = *(const u32x2*)(zrow + d);
            u32x2 o;
            o[0] = pack2(O[dt][4 * g] * inv * siluf_(bflo(zz[0])), O[dt][4 * g + 1] * inv * siluf_(bfhi(zz[0])));
            o[1] = pack2(O[dt][4 * g + 2] * inv * siluf_(bflo(zz[1])), O[dt][4 * g + 3] * inv * siluf_(bfhi(zz[1])));
            *(u32x2*)(yrow + d) = o;
        }
}

DI void attnA_item(const Params& p, unsigned char* smem, int item) {
    const int b = item >> 6, head = (item >> 3) & 7, cgp = item & 7;
    int tid = threadIdx.x; asm volatile("" : "+v"(tid));
    const int wid = tid >> 6, lane = tid & 63, mr = lane & 31, mh = lane >> 5;
    LAS unsigned char* lds = (LAS unsigned char*)smem;
    const bf16_t* PA = (const bf16_t*)(p.ws + OFF_PA);
    const bf16_t* VT = (const bf16_t*)(p.ws + OFF_VT);
    bf16_t* YA = (bf16_t*)((char*)p.out + OFF_YA);
    const int cw = cgp * 4 + (wid >> 1), qt = wid & 1;
    const size_t qrow = (size_t)b * SEQ + cw * 64 + qt * 32 + mr;
    if (tid < 257) *(LAS float*)(lds + AttnCfg<128>::BIAS_OFF + tid * 4) = p.in[I_RELB][head * 257 + tid] * 1.4426950408889634f;
    bf16x8 Qf[8];
    attn_load_q<128>(Qf, PA + qrow * 3072 + head * 128, p.in[I_AQG], 0.08838834764831845f * 1.4426950408889634f, mh);
    f32x16 O[4];
#pragma unroll
    for (int dt = 0; dt < 4; ++dt)
#pragma unroll
        for (int i = 0; i < 16; ++i) O[dt][i] = 0.f;
    float m_run = -1e30f, l_run = 0.f;
    const int kc0 = cgp * 4 - 8 < 0 ? 0 : cgp * 4 - 8, kc1 = cgp * 4 + 3;
    const bf16_t* kbase = PA + (size_t)b * SEQ * 3072 + 1024 + head * 128;
    const bf16_t* vbase = VT + (size_t)(head * 128) * T_TOK + (size_t)b * SEQ;
    KVRegs<128> R;
    attn_fetch<128>(R, kbase + (size_t)kc0 * 64 * 3072, 3072, vbase + kc0 * 64, T_TOK, tid);
    for (int kc = kc0; kc <= kc1; ++kc) {
        __syncthreads();
        attn_commit<128>(R, lds, p.in[I_AKG], tid);
        __syncthreads();
        if (kc < kc1) attn_fetch<128>(R, kbase + (size_t)(kc + 1) * 64 * 3072, 3072, vbase + (kc + 1) * 64, T_TOK, tid);
        if (kc >= cw - 8 && kc <= cw)
            attn_chunk<128, true, false>(Qf, lds, O, m_run, l_run, lds, 0, mr, mh, (cw - kc) * 64 + qt * 32);
    }
    attn_store(O, l_run, PA + qrow * 3072 + 2048 + head * 128, YA + qrow * 1024 + head * 128, mh);
    __syncthreads();
    if (tid == 0) __hip_atomic_fetch_add((unsigned*)(p.ws + OFF_CTR + 64), 1u, __ATOMIC_RELAXED, __HIP_MEMORY_SCOPE_AGENT);
}
DI void attnC_item(const Params& p, unsigned char* smem, int item) {
    const int b = item >> 6, hc = (item >> 4) & 3, qg = item & 15;
    int tid = threadIdx.x; asm volatile("" : "+v"(tid));
    const int wid = tid >> 6, lane = tid & 63, mr = lane & 31, mh = lane >> 5;
    LAS unsigned char* lds = (LAS unsigned char*)smem;
    const bf16_t* PC = (const bf16_t*)(p.ws + OFF_PC);
    const bf16_t* MK = (const bf16_t*)(p.ws + OFF_MK);
    const bf16_t* MVT = (const bf16_t*)(p.ws + OFF_MVT);
    bf16_t* YC = (bf16_t*)((char*)p.out + OFF_YC);
    const int qt = wid >> 1, dh = wid & 1;
    const size_t qrow = (size_t)b * SEQ + qg * 128 + qt * 32 + mr;
    constexpr int Q_OFF = AttnCfg<256>::V_OFF + 256 * AttnCfg<256>::VSTR;
    __syncthreads();
    {
        bf16x8 Qf[16];
        attn_load_q<256>(Qf, PC + qrow * 2048 + hc * 256, p.in[I_CQG], 0.0625f * 1.4426950408889634f, mh);
        if (dh == 0) {
#pragma unroll
            for (int s = 0; s < 16; ++s) *(LAS bf16x8*)(lds + Q_OFF + (qt * 32 + mr) * 528 + s * 32 + mh * 16) = Qf[s];
        }
    }
    const LAS unsigned char* qp = lds + Q_OFF + (qt * 32 + mr) * 528 + mh * 16;
    bf16x8 Qd[16];
    f32x16 O[4];
#pragma unroll
    for (int dt = 0; dt < 4; ++dt)
#pragma unroll
        for (int i = 0; i < 16; ++i) O[dt][i] = 0.f;
    float m_run = -1e30f, l_run = 0.f;
    const bf16_t* kbase = MK + (size_t)b * NMEM * 1024 + hc * 256;
    const bf16_t* vbase = MVT + (size_t)(hc * 256) * 2048 + (size_t)b * NMEM;
    KVRegs<256> R;
    attn_fetch<256>(R, kbase, 1024, vbase, 2048, tid);
    for (int kc = 0; kc < 4; ++kc) {
        __syncthreads();
        attn_commit<256>(R, lds, p.in[I_CKG], tid);
        __syncthreads();
        if (kc < 3) attn_fetch<256>(R, kbase + (size_t)(kc + 1) * 64 * 1024, 1024, vbase + (kc + 1) * 64, 2048, tid);
        attn_chunk<256, false, true>(Qd, qp, O, m_run, l_run, lds, dh * 128, mr, mh, 0);
    }
    attn_store(O, l_run, PC + qrow * 2048 + 1024 + hc * 256 + dh * 128, YC + qrow * 1024 + hc * 256 + dh * 128, mh);
    __syncthreads();
}
DI void phase2(const Params& p, unsigned char* smem) {
    const int c = blockIdx.x;
    if (c < 128) scan_item(p, smem, c);
    for (int it = c + p.G; it < 128 && c < 128; it += p.G) scan_item(p, smem, it);
    unsigned* ctr = (unsigned*)(p.ws + OFF_CTR);
    LAS int* sitem = (LAS int*)((LAS unsigned char*)smem + LDS_BYTES - 16);
    auto fetch = [&]() -> int {
        __syncthreads();
        if (threadIdx.x == 0) *sitem = (int)atomicAdd(ctr, 1u);
        __syncthreads();
        return *sitem;
    };
    int item = fetch();
    while (item < 512) { attnA_item(p, smem, item); item = fetch(); }
    while (item < 1024) { attnC_item(p, smem, item - 512); item = fetch(); }
    if (blockIdx.x >= 128 && p.G == 256) {
        if (threadIdx.x == 0) { while (__hip_atomic_load((unsigned*)(p.ws + OFF_CTR + 64), __ATOMIC_RELAXED, __HIP_MEMORY_SCOPE_AGENT) < 512u) __builtin_amdgcn_s_sleep(8); }
        __syncthreads();
        gemm_phase<5>((LAS unsigned char*)smem, p);
    }
}

__global__ void __launch_bounds__(NTHREADS) hybrid_fwd(Params p) {
    extern __shared__ __attribute__((aligned(16))) unsigned char smem[];
    cg::grid_group grid = cg::this_grid();
#ifndef PHMASK
#define PHMASK 31
#endif
    if (PHMASK & 1) phase0(p, smem);
    grid.sync();
    if (PHMASK & 2) gemm_phase<1>((LAS unsigned char*)smem, p);
    grid.sync();
    if (PHMASK & 4) phase2(p, smem);
    grid.sync();
    if (PHMASK & 8) gemm_phase<3>((LAS unsigned char*)smem, p);
    grid.sync();
    if (PHMASK & 16) gemm_phase<4>((LAS unsigned char*)smem, p);
}

extern "C" void kernel_launch(void* const* d_in, const int* in_sizes, int n_in, void* d_out, int out_size, void* d_ws, size_t ws_size, hipStream_t stream) {
    static int grid_blocks = 0;
    if (grid_blocks == 0) {
        if (n_in != 27 || ws_size < WS_END || out_size != T_TOK * DM) { fprintf(stderr, "kernel_launch: unexpected shapes (n_in %d ws %zu out %d)\n", n_in, ws_size, out_size); grid_blocks = -1; return; }
        int dev = 0, cus = 0, per_cu = 0;
        hipGetDevice(&dev);
        hipDeviceGetAttribute(&cus, hipDeviceAttributeMultiprocessorCount, dev);
        if (hipFuncSetAttribute((const void*)hybrid_fwd, hipFuncAttributeMaxDynamicSharedMemorySize, LDS_BYTES) != hipSuccess) { fprintf(stderr, "kernel_launch: hipFuncSetAttribute failed\n"); grid_blocks = -1; return; }
        if (hipOccupancyMaxActiveBlocksPerMultiprocessor(&per_cu, (const void*)hybrid_fwd, NTHREADS, LDS_BYTES) != hipSuccess || per_cu < 1) { fprintf(stderr, "kernel_launch: occupancy query failed (%d)\n", per_cu); grid_blocks = -1; return; }
        grid_blocks = cus * 1;
        if (grid_blocks != 256) { fprintf(stderr, "kernel_launch: built for 256 CUs, found %d\n", cus); grid_blocks = -1; return; }
    }
    if (grid_blocks < 0) return;
    Params p{};
    for (int i = 0; i < 27; ++i) p.in[i] = (const float*)d_in[i];
    p.out = (float*)d_out; p.ws = (unsigned char*)d_ws; p.G = grid_blocks; p.pad = 0;
    void* args[] = {&p};
    hipError_t e = hipLaunchCooperativeKernel((const void*)hybrid_fwd, dim3(grid_blocks), dim3(NTHREADS), args, LDS_BYTES, stream);
    if (e != hipSuccess) fprintf(stderr, "cooperative launch failed: %s (grid %d)\n", hipGetErrorString(e), grid_blocks);
}
```

```cpp
#include <hip/hip_runtime.h>
#include <hip/hip_cooperative_groups.h>
#include <cstdio>
namespace cg = cooperative_groups;

#define DI __device__ __forceinline__
#define LAS __attribute__((address_space(3)))
typedef unsigned short bf16_t;
typedef short bf16x8 __attribute__((ext_vector_type(8)));
typedef float f32x2 __attribute__((ext_vector_type(2)));
typedef float f32x4 __attribute__((ext_vector_type(4)));
typedef float f32x16 __attribute__((ext_vector_type(16)));
typedef unsigned u32x2 __attribute__((ext_vector_type(2)));
typedef unsigned u32x4 __attribute__((ext_vector_type(4)));
typedef __bf16 bf16v2 __attribute__((ext_vector_type(2)));

constexpr int T_TOK = 16384, DM = 2048, SEQ = 2048, NB = 8, NMEM = 256;
constexpr int INC = 16512;
constexpr int NTHREADS = 512;
constexpr int LDS_BYTES = 139264;

constexpr size_t SZ_WT = (size_t)INC * DM * 2;
constexpr size_t OFF_WT = 0;
constexpr size_t OFF_WMEM = OFF_WT + SZ_WT;
constexpr size_t OFF_WUA = OFF_WMEM + (size_t)2048 * 2048 * 2;
constexpr size_t OFF_WUB = OFF_WUA + (size_t)2048 * 1024 * 2;
constexpr size_t OFF_WUC = OFF_WUB + (size_t)2048 * 1024 * 2;
constexpr size_t OFF_WO = OFF_WUC + (size_t)2048 * 1024 * 2;
constexpr size_t OFF_H = OFF_WO + (size_t)2048 * 2048 * 2;
constexpr size_t OFF_M = OFF_H + (size_t)T_TOK * 2048 * 2;
constexpr size_t OFF_PA = OFF_M + (size_t)2048 * 2048 * 2;
constexpr size_t OFF_PB = OFF_PA + (size_t)T_TOK * 3072 * 2;
constexpr size_t OFF_PL = OFF_PB + (size_t)T_TOK * 4096 * 2;
constexpr size_t OFF_PC = OFF_PL + (size_t)T_TOK * 256 * 2;
constexpr size_t OFF_VT = OFF_PC + (size_t)T_TOK * 2048 * 2;
constexpr size_t OFF_MK = OFF_VT + (size_t)1024 * T_TOK * 2;
constexpr size_t OFF_MVT = OFF_MK + (size_t)2048 * 1024 * 2;
constexpr size_t OFF_CTR = OFF_MVT + (size_t)1024 * 2048 * 2;
constexpr size_t WS_END = OFF_CTR + 256;
constexpr size_t OFF_MERGED = OFF_PB;
constexpr size_t OFF_SCR = OFF_PB + (size_t)T_TOK * 2048 * 2;
constexpr size_t OFF_G = OFF_PA;
constexpr size_t SCR_PER_WG = 2 * 131072;
constexpr size_t OFF_YA = 0, OFF_YB = (size_t)T_TOK * 1024 * 2, OFF_YC = 2 * OFF_YB;
constexpr size_t OFF_G2 = 3 * OFF_YB;

struct Params {
    const float* in[27];
    float* out;
    unsigned char* ws;
    int G; int pad;
};
enum { I_X = 0, I_MEM, I_NORMG, I_WIN, I_AQG, I_AKG, I_RELB, I_WUPA, I_MURKV, I_MUW, I_MUA, I_W0, I_W2, I_A0, I_A2, I_KK, I_KA, I_RK, I_LNW, I_LNB, I_WUPB,
       I_MEMG, I_WMEMKV, I_CQG, I_CKG, I_WUPC, I_WO };

DI unsigned pack2(float lo, float hi) { f32x2 v = {lo, hi}; bf16v2 b = __builtin_convertvector(v, bf16v2); return __builtin_bit_cast(unsigned, b); }
DI float bflo(unsigned u) { return __uint_as_float(u << 16); }
DI float bfhi(unsigned u) { return __uint_as_float(u & 0xffff0000u); }
DI float sigmoidf_(float x) { return __builtin_amdgcn_rcpf(1.0f + __expf(-x)); }
DI float siluf_(float x) { return x * sigmoidf_(x); }
DI float wave_sum(float v) {
#pragma unroll
    for (int o = 32; o > 0; o >>= 1) v += __shfl_xor(v, o);
    return v;
}
template <int CTRL> DI float dpp_mov(float x) { return __int_as_float(__builtin_amdgcn_update_dpp(0, __float_as_int(x), CTRL, 0xf, 0xf, false)); }
DI float reduce8(float x) {
    x += dpp_mov<0xB1>(x);
    x += dpp_mov<0x4E>(x);
    x += dpp_mov<0x141>(x);
    return x;
}
DI int crow(int i, int h) { return (i & 3) + 8 * (i >> 2) + 4 * h; }
#define MFMA32(a, b, c) __builtin_amdgcn_mfma_f32_32x32x16_bf16((a), (b), (c), 0, 0, 0)

struct TrTile { const float* src; bf16_t* dst; int R, C, tr, tc; };
DI void tr_load(const TrTile& t, f32x4& v0, f32x4& v1, int tid) {
    const int r = tid >> 3, cs = (tid & 7) * 8;
    const float* sp = t.src + (size_t)(t.tr * 64 + r) * t.C + t.tc * 64 + cs;
    v0 = *(const f32x4*)sp; v1 = *(const f32x4*)(sp + 4);
}
DI void tr_to_lds(const f32x4& v0, const f32x4& v1, float* lds, int tid) {
    const int r = tid >> 3, cs = (tid & 7) * 8;
    float* lp = lds + r * 65 + cs;
    lp[0] = v0[0]; lp[1] = v0[1]; lp[2] = v0[2]; lp[3] = v0[3]; lp[4] = v1[0]; lp[5] = v1[1]; lp[6] = v1[2]; lp[7] = v1[3];
}
DI void tr_store(const TrTile& t, const float* lds, int tid) {
    const int c = tid >> 3, ks = (tid & 7) * 8;
    u32x4 o;
    o[0] = pack2(lds[(ks + 0) * 65 + c], lds[(ks + 1) * 65 + c]);
    o[1] = pack2(lds[(ks + 2) * 65 + c], lds[(ks + 3) * 65 + c]);
    o[2] = pack2(lds[(ks + 4) * 65 + c], lds[(ks + 5) * 65 + c]);
    o[3] = pack2(lds[(ks + 6) * 65 + c], lds[(ks + 7) * 65 + c]);
    *(u32x4*)(t.dst + (size_t)(t.tc * 64 + c) * t.R + t.tr * 64 + ks) = o;
}
DI void rms_load(f32x4 (&v)[8], const float* __restrict__ x, int lane) {
#pragma unroll
    for (int i = 0; i < 8; ++i) v[i] = ((const f32x4*)x)[i * 64 + lane];
}
DI void rms_finish(const f32x4 (&v)[8], const float* __restrict__ g, bf16_t* __restrict__ out, int lane) {
    float ss = 0.f;
#pragma unroll
    for (int i = 0; i < 8; ++i) ss += v[i][0] * v[i][0] + v[i][1] * v[i][1] + v[i][2] * v[i][2] + v[i][3] * v[i][3];
    ss = wave_sum(ss);
    const float rstd = rsqrtf(ss * (1.0f / 2048.0f) + 1e-6f);
#pragma unroll
    for (int i = 0; i < 8; ++i) {
        const f32x4 g4 = ((const f32x4*)g)[i * 64 + lane];
        u32x2 o; o[0] = pack2(v[i][0] * rstd * g4[0], v[i][1] * rstd * g4[1]); o[1] = pack2(v[i][2] * rstd * g4[2], v[i][3] * rstd * g4[3]);
        ((u32x2*)out)[i * 64 + lane] = o;
    }
}
DI void phase0(const Params& p, unsigned char* smem) {
    float* lds = (float*)smem;
    const int G = p.G, c = blockIdx.x;
    if (c == 0 && threadIdx.x == 0) { *(unsigned*)(p.ws + OFF_CTR) = 0u; *(unsigned*)(p.ws + OFF_CTR + 64) = 0u; }
    constexpr int N_WIN = 32 * 258, N_SQ = 32 * 32, N_UP = 16 * 32;
    constexpr int NTR = N_WIN + N_SQ + 3 * N_UP + N_SQ;
    const int tid = threadIdx.x;
    auto tile_of = [&](int u, TrTile& t) {
        int l = u;
        if (l < N_WIN) { t = {p.in[I_WIN], (bf16_t*)(p.ws + OFF_WT), 2048, INC, l & 31, l >> 5}; return; }
        l -= N_WIN;
        if (l < N_SQ) { t = {p.in[I_WMEMKV], (bf16_t*)(p.ws + OFF_WMEM), 2048, 2048, l & 31, l >> 5}; return; }
        l -= N_SQ;
        if (l < 3 * N_UP) {
            const int w = l / N_UP; l -= w * N_UP;
            t = {w == 0 ? p.in[I_WUPA] : (w == 1 ? p.in[I_WUPB] : p.in[I_WUPC]), (bf16_t*)(p.ws + (w == 0 ? OFF_WUA : (w == 1 ? OFF_WUB : OFF_WUC))), 1024, 2048, l & 15, l >> 4}; return;
        }
        l -= 3 * N_UP;
        t = {p.in[I_WO], (bf16_t*)(p.ws + OFF_WO), 2048, 2048, l & 31, l >> 5};
    };
    {
        TrTile cur, nxt; f32x4 v0, v1;
        int u = c, par = 0;
        if (u < NTR) { tile_of(u, cur); tr_load(cur, v0, v1, tid); }
        for (; u < NTR; u += G) {
            float* buf = lds + par * (64 * 65);
            tr_to_lds(v0, v1, buf, tid);
            const bool more = u + G < NTR;
            if (more) { tile_of(u + G, nxt); tr_load(nxt, v0, v1, tid); }
            __syncthreads();
            tr_store(cur, buf, tid);
            cur = nxt; par ^= 1;
        }
    }
    {
        const int wid = tid >> 6, lane = tid & 63;
        auto row_ptrs = [&](int row, const float*& x, const float*& g, bf16_t*& o) {
            if (row < T_TOK) { x = p.in[I_X] + (size_t)row * 2048; g = p.in[I_NORMG]; o = (bf16_t*)(p.ws + OFF_H) + (size_t)row * 2048; }
            else { x = p.in[I_MEM] + (size_t)(row - T_TOK) * 2048; g = p.in[I_MEMG]; o = (bf16_t*)(p.ws + OFF_M) + (size_t)(row - T_TOK) * 2048; }
        };
        constexpr int NRG = (T_TOK + 2048) / 8;
        f32x4 va[8], vb[8];
        const float* x; const float* g; bf16_t* o;
        int rg = c;
        if (rg < NRG) { row_ptrs(rg * 8 + wid, x, g, o); rms_load(va, x, lane); }
        for (; rg < NRG; rg += 2 * G) {
            const float* x2; const float* g2; bf16_t* o2;
            const bool m1 = rg + G < NRG;
            if (m1) { row_ptrs((rg + G) * 8 + wid, x2, g2, o2); rms_load(vb, x2, lane); }
            rms_finish(va, g, o, lane);
            const bool m2 = rg + 2 * G < NRG;
            if (m2) { row_ptrs((rg + 2 * G) * 8 + wid, x, g, o); rms_load(va, x, lane); }
            if (m1) rms_finish(vb, g2, o2, lane);
        }
    }
    __syncthreads();
}

constexpr int BM = 256, BK = 64, HALF = 128, HTB = HALF * BK * 2;
DI int lds_byte(int r, int c) { const int st = (r >> 4) * 2 + (c >> 5), rr = r & 15, cc = c & 31, ob = rr * 64 + cc * 2; return st * 1024 + (ob ^ (((ob >> 9) & 1) << 5)); }
DI void stage_rc(int b, int& R, int& C) { const int st = b / 1024, sb = b % 1024, swz = sb ^ (((sb >> 9) & 1) << 5); R = (st >> 1) * 16 + swz / 64; C = (st & 1) * 32 + (swz % 64) / 2; }

enum { EPI_BF16 = 0, EPI_UP = 1, EPI_GATE = 2, EPI_SIG = 3, EPI_OUT = 4, EPI_UPG = 5 };
struct Unit { const char* A; const char* B; char* C; int K; int ldc; int kind; int aux; const float* X; const char* Gp; };

DI void epilogue(const f32x4 (&acc)[2][2][4][2], const Unit& u, int wr, int wc, int fr, int fq, int tid, char* scr) {
    if (u.kind == EPI_BF16) {
#pragma unroll
        for (int ai = 0; ai < 2; ++ai)
#pragma unroll
            for (int m = 0; m < 4; ++m) {
                bf16_t* rowp = (bf16_t*)u.C + (size_t)(ai * 128 + wr * 64 + m * 16 + fr) * u.ldc + wc * 64 + 16 * fq;
#pragma unroll
                for (int bj = 0; bj < 2; ++bj) {
                    const f32x4 a0 = acc[ai][bj][m][0], a1 = acc[ai][bj][m][1];
                    u32x4 o; o[0] = pack2(a0[0], a0[1]); o[1] = pack2(a0[2], a0[3]); o[2] = pack2(a1[0], a1[1]); o[3] = pack2(a1[2], a1[3]);
                    *(u32x4*)(rowp + bj * 8) = o;
                }
            }
    } else if (u.kind == EPI_OUT) {
        const size_t ro0 = (size_t)(wr * 64 + fr) * 2048 + wc * 64 + 16 * fq;
        const float* xp = u.X + ro0; float* op = (float*)u.C + ro0;
#pragma unroll
        for (int ai = 0; ai < 2; ++ai) {
#pragma unroll
            for (int mp = 0; mp < 2; ++mp) {
                asm volatile("" : "+v"(xp), "+v"(op) : : "memory");
                f32x4 xv[2][4];
#pragma unroll
                for (int mm = 0; mm < 2; ++mm)
#pragma unroll
                    for (int q = 0; q < 4; ++q) xv[mm][q] = *(const f32x4*)(xp + mm * 16 * 2048 + q * 4);
                asm volatile("" ::: "memory");
#pragma unroll
                for (int mm = 0; mm < 2; ++mm) {
                    const int m = mp * 2 + mm;
#pragma unroll
                    for (int bj = 0; bj < 2; ++bj)
#pragma unroll
                        for (int n = 0; n < 2; ++n) *(f32x4*)(op + mm * 16 * 2048 + bj * 8 + n * 4) = acc[ai][bj][m][n] + xv[mm][bj * 2 + n];
                }
                xp += 32 * 2048; op += 32 * 2048;
            }
            xp += 64 * 2048; op += 64 * 2048;
        }
    } else if (u.kind == EPI_UP || u.kind == EPI_SIG) {
        const bool sg = u.kind == EPI_SIG;
        u32x2* sp = (u32x2*)(sg ? u.C : scr) + tid;
#pragma unroll
        for (int ai = 0; ai < 2; ++ai)
#pragma unroll
            for (int m = 0; m < 4; ++m) {
                asm volatile("" : "+v"(sp) : : "memory");
#pragma unroll
                for (int bj = 0; bj < 2; ++bj)
#pragma unroll
                    for (int n = 0; n < 2; ++n) {
                        f32x4 a = acc[ai][bj][m][n];
                        if (sg) { a[0] = sigmoidf_(a[0]); a[1] = sigmoidf_(a[1]); a[2] = sigmoidf_(a[2]); a[3] = sigmoidf_(a[3]); }
                        u32x2 o; o[0] = pack2(a[0], a[1]); o[1] = pack2(a[2], a[3]);
                        sp[(bj * 2 + n) * 512] = o;
                    }
                sp += 4 * 512;
            }
    } else {
        u32x2* sp = (u32x2*)scr + tid;
        const bool isg = u.kind == EPI_GATE;
        const u32x2* gp = isg ? (const u32x2*)scr + tid : (const u32x2*)u.Gp + tid;
        const int mode = u.aux;
        u32x2 uu[2][4], mm[2][4];
        auto issue = [&](int slot) {
#pragma unroll
            for (int q = 0; q < 4; ++q) { uu[slot][q] = gp[q * 512]; mm[slot][q] = (u32x2){0u, 0u}; if (mode != 0) mm[slot][q] = sp[q * 512 + 16384]; }
        };
        issue(0);
#pragma unroll
        for (int ai = 0; ai < 2; ++ai)
#pragma unroll
            for (int m = 0; m < 4; ++m) {
                const int g = ai * 4 + m, cur = g & 1;
                u32x2* spc = sp;
                sp += 4 * 512; gp += 4 * 512;
                asm volatile("" : "+v"(sp), "+v"(gp) : : "memory");
                if (g < 7) issue(cur ^ 1);
                __builtin_amdgcn_sched_barrier(0);
                bf16_t* rowp = (bf16_t*)u.C + (size_t)(ai * 128 + wr * 64 + m * 16 + fr) * u.ldc + wc * 64 + 16 * fq;
#pragma unroll
                for (int bj = 0; bj < 2; ++bj)
#pragma unroll
                    for (int n = 0; n < 2; ++n) {
                        const int q = bj * 2 + n;
                        const u32x2 u2 = uu[cur][q], m2 = mm[cur][q];
                        f32x4 a = acc[ai][bj][m][n];
                        if (isg) { a[0] = sigmoidf_(a[0]); a[1] = sigmoidf_(a[1]); a[2] = sigmoidf_(a[2]); a[3] = sigmoidf_(a[3]); }
                        const float r0 = bflo(m2[0]) + a[0] * bflo(u2[0]);
                        const float r1 = bfhi(m2[0]) + a[1] * bfhi(u2[0]);
                        const float r2 = bflo(m2[1]) + a[2] * bflo(u2[1]);
                        const float r3 = bfhi(m2[1]) + a[3] * bfhi(u2[1]);
                        u32x2 o; o[0] = pack2(r0, r1); o[1] = pack2(r2, r3);
                        if (mode == 2) *(u32x2*)(rowp + bj * 8 + n * 4) = o; else spc[q * 512 + 16384] = o;
                    }
            }
    }
}

DI void tile_pmpn(int tl, int& pm, int& pn) { pm = (tl & 7) + 8 * (tl >> 6); pn = (tl >> 3) & 7; }
DI const char* gate_tile_ptr(const Params& p, int g) {
    const unsigned long long a0 = (unsigned long long)p.out + OFF_G2 + (unsigned long long)g * 131072ull, a1 = (unsigned long long)p.ws + OFF_G + (unsigned long long)(g - 128) * 131072ull;
    return (const char*)(g < 128 ? a0 : a1);
}
DI void gate_unit(const Params& p, int g, Unit& u) {
    const int lt = g >> 1, x = g & 1;
    int pm, pn; tile_pmpn(256 + lt, pm, pn);
    const char* ws = (const char*)p.ws;
    u.X = nullptr; u.ldc = 0; u.Gp = nullptr; u.aux = 0;
    u.K = 2048; u.kind = EPI_SIG;
    u.A = ws + OFF_H + (size_t)pm * 256 * 4096;
    u.B = ws + OFF_WT + (size_t)(10368 + 2048 * x + 256 * pn) * 4096;
    u.C = (char*)gate_tile_ptr(p, g);
}
DI bool p1_unit(const Params& p, int L, Unit& u) {
    if (L >= 2688) return false;

    u.K = 2048; u.kind = EPI_BF16; u.aux = 0; u.X = nullptr; u.Gp = nullptr;
    const char* ws = (const char*)p.ws;
    if (L < 2368) {
        const int gid = L / 296, rem = L - gid * 296, pm = gid * 8 + (rem & 7), ct = rem >> 3;
        int brow, col, ldc; size_t cb;
        if (ct < 8) { brow = ct * 256; cb = OFF_PA; col = ct * 256; ldc = 3072; }
        else if (ct < 12) { brow = 3072 + (ct - 8) * 256; cb = OFF_PA; col = 2048 + (ct - 8) * 256; ldc = 3072; }
        else if (ct < 28) { brow = 4096 + (ct - 12) * 256; cb = OFF_PB; col = (ct - 12) * 256; ldc = 4096; }
        else if (ct == 28) { brow = 8192; cb = OFF_PL; col = 0; ldc = 256; }
        else { brow = 8320 + (ct - 29) * 256; cb = OFF_PC; col = (ct - 29) * 256; ldc = 2048; }
        u.A = ws + OFF_H + (size_t)pm * 256 * 4096; u.B = ws + OFF_WT + (size_t)brow * 4096;
        u.C = (char*)p.ws + cb + ((size_t)pm * 256 * ldc + col) * 2; u.ldc = ldc;
    } else if (L < 2624) {
        const int l = L - 2368, pm = l & 3, pn = l >> 2;
        u.A = ws + OFF_WT + (size_t)(2048 + pm * 256) * 4096; u.B = ws + OFF_H + (size_t)pn * 256 * 4096;
        u.C = (char*)p.ws + OFF_VT + ((size_t)pm * 256 * T_TOK + pn * 256) * 2; u.ldc = T_TOK;
    } else if (L < 2656) {
        const int l = L - 2624, pm = l & 7, pn = l >> 3;
        u.A = ws + OFF_M + (size_t)pm * 256 * 4096; u.B = ws + OFF_WMEM + (size_t)pn * 256 * 4096;
        u.C = (char*)p.ws + OFF_MK + ((size_t)pm * 256 * 1024 + pn * 256) * 2; u.ldc = 1024;
    } else {
        const int l = L - 2656, pm = l & 3, pn = l >> 2;
        u.A = ws + OFF_WMEM + (size_t)(1024 + pm * 256) * 4096; u.B = ws + OFF_M + (size_t)pn * 256 * 4096;
        u.C = (char*)p.ws + OFF_MVT + ((size_t)pm * 256 * 2048 + pn * 256) * 2; u.ldc = 2048;
    }
    return true;
}
constexpr int PG_N = 2;
DI bool p3_unit(const Params& p, int cp, int ui, Unit& u) {
    if (ui >= 12 - PG_N) return false;
    const bool light = ui >= 6;
    int x, isgate; bool pre = false;
    if (!light) { x = ui >> 1; isgate = ui & 1; }
    else { const int li = ui - 6; if (li < PG_N) { x = li; isgate = 0; pre = true; } else { const int r = li - PG_N; x = PG_N + (r >> 1); isgate = r & 1; } }
    const int tl = light ? 256 + cp : cp;
    int pm, pn; tile_pmpn(tl, pm, pn);
    const char* ws = (const char*)p.ws; const char* yo = (const char*)p.out;
    u.X = nullptr; u.ldc = 2048; u.Gp = nullptr;
    u.C = (char*)p.ws + OFF_MERGED + ((size_t)pm * 256 * 2048 + pn * 256) * 2;
    if (!isgate) {
        u.K = 1024; u.kind = pre ? EPI_UPG : EPI_UP; u.aux = pre ? x : 0;
        u.A = yo + (size_t)x * OFF_YB + (size_t)pm * 256 * 2048;
        u.B = ws + (x == 0 ? OFF_WUA : (x == 1 ? OFF_WUB : OFF_WUC)) + (size_t)pn * 256 * 2048;
        if (pre) u.Gp = gate_tile_ptr(p, 2 * cp + x);
    } else {
        u.K = 2048; u.kind = EPI_GATE; u.aux = x;
        u.A = ws + OFF_H + (size_t)pm * 256 * 4096;
        u.B = ws + OFF_WT + (size_t)(10368 + 2048 * x + 256 * pn) * 4096;
    }
    return true;
}
DI bool pg_unit(const Params& p, int ui, Unit& u) {
    if (ui >= 3) return false;
    gate_unit(p, 128 + 3 * ((int)blockIdx.x - 128) + ui, u);
    return true;
}
DI bool p4_unit(const Params& p, int cp, int ui, Unit& u) {
    const int tl = cp + p.G * ui;
    if (tl >= 512) return false;
    int pm, pn; tile_pmpn(tl, pm, pn);
    const char* ws = (const char*)p.ws;
    u.K = 2048; u.kind = EPI_OUT; u.aux = 0; u.ldc = 2048; u.Gp = nullptr;
    u.A = ws + OFF_MERGED + (size_t)pm * 256 * 4096; u.B = ws + OFF_WO + (size_t)pn * 256 * 4096;
    u.C = (char*)(p.out + (size_t)pm * 256 * 2048 + pn * 256);
    u.X = p.in[I_X] + (size_t)pm * 256 * 2048 + pn * 256;
    return true;
}
template <int PH> DI bool get_unit(const Params& p, int cp, int ui, Unit& u) {
    if (PH == 1) return p1_unit(p, ui * p.G + cp, u);
    if (PH == 3) return p3_unit(p, cp, ui, u);
    if (PH == 5) return pg_unit(p, ui, u);
    if (PH == 7) { if (ui >= 1 || cp < 128) return false; gate_unit(p, cp - 128, u); return true; }
    return p4_unit(p, cp, ui, u);
}

template <int PH>
DI void gemm_phase(LAS unsigned char* lds, const Params& p) {
    int tid = threadIdx.x; asm volatile("" : "+v"(tid));
    const int wid = __builtin_amdgcn_readfirstlane(tid >> 6), lane = tid & 63, wr = wid >> 2, wc = wid & 3, fr = lane & 15, fq = lane >> 4;
    const int c = blockIdx.x, cp = (p.G & 7) == 0 ? (c & 7) * (p.G >> 3) + (c >> 3) : c;
    char* scr = (char*)p.ws + OFF_SCR + (size_t)c * SCR_PER_WG;
    int sR[2], sC[2];
#pragma unroll
    for (int i = 0; i < 2; ++i) stage_rc(tid * 16 + i * 8192, sR[i], sC[i]);
    int sRB[2][2];
#pragma unroll
    for (int bj = 0; bj < 2; ++bj)
#pragma unroll
        for (int i = 0; i < 2; ++i) { const int R = sR[i]; sRB[bj][i] = 64 * (R >> 5) + 16 * ((R >> 2) & 3) + 8 * bj + 4 * ((R >> 4) & 1) + (R & 3); }
    const unsigned ldsw = (unsigned)wid * 1024u;
    const int aoff = lds_byte(wr * 64 + fr, fq * 8), boff = lds_byte(wc * 32 + fr, fq * 8);
#define G_SA(b, h) (((b) * 2 + (h)) * HTB)
#define G_SB(b, h) ((4 + (b) * 2 + (h)) * HTB)
#define G_STAGE(bufoff, gbase, KK) do { _Pragma("unroll") for (int _i = 0; _i < 2; ++_i) \
        __builtin_amdgcn_global_load_lds((const unsigned*)((gbase) + (size_t)(unsigned)((sR[_i] * (KK) + sC[_i]) * 2)), (LAS unsigned*)(lds + (bufoff) + ldsw + _i * 8192), 16, 0, 0); } while (0)
#define G_STAGE_B(bufoff, gbase, KK, bj) do { _Pragma("unroll") for (int _i = 0; _i < 2; ++_i) \
        __builtin_amdgcn_global_load_lds((const unsigned*)((gbase) + (size_t)(unsigned)((sRB[bj][_i] * (KK) + sC[_i]) * 2)), (LAS unsigned*)(lds + (bufoff) + ldsw + _i * 8192), 16, 0, 0); } while (0)
#define G_LDA(dst, b, h) do { _Pragma("unroll") for (int m = 0; m < 4; ++m) _Pragma("unroll") for (int k = 0; k < 2; ++k) dst[m][k] = *(const LAS bf16x8*)(lds + G_SA(b, h) + aoff + m * 2048 + k * 1024); } while (0)
#define G_LDB(dst, b, h) do { _Pragma("unroll") for (int n = 0; n < 2; ++n) _Pragma("unroll") for (int k = 0; k < 2; ++k) dst[n][k] = *(const LAS bf16x8*)(lds + G_SB(b, h) + boff + n * 2048 + k * 1024); } while (0)
#define G_MMA(ai, bj, At, Bt) do { __builtin_amdgcn_s_setprio(1); _Pragma("unroll") for (int m = 0; m < 4; ++m) _Pragma("unroll") for (int n = 0; n < 2; ++n) _Pragma("unroll") for (int k = 0; k < 2; ++k) \
        acc[ai][bj][m][n] = __builtin_amdgcn_mfma_f32_16x16x32_bf16(Bt[n][k], At[m][k], acc[ai][bj][m][n], 0, 0, 0); __builtin_amdgcn_s_setprio(0); } while (0)
#define G_WAIT_V(n) asm volatile("s_waitcnt vmcnt(" #n ")" ::: "memory")
#define G_WAIT_L(n) asm volatile("s_waitcnt lgkmcnt(" #n ")" ::: "memory")
#define G_BAR __builtin_amdgcn_s_barrier()
#define G_SCHED __builtin_amdgcn_sched_barrier(0)
    Unit cur, nxt; int ui = 0;
    if (!get_unit<PH>(p, cp, 0, cur)) return;
    f32x4 acc[2][2][4][2];
#pragma unroll
    for (int a = 0; a < 2; ++a)
#pragma unroll
        for (int b = 0; b < 2; ++b)
#pragma unroll
            for (int m = 0; m < 4; ++m)
#pragma unroll
                for (int n = 0; n < 2; ++n) acc[a][b][m][n] = (f32x4){0.f, 0.f, 0.f, 0.f};
    bf16x8 At[4][2], B0[2][2], B1[2][2];
    const char* cA = cur.A; const char* cB = cur.B; int Kc = cur.K;
    {
        const size_t hs = (size_t)HALF * Kc * 2;
        G_STAGE_B(G_SB(0, 0), cB, Kc, 0); G_STAGE(G_SA(0, 0), cA, Kc); G_STAGE_B(G_SB(0, 1), cB, Kc, 1); G_STAGE(G_SA(0, 1), cA + hs, Kc);
        if (wr == 1) G_BAR;
        G_WAIT_V(4); G_BAR;
        G_STAGE_B(G_SB(1, 0), cB + 128, Kc, 0); G_STAGE(G_SA(1, 0), cA + 128, Kc); G_STAGE_B(G_SB(1, 1), cB + 128, Kc, 1);
        G_WAIT_V(6); G_BAR;
    }
    for (;;) {
        const bool has_next = get_unit<PH>(p, cp, ui + 1, nxt);
        const char* nA = has_next ? nxt.A : cA; const char* nB = has_next ? nxt.B : cB; const int Kn = has_next ? nxt.K : Kc;
        const int nt = Kc / BK;
        const size_t hsc = (size_t)HALF * Kc * 2;
        for (int t = 0; t < nt; t += 2) {
            const bool last = (t == nt - 2);
            const char* a1 = cA + (size_t)(t + 1) * 128;
            const int K2 = last ? Kn : Kc;
            const size_t hs2 = (size_t)HALF * K2 * 2;
            const char* a2 = last ? nA : cA + (size_t)(t + 2) * 128; const char* b2 = last ? nB : cB + (size_t)(t + 2) * 128;
            const char* a3 = a2 + 128; const char* b3 = b2 + 128;
            G_LDB(B0, 0, 0); G_SCHED; G_LDA(At, 0, 0); G_STAGE(G_SA(1, 1), a1 + hsc, Kc);
            G_WAIT_L(8); G_BAR; G_WAIT_L(0); G_MMA(0, 0, At, B0); G_BAR; G_SCHED;
            G_LDB(B1, 0, 1); G_STAGE_B(G_SB(0, 0), b2, K2, 0);
            G_BAR; G_WAIT_L(0); G_MMA(0, 1, At, B1); G_BAR;
            G_LDA(At, 0, 1); G_STAGE(G_SA(0, 0), a2, K2);
            G_BAR; G_WAIT_L(0); G_MMA(1, 0, At, B0); G_BAR; G_SCHED;
            G_STAGE_B(G_SB(0, 1), b2, K2, 1);
            G_WAIT_V(6); G_BAR; G_MMA(1, 1, At, B1); G_BAR;
            G_LDB(B0, 1, 0); G_SCHED; G_LDA(At, 1, 0); G_STAGE(G_SA(0, 1), a2 + hs2, K2);
            G_WAIT_L(8); G_BAR; G_WAIT_L(0); G_MMA(0, 0, At, B0); G_BAR; G_SCHED;
            G_LDB(B1, 1, 1); G_STAGE_B(G_SB(1, 0), b3, K2, 0);
            G_BAR; G_WAIT_L(0); G_MMA(0, 1, At, B1); G_BAR;
            G_LDA(At, 1, 1); G_STAGE(G_SA(1, 0), a3, K2);
            G_BAR; G_WAIT_L(0); G_MMA(1, 0, At, B0); G_BAR; G_SCHED;
            G_STAGE_B(G_SB(1, 1), b3, K2, 1);
            G_WAIT_V(6); G_BAR; G_MMA(1, 1, At, B1); G_BAR;
        }
        epilogue(acc, cur, wr, wc, fr, fq, tid, scr);
        if (!has_next) break;
#pragma unroll
        for (int a = 0; a < 2; ++a)
#pragma unroll
            for (int b = 0; b < 2; ++b)
#pragma unroll
                for (int m = 0; m < 4; ++m)
#pragma unroll
                    for (int n = 0; n < 2; ++n) acc[a][b][m][n] = (f32x4){0.f, 0.f, 0.f, 0.f};
        cur = nxt; cA = nA; cB = nB; Kc = Kn; ++ui;
    }
    G_WAIT_V(0);
    if (wr == 0) G_BAR;
    G_BAR;
}

constexpr int SB_W = 0, SB_KK = 8192, SB_BV = 16384, SB_KP = 24576, SB_R = 32768, SB_V = 40960, SB_O = 49152, SB_SIZE = 57344;
constexpr int SC_AWD = 114688, SC_AAD = 119296;
constexpr int SC_ASTR = 144;
DI void ld8(const bf16_t* ptr, float (&f)[8]) {
    const u32x4 v = *(const u32x4*)ptr;
#pragma unroll
    for (int i = 0; i < 4; ++i) { f[2 * i] = bflo(v[i]); f[2 * i + 1] = bfhi(v[i]); }
}
struct ScanOps { f32x4 w0, w1, a0, a1, b0, b1, k0, k1, r0, r1; f32x2 v; };
DI void scan_load(ScanOps& o, const LAS unsigned char* bp, const LAS unsigned char* vp) {
    o.w0 = *(const LAS f32x4*)(bp + SB_W); o.w1 = *(const LAS f32x4*)(bp + SB_W + 16);
    o.a0 = *(const LAS f32x4*)(bp + SB_KK); o.a1 = *(const LAS f32x4*)(bp + SB_KK + 16);
    o.b0 = *(const LAS f32x4*)(bp + SB_BV); o.b1 = *(const LAS f32x4*)(bp + SB_BV + 16);
    o.k0 = *(const LAS f32x4*)(bp + SB_KP); o.k1 = *(const LAS f32x4*)(bp + SB_KP + 16);
    o.r0 = *(const LAS f32x4*)(bp + SB_R); o.r1 = *(const LAS f32x4*)(bp + SB_R + 16);
    o.v = *(const LAS f32x2*)vp;
}
DI f32x2 lo2(f32x4 x) { return (f32x2){x[0], x[1]}; }
DI f32x2 hi2(f32x4 x) { return (f32x2){x[2], x[3]}; }
DI f32x2 splat2(float x) { return (f32x2){x, x}; }
DI void reduce8x2(float& a, float& b) {
    float ra, rb;
    asm volatile("s_nop 1\n\t"
                 "v_add_f32_dpp %0, %2, %2 quad_perm:[1,0,3,2] row_mask:0xf bank_mask:0xf bound_ctrl:1\n\t"
                 "v_add_f32_dpp %1, %3, %3 quad_perm:[1,0,3,2] row_mask:0xf bank_mask:0xf bound_ctrl:1\n\t"
                 "s_nop 0\n\t"
                 "v_add_f32_dpp %0, %0, %0 quad_perm:[2,3,0,1] row_mask:0xf bank_mask:0xf bound_ctrl:1\n\t"
                 "v_add_f32_dpp %1, %1, %1 quad_perm:[2,3,0,1] row_mask:0xf bank_mask:0xf bound_ctrl:1\n\t"
                 "s_nop 0\n\t"
                 "v_add_f32_dpp %0, %0, %0 row_half_mirror row_mask:0xf bank_mask:0xf bound_ctrl:1\n\t"
                 "v_add_f32_dpp %1, %1, %1 row_half_mirror row_mask:0xf bank_mask:0xf bound_ctrl:1\n\t"
                 "s_nop 1"
                 : "=&v"(ra), "=&v"(rb) : "v"(a), "v"(b));
    a = ra; b = rb;
}
DI void scan_step(f32x2 (&S0)[4], f32x2 (&S1)[4], const ScanOps& o, LAS unsigned char* op, bool wr) {
    const f32x2 kk[4] = {lo2(o.a0), hi2(o.a0), lo2(o.a1), hi2(o.a1)};
    f32x2 p0 = S0[0] * kk[0], p1 = S1[0] * kk[0];
#pragma unroll
    for (int q = 1; q < 4; ++q) { p0 = __builtin_elementwise_fma(S0[q], kk[q], p0); p1 = __builtin_elementwise_fma(S1[q], kk[q], p1); }
    float sa0 = p0[0] + p0[1], sa1 = p1[0] + p1[1];
    reduce8x2(sa0, sa1);
    const f32x2 ww[4] = {lo2(o.w0), hi2(o.w0), lo2(o.w1), hi2(o.w1)};
    const f32x2 bb[4] = {lo2(o.b0), hi2(o.b0), lo2(o.b1), hi2(o.b1)};
    const f32x2 kv[4] = {lo2(o.k0), hi2(o.k0), lo2(o.k1), hi2(o.k1)};
    const f32x2 rr[4] = {lo2(o.r0), hi2(o.r0), lo2(o.r1), hi2(o.r1)};
    const f32x2 v0 = splat2(o.v[0]), v1 = splat2(o.v[1]), s0 = splat2(-sa0), s1 = splat2(-sa1);
#pragma unroll
    for (int q = 0; q < 4; ++q) {
        const f32x2 t0 = __builtin_elementwise_fma(bb[q], s0, kv[q] * v0), t1 = __builtin_elementwise_fma(bb[q], s1, kv[q] * v1);
        S0[q] = __builtin_elementwise_fma(S0[q], ww[q], t0); S1[q] = __builtin_elementwise_fma(S1[q], ww[q], t1);
    }
    f32x2 q0 = S0[0] * rr[0], q1 = S1[0] * rr[0];
#pragma unroll
    for (int q = 1; q < 4; ++q) { q0 = __builtin_elementwise_fma(S0[q], rr[q], q0); q1 = __builtin_elementwise_fma(S1[q], rr[q], q1); }
    float o0 = q0[0] + q0[1], o1 = q1[0] + q1[1];
    reduce8x2(o0, o1);
    (void)wr;
    *(LAS f32x2*)op = (f32x2){o0, o1};
}
DI void scan_item(const Params& p, unsigned char* smem, int item) {
    const int b = item >> 4, h = item & 15;
    int tid = threadIdx.x; asm volatile("" : "+v"(tid));
    const int wid = __builtin_amdgcn_readfirstlane(tid >> 6), lane = tid & 63;
    const bf16_t* PB = (const bf16_t*)(p.ws + OFF_PB);
    const bf16_t* PL = (const bf16_t*)(p.ws + OFF_PL);
    bf16_t* YB = (bf16_t*)((char*)p.out + OFF_YB);
    LAS unsigned char* lds = (LAS unsigned char*)smem;
    const bool helper = wid >= 4;
    const int hw = wid & 3, mat = hw >> 1, tn = hw & 1, mr = lane & 31, mh = lane >> 5;
    bf16x8 Bf[4];
    float w0c = 0.f, a0c = 0.f, kac = 0.f;
    if (helper) {
        const float* Wx = (mat == 0 ? p.in[I_W2] : p.in[I_A2]) + h * 64 + tn * 32 + mr;
#pragma unroll
        for (int s = 0; s < 4; ++s) {
            u32x4 pk;
#pragma unroll
            for (int jj = 0; jj < 4; ++jj) pk[jj] = pack2(Wx[(size_t)(16 * s + 8 * mh + 2 * jj) * 1024], Wx[(size_t)(16 * s + 8 * mh + 2 * jj + 1) * 1024]);
            Bf[s] = __builtin_bit_cast(bf16x8, pk);
        }
        const int cj = h * 64 + tn * 32 + mr;
        w0c = p.in[I_W0][cj]; a0c = p.in[I_A0][cj]; kac = p.in[I_KA][cj];
    }
    const int ht = tid & 255, et = ht >> 3, eg = ht & 7, ec = h * 64 + eg * 8;
    float muw[8], mua[8], mur[8], muk[8], muv[8], kkc[8], rkc[8], lnw[8], lnb[8];
    {
        auto ldc = [&](const float* src, float (&d)[8]) { const f32x4 a = *(const f32x4*)src, bq = *(const f32x4*)(src + 4); d[0] = a[0]; d[1] = a[1]; d[2] = a[2]; d[3] = a[3]; d[4] = bq[0]; d[5] = bq[1]; d[6] = bq[2]; d[7] = bq[3]; };
        ldc(p.in[I_MUW] + eg * 8, muw); ldc(p.in[I_MUA] + eg * 8, mua);
        ldc(p.in[I_MURKV] + ec, mur); ldc(p.in[I_MURKV] + 1024 + ec, muk); ldc(p.in[I_MURKV] + 2048 + ec, muv);
        ldc(p.in[I_KK] + ec, kkc); ldc(p.in[I_RK] + ec, rkc); ldc(p.in[I_LNW] + ec, lnw); ldc(p.in[I_LNB] + ec, lnb);
    }
    u32x4 L[10]; u32x4 Z;
#pragma unroll
    for (int i = 0; i < 10; ++i) L[i] = (u32x4){0u, 0u, 0u, 0u};
    Z = (u32x4){0u, 0u, 0u, 0u};
    auto loadA = [&](int ch) {
        const size_t row = (size_t)b * SEQ + ch * 32 + et;
        const size_t prow = (ch * 32 + et) > 0 ? row - 1 : row;
        L[0] = *(const u32x4*)(PL + row * 256 + eg * 8); L[1] = *(const u32x4*)(PL + prow * 256 + eg * 8);
        L[2] = *(const u32x4*)(PL + row * 256 + 64 + eg * 8); L[3] = *(const u32x4*)(PL + prow * 256 + 64 + eg * 8);
#pragma unroll
        for (int q = 0; q < 3; ++q) { L[4 + 2 * q] = *(const u32x4*)(PB + row * 4096 + q * 1024 + ec); L[5 + 2 * q] = *(const u32x4*)(PB + prow * 4096 + q * 1024 + ec); }
    };
    auto loadZ = [&](int ch) { Z = *(const u32x4*)(PB + ((size_t)b * SEQ + ch * 32 + et) * 4096 + 3072 + ec); };
    auto unp = [&](const u32x4& v, float (&f)[8]) {
#pragma unroll
        for (int i = 0; i < 4; ++i) { f[2 * i] = bflo(v[i]); f[2 * i + 1] = bfhi(v[i]); } };
    auto stepA = [&](int ch, int buf) {
        const float pm = (ch * 32 + et) > 0 ? 1.0f : 0.0f;
        LAS unsigned char* bb = lds + buf * SB_SIZE;
        float cur[8], prv[8], x[8];
        unp(L[0], cur); unp(L[1], prv);
        u32x4 o;
#pragma unroll
        for (int i = 0; i < 8; ++i) { const float xx = cur[i] + muw[i] * (prv[i] * pm - cur[i]); x[i] = 1.0f - 2.0f * __builtin_amdgcn_rcpf(1.0f + __expf(2.0f * xx)); }
        o[0] = pack2(x[0], x[1]); o[1] = pack2(x[2], x[3]); o[2] = pack2(x[4], x[5]); o[3] = pack2(x[6], x[7]);
        *(LAS u32x4*)(lds + SC_AWD + et * SC_ASTR + eg * 16) = o;
        unp(L[2], cur); unp(L[3], prv);
#pragma unroll
        for (int i = 0; i < 8; ++i) x[i] = cur[i] + mua[i] * (prv[i] * pm - cur[i]);
        o[0] = pack2(x[0], x[1]); o[1] = pack2(x[2], x[3]); o[2] = pack2(x[4], x[5]); o[3] = pack2(x[6], x[7]);
        *(LAS u32x4*)(lds + SC_AAD + et * SC_ASTR + eg * 16) = o;
#pragma unroll
        for (int q = 0; q < 3; ++q) {
            unp(L[4 + 2 * q], cur); unp(L[5 + 2 * q], prv);
#pragma unroll
            for (int i = 0; i < 8; ++i) { const float m = q == 0 ? mur[i] : (q == 1 ? muk[i] : muv[i]); x[i] = cur[i] + m * (prv[i] * pm - cur[i]); }
            const int dsto = (q == 0 ? SB_R : (q == 1 ? SB_KP : SB_V)) + et * 256 + eg * 32;
            *(LAS f32x4*)(bb + dsto) = (f32x4){x[0], x[1], x[2], x[3]};
            *(LAS f32x4*)(bb + dsto + 16) = (f32x4){x[4], x[5], x[6], x[7]};
            if (q == 1) {
                float kk[8]; float ss = 0.f;
#pragma unroll
                for (int i = 0; i < 8; ++i) { kk[i] = x[i] * kkc[i]; ss += kk[i] * kk[i]; }
                ss = reduce8(ss);
                const float rn = rsqrtf(fmaxf(ss, 1e-24f));
                *(LAS f32x4*)(bb + SB_KK + et * 256 + eg * 32) = (f32x4){kk[0] * rn, kk[1] * rn, kk[2] * rn, kk[3] * rn};
                *(LAS f32x4*)(bb + SB_KK + et * 256 + eg * 32 + 16) = (f32x4){kk[4] * rn, kk[5] * rn, kk[6] * rn, kk[7] * rn};
            }
        }
    };
    auto stepB = [&](int buf) {
        LAS unsigned char* bb = lds + buf * SB_SIZE;
        f32x16 acc;
#pragma unroll
        for (int i = 0; i < 16; ++i) acc[i] = 0.f;
        const int abase = (mat == 0 ? SC_AWD : SC_AAD) + mr * SC_ASTR + mh * 16;
#pragma unroll
        for (int s = 0; s < 4; ++s) { const bf16x8 a = *(const LAS bf16x8*)(lds + abase + s * 32); acc = MFMA32(a, Bf[s], acc); }
        const int jcol = tn * 32 + mr;
#pragma unroll
        for (int i = 0; i < 16; ++i) {
            const int t = crow(i, mh);
            if (mat == 0) {
                const float y = -(w0c + acc[i]);
                const float sp = fmaxf(y, 0.f) + __logf(1.0f + __expf(-fabsf(y)));
                const float w = -sp - 0.5f;
                *(LAS float*)(bb + SB_W + t * 256 + jcol * 4) = __expf(-__expf(w));
            } else {
                const float a = sigmoidf_(a0c + acc[i]);
                const float kl = *(LAS float*)(bb + SB_KP + t * 256 + jcol * 4);
                const float kk = *(LAS float*)(bb + SB_KK + t * 256 + jcol * 4);
                *(LAS float*)(bb + SB_KP + t * 256 + jcol * 4) = kl * (1.0f + (a - 1.0f) * kac);
                *(LAS float*)(bb + SB_BV + t * 256 + jcol * 4) = kk * a;
            }
        }
    };
    auto epi = [&](int ch, int buf) {
        const size_t row = (size_t)b * SEQ + ch * 32 + et;
        LAS unsigned char* bb = lds + buf * SB_SIZE;
        const f32x4 o0 = *(const LAS f32x4*)(bb + SB_O + et * 256 + eg * 32), o1 = *(const LAS f32x4*)(bb + SB_O + et * 256 + eg * 32 + 16);
        float o[8] = {o0[0], o0[1], o0[2], o0[3], o1[0], o1[1], o1[2], o1[3]};
        float sm = 0.f;
#pragma unroll
        for (int i = 0; i < 8; ++i) sm += o[i];
        const float mean = reduce8(sm) * (1.0f / 64.0f);
        float sv = 0.f;
#pragma unroll
        for (int i = 0; i < 8; ++i) { const float d = o[i] - mean; sv += d * d; }
        const float rstd = rsqrtf(reduce8(sv) * (1.0f / 64.0f) + 64e-5f);
        const f32x4 r0 = *(const LAS f32x4*)(bb + SB_R + et * 256 + eg * 32), r1 = *(const LAS f32x4*)(bb + SB_R + et * 256 + eg * 32 + 16);
        const f32x4 k0 = *(const LAS f32x4*)(bb + SB_KP + et * 256 + eg * 32), k1 = *(const LAS f32x4*)(bb + SB_KP + et * 256 + eg * 32 + 16);
        float bs = r0[0] * k0[0] * rkc[0] + r0[1] * k0[1] * rkc[1] + r0[2] * k0[2] * rkc[2] + r0[3] * k0[3] * rkc[3]
                 + r1[0] * k1[0] * rkc[4] + r1[1] * k1[1] * rkc[5] + r1[2] * k1[2] * rkc[6] + r1[3] * k1[3] * rkc[7];
        bs = reduce8(bs);
        const f32x4 v0 = *(const LAS f32x4*)(bb + SB_V + et * 256 + eg * 32), v1 = *(const LAS f32x4*)(bb + SB_V + et * 256 + eg * 32 + 16);
        float z[8]; unp(Z, z);
        float y[8];
#pragma unroll
        for (int i = 0; i < 8; ++i) {
            const float vv = i < 4 ? v0[i] : v1[i - 4];
            y[i] = ((o[i] - mean) * rstd * lnw[i] + lnb[i] + bs * vv) * siluf_(z[i]);
        }
        u32x4 ov; ov[0] = pack2(y[0], y[1]); ov[1] = pack2(y[2], y[3]); ov[2] = pack2(y[4], y[5]); ov[3] = pack2(y[6], y[7]);
        *(u32x4*)(YB + row * 1024 + ec) = ov;
    };

    if (helper) {
        loadA(0); stepA(0, 0); loadA(1);
        __syncthreads();
        stepB(0);
        __syncthreads();
#pragma unroll 1
        for (int ch = 0; ch < SEQ / 32; ++ch) {
            const int buf = ch & 1;
            if (ch > 0) epi(ch - 1, buf ^ 1);
            if (ch + 1 < SEQ / 32) stepA(ch + 1, buf ^ 1);
            if (ch + 2 < SEQ / 32) loadA(ch + 2);
            __syncthreads();
            if (ch + 1 < SEQ / 32) stepB(buf ^ 1);
            loadZ(ch);
            __syncthreads();
        }
        epi(SEQ / 32 - 1, 1);
        __syncthreads();
    } else {
        const int il = lane >> 3, jl = lane & 7, row0 = (wid & 3) * 16 + il * 2;
        f32x2 S0[4], S1[4];
#pragma unroll
        for (int q = 0; q < 4; ++q) { S0[q] = (f32x2){0.f, 0.f}; S1[q] = (f32x2){0.f, 0.f}; }
        __syncthreads();
        __syncthreads();
#pragma unroll 1
        for (int ch = 0; ch < SEQ / 32; ++ch) {
            const int buf = ch & 1;
            const LAS unsigned char* bp = lds + buf * SB_SIZE + jl * 32;
            const LAS unsigned char* vp = lds + buf * SB_SIZE + SB_V + row0 * 4;
            LAS unsigned char* op = lds + buf * SB_SIZE + SB_O + row0 * 4;
#pragma unroll 1
            for (int half = 0; half < 2; ++half) {
                ScanOps oa, ob;
                scan_load(oa, bp + half * 16 * 256, vp + half * 16 * 256);
#pragma unroll 1
                for (int t = half * 16; t < half * 16 + 16; t += 2) {
                    scan_load(ob, bp + (t + 1) * 256, vp + (t + 1) * 256);
                    scan_step(S0, S1, oa, op + t * 256, jl == 0);
                    scan_load(oa, bp + (t + 2) * 256, vp + (t + 2) * 256);
                    scan_step(S0, S1, ob, op + (t + 1) * 256, jl == 0);
                }
                __syncthreads();
            }
        }
        __syncthreads();
    }
}

template <int HD> struct AttnCfg { static constexpr int KSTR = HD * 2 + 16, VSTR = 136, VROWS = HD, K_OFF = 0, V_OFF = 64 * KSTR, BIAS_OFF = V_OFF + VROWS * VSTR; };

template <int HD>
DI void attn_load_q(bf16x8 (&Qf)[HD / 16], const bf16_t* qrow, const float* g, float scale, int mh) {
    u32x4 raw[HD / 16]; float ss = 0.f;
#pragma unroll
    for (int s = 0; s < HD / 16; ++s) {
        raw[s] = *(const u32x4*)(qrow + 16 * s + 8 * mh);
#pragma unroll
        for (int i = 0; i < 4; ++i) { const float a = bflo(raw[s][i]), bb = bfhi(raw[s][i]); ss += a * a + bb * bb; }
    }
    ss += __shfl_xor(ss, 32);
    const float rstd = rsqrtf(ss * (1.0f / HD) + 1e-6f) * scale;
#pragma unroll
    for (int s = 0; s < HD / 16; ++s) {
        const f32x4 g0 = *(const f32x4*)(g + 16 * s + 8 * mh), g1 = *(const f32x4*)(g + 16 * s + 8 * mh + 4);
        u32x4 o;
        o[0] = pack2(bflo(raw[s][0]) * rstd * g0[0], bfhi(raw[s][0]) * rstd * g0[1]);
        o[1] = pack2(bflo(raw[s][1]) * rstd * g0[2], bfhi(raw[s][1]) * rstd * g0[3]);
        o[2] = pack2(bflo(raw[s][2]) * rstd * g1[0], bfhi(raw[s][2]) * rstd * g1[1]);
        o[3] = pack2(bflo(raw[s][3]) * rstd * g1[2], bfhi(raw[s][3]) * rstd * g1[3]);
        Qf[s] = __builtin_bit_cast(bf16x8, o);
    }
}
template <int HD> struct KVRegs { u32x4 k[HD / 64]; u32x4 v[HD == 128 ? 2 : 4]; };
template <int HD>
DI void attn_fetch(KVRegs<HD>& R, const bf16_t* ksrc, size_t ldk, const bf16_t* vsrc, size_t ldv, int tid) {
    constexpr int EPT = HD / 8;
    const int key = tid >> 3, part = tid & 7;
    const bf16_t* src = ksrc + (size_t)key * ldk + part * EPT;
#pragma unroll
    for (int v = 0; v < EPT / 8; ++v) R.k[v] = *(const u32x4*)(src + v * 8);
    constexpr int TPR = 512 / HD, KPT = 64 / TPR;
    const int d = tid / TPR, vpart = tid % TPR;
    const bf16_t* vs = vsrc + (size_t)d * ldv + vpart * KPT;
#pragma unroll
    for (int v = 0; v < KPT / 8; ++v) R.v[v] = *(const u32x4*)(vs + v * 8);
}
template <int HD>
DI void attn_commit(const KVRegs<HD>& R, LAS unsigned char* lds, const float (&gkr)[HD / 8], int tid) {
    constexpr int EPT = HD / 8;
    const int key = tid >> 3, part = tid & 7;
    float ss = 0.f;
#pragma unroll
    for (int v = 0; v < EPT / 8; ++v)
#pragma unroll
        for (int i = 0; i < 4; ++i) { const float a = bflo(R.k[v][i]), bb = bfhi(R.k[v][i]); ss += a * a + bb * bb; }
    ss = reduce8(ss);
    const float rstd = rsqrtf(ss * (1.0f / HD) + 1e-6f);
#pragma unroll
    for (int v = 0; v < EPT / 8; ++v) {
        u32x4 o;
        o[0] = pack2(bflo(R.k[v][0]) * rstd * gkr[v * 8 + 0], bfhi(R.k[v][0]) * rstd * gkr[v * 8 + 1]);
        o[1] = pack2(bflo(R.k[v][1]) * rstd * gkr[v * 8 + 2], bfhi(R.k[v][1]) * rstd * gkr[v * 8 + 3]);
        o[2] = pack2(bflo(R.k[v][2]) * rstd * gkr[v * 8 + 4], bfhi(R.k[v][2]) * rstd * gkr[v * 8 + 5]);
        o[3] = pack2(bflo(R.k[v][3]) * rstd * gkr[v * 8 + 6], bfhi(R.k[v][3]) * rstd * gkr[v * 8 + 7]);
        *(LAS u32x4*)(lds + AttnCfg<HD>::K_OFF + key * AttnCfg<HD>::KSTR + (part * EPT + v * 8) * 2) = o;
    }
    constexpr int TPR = 512 / HD, KPT = 64 / TPR;
    const int d = tid / TPR, vpart = tid % TPR;
#pragma unroll
    for (int v = 0; v < KPT / 8; ++v) {
        LAS unsigned char* dp = lds + AttnCfg<HD>::V_OFF + d * AttnCfg<HD>::VSTR + (vpart * KPT + v * 8) * 2;
        *(LAS u32x2*)dp = (u32x2){R.v[v][0], R.v[v][1]};
        *(LAS u32x2*)(dp + 8) = (u32x2){R.v[v][2], R.v[v][3]};
    }
}
template <int HD, bool BIAS, bool QLDS>
DI void attn_chunk(const bf16x8 (&Qf)[HD / 16], const LAS unsigned char* qp, f32x16 (&O)[4], float& m_run, float& l_run, const LAS unsigned char* lds, int dbase, int mr, int mh, int qk_delta) {
#pragma unroll 1
    for (int kt = 0; kt < 2; ++kt) {
        f32x16 sc;
#pragma unroll
        for (int i = 0; i < 16; ++i) sc[i] = 0.f;
        const LAS unsigned char* kp = lds + AttnCfg<HD>::K_OFF + (kt * 32 + mr) * AttnCfg<HD>::KSTR + mh * 16;
        f32x16 sc2;
#pragma unroll
        for (int i = 0; i < 16; ++i) sc2[i] = 0.f;
#pragma unroll
        for (int s = 0; s < HD / 16; s += 2) {
            if ((s & 3) == 0) __builtin_amdgcn_sched_barrier(0);
            const bf16x8 a0 = *(const LAS bf16x8*)(kp + s * 32), a1 = *(const LAS bf16x8*)(kp + s * 32 + 32);
            const bf16x8 qb0 = QLDS ? *(const LAS bf16x8*)(qp + s * 32) : Qf[s], qb1 = QLDS ? *(const LAS bf16x8*)(qp + s * 32 + 32) : Qf[s + 1];
            sc = MFMA32(a0, qb0, sc); sc2 = MFMA32(a1, qb1, sc2);
        }
#pragma unroll
        for (int i = 0; i < 16; ++i) sc[i] += sc2[i];
        float mx = -1e30f;
        if (BIAS) {
            if (qk_delta >= 192) {
                const float cb = *(const LAS float*)(lds + AttnCfg<HD>::BIAS_OFF + 256 * 4);
#pragma unroll
                for (int i = 0; i < 16; ++i) sc[i] += cb;
            } else {
#pragma unroll
                for (int i = 0; i < 16; ++i) {
                    int dist = qk_delta + mr - (kt * 32 + crow(i, mh));
                    dist = dist < -128 ? -128 : (dist > 128 ? 128 : dist);
                    sc[i] += *(const LAS float*)(lds + AttnCfg<HD>::BIAS_OFF + (dist + 128) * 4);
                }
            }
        }
#pragma unroll
        for (int i = 0; i < 16; ++i) mx = fmaxf(mx, sc[i]);
        mx = fmaxf(mx, __shfl_xor(mx, 32));
        const float m_new = fmaxf(m_run, mx), alpha = __builtin_amdgcn_exp2f(m_run - m_new);
        float ls = 0.f;
#pragma unroll
        for (int i = 0; i < 16; ++i) { const float pv = __builtin_amdgcn_exp2f(sc[i] - m_new); sc[i] = pv; ls += pv; }
        l_run = l_run * alpha + ls;
        if (__builtin_amdgcn_ballot_w64(m_new > m_run) != 0ull) {
#pragma unroll
            for (int dt = 0; dt < 4; ++dt)
#pragma unroll
                for (int i = 0; i < 16; ++i) O[dt][i] *= alpha;
        }
        m_run = m_new;
#pragma unroll
        for (int s2 = 0; s2 < 2; ++s2) {
            u32x4 pk;
#pragma unroll
            for (int j = 0; j < 4; ++j) pk[j] = pack2(sc[8 * s2 + 2 * j], sc[8 * s2 + 2 * j + 1]);
            const bf16x8 pb = __builtin_bit_cast(bf16x8, pk);
#pragma unroll
            for (int dt = 0; dt < 4; ++dt) {
                const LAS unsigned char* vp = lds + AttnCfg<HD>::V_OFF + (dbase + dt * 32 + mr) * AttnCfg<HD>::VSTR + (kt * 32 + 16 * s2 + 4 * mh) * 2;
                const u32x2 lo = *(const LAS u32x2*)vp, hi = *(const LAS u32x2*)(vp + 16);
                const u32x4 va = {lo[0], lo[1], hi[0], hi[1]};
                O[dt] = MFMA32(__builtin_bit_cast(bf16x8, va), pb, O[dt]);
            }
        }
    }
}
DI void attn_store(const f32x16 (&O)[4], float l_run, const bf16_t* zrow, bf16_t* yrow, int mh) {
    const float lt = l_run + __shfl_xor(l_run, 32);
    const float inv = 1.0f / lt;
#pragma unroll
    for (int dt = 0; dt < 4; ++dt)
#pragma unroll
        for (int g = 0; g < 4; ++g) {
            const int d = dt * 32 + 8 * g + 4 * mh;
            const u32x2 zz = *(const u32x2*)(zrow + d);
            u32x2 o;
            o[0] = pack2(O[dt][4 * g] * inv * siluf_(bflo(zz[0])), O[dt][4 * g + 1] * inv * siluf_(bfhi(zz[0])));
            o[1] = pack2(O[dt][4 * g + 2] * inv * siluf_(bflo(zz[1])), O[dt][4 * g + 3] * inv * siluf_(bfhi(zz[1])));
            *(u32x2*)(yrow + d) = o;
        }
}

DI void attnA_item(const Params& p, unsigned char* smem, int item) {
    const int b = item >> 6, head = (item >> 3) & 7, cgp = item & 7;
    int tid = threadIdx.x; asm volatile("" : "+v"(tid));
    const int wid = tid >> 6, lane = tid & 63, mr = lane & 31, mh = lane >> 5;
    LAS unsigned char* lds = (LAS unsigned char*)smem;
    const bf16_t* PA = (const bf16_t*)(p.ws + OFF_PA);
    const bf16_t* VT = (const bf16_t*)(p.ws + OFF_VT);
    bf16_t* YA = (bf16_t*)((char*)p.out + OFF_YA);
    const int cw = cgp * 4 + (wid >> 1), qt = wid & 1;
    const size_t qrow = (size_t)b * SEQ + cw * 64 + qt * 32 + mr;
    if (tid < 257) *(LAS float*)(lds + AttnCfg<128>::BIAS_OFF + tid * 4) = p.in[I_RELB][head * 257 + tid] * 1.4426950408889634f;
    bf16x8 Qf[8];
    attn_load_q<128>(Qf, PA + qrow * 3072 + head * 128, p.in[I_AQG], 0.08838834764831845f * 1.4426950408889634f, mh);
    f32x16 O[4];
#pragma unroll
    for (int dt = 0; dt < 4; ++dt)
#pragma unroll
        for (int i = 0; i < 16; ++i) O[dt][i] = 0.f;
    float m_run = -1e30f, l_run = 0.f;
    const int kc0 = cgp * 4 - 8 < 0 ? 0 : cgp * 4 - 8, kc1 = cgp * 4 + 3;
    const bf16_t* kbase = PA + (size_t)b * SEQ * 3072 + 1024 + head * 128;
    const bf16_t* vbase = VT + (size_t)(head * 128) * T_TOK + (size_t)b * SEQ;
    float gkr[16];
    {
#pragma unroll
        for (int i = 0; i < 4; ++i) { const f32x4 g4 = *(const f32x4*)(p.in[I_AKG] + (tid & 7) * 16 + i * 4); gkr[4 * i] = g4[0]; gkr[4 * i + 1] = g4[1]; gkr[4 * i + 2] = g4[2]; gkr[4 * i + 3] = g4[3]; }
    }
    KVRegs<128> R;
    attn_fetch<128>(R, kbase + (size_t)kc0 * 64 * 3072, 3072, vbase + kc0 * 64, T_TOK, tid);
    for (int kc = kc0; kc <= kc1; ++kc) {
        __syncthreads();
        attn_commit<128>(R, lds, gkr, tid);
        __syncthreads();
        if (kc < kc1) attn_fetch<128>(R, kbase + (size_t)(kc + 1) * 64 * 3072, 3072, vbase + (kc + 1) * 64, T_TOK, tid);
        if (kc >= cw - 8 && kc <= cw)
            attn_chunk<128, true, false>(Qf, lds, O, m_run, l_run, lds, 0, mr, mh, (cw - kc) * 64 + qt * 32);
    }
    attn_store(O, l_run, PA + qrow * 3072 + 2048 + head * 128, YA + qrow * 1024 + head * 128, mh);
    __syncthreads();
    if (tid == 0) __hip_atomic_fetch_add((unsigned*)(p.ws + OFF_CTR + 64), 1u, __ATOMIC_RELAXED, __HIP_MEMORY_SCOPE_AGENT);
}
DI void attnC_item(const Params& p, unsigned char* smem, int item) {
    const int b = item >> 6, hc = (item >> 4) & 3, qg = item & 15;
    int tid = threadIdx.x; asm volatile("" : "+v"(tid));
    const int wid = tid >> 6, lane = tid & 63, mr = lane & 31, mh = lane >> 5;
    LAS unsigned char* lds = (LAS unsigned char*)smem;
    const bf16_t* PC = (const bf16_t*)(p.ws + OFF_PC);
    const bf16_t* MK = (const bf16_t*)(p.ws + OFF_MK);
    const bf16_t* MVT = (const bf16_t*)(p.ws + OFF_MVT);
    bf16_t* YC = (bf16_t*)((char*)p.out + OFF_YC);
    const int qt = wid >> 1, dh = wid & 1;
    const size_t qrow = (size_t)b * SEQ + qg * 128 + qt * 32 + mr;
    constexpr int Q_OFF = AttnCfg<256>::V_OFF + 256 * AttnCfg<256>::VSTR;
    __syncthreads();
    {
        bf16x8 Qf[16];
        attn_load_q<256>(Qf, PC + qrow * 2048 + hc * 256, p.in[I_CQG], 0.0625f * 1.4426950408889634f, mh);
        if (dh == 0) {
#pragma unroll
            for (int s = 0; s < 16; ++s) *(LAS bf16x8*)(lds + Q_OFF + (qt * 32 + mr) * 528 + s * 32 + mh * 16) = Qf[s];
        }
    }
    const LAS unsigned char* qp = lds + Q_OFF + (qt * 32 + mr) * 528 + mh * 16;
    bf16x8 Qd[16];
    f32x16 O[4];
#pragma unroll
    for (int dt = 0; dt < 4; ++dt)
#pragma unroll
        for (int i = 0; i < 16; ++i) O[dt][i] = 0.f;
    float m_run = -1e30f, l_run = 0.f;
    const bf16_t* kbase = MK + (size_t)b * NMEM * 1024 + hc * 256;
    const bf16_t* vbase = MVT + (size_t)(hc * 256) * 2048 + (size_t)b * NMEM;
    float gkr[32];
    {
#pragma unroll
        for (int i = 0; i < 8; ++i) { const f32x4 g4 = *(const f32x4*)(p.in[I_CKG] + (tid & 7) * 32 + i * 4); gkr[4 * i] = g4[0]; gkr[4 * i + 1] = g4[1]; gkr[4 * i + 2] = g4[2]; gkr[4 * i + 3] = g4[3]; }
    }
    KVRegs<256> R;
    attn_fetch<256>(R, kbase, 1024, vbase, 2048, tid);
    for (int kc = 0; kc < 4; ++kc) {
        __syncthreads();
        attn_commit<256>(R, lds, gkr, tid);
        __syncthreads();
        if (kc < 3) attn_fetch<256>(R, kbase + (size_t)(kc + 1) * 64 * 1024, 1024, vbase + (kc + 1) * 64, 2048, tid);
        attn_chunk<256, false, true>(Qd, qp, O, m_run, l_run, lds, dh * 128, mr, mh, 0);
    }
    attn_store(O, l_run, PC + qrow * 2048 + 1024 + hc * 256 + dh * 128, YC + qrow * 1024 + hc * 256 + dh * 128, mh);
    __syncthreads();
}
DI void phase2(const Params& p, unsigned char* smem) {
    const int c = blockIdx.x;
    if (c < 128) scan_item(p, smem, c);
    for (int it = c + p.G; it < 128 && c < 128; it += p.G) scan_item(p, smem, it);
    unsigned* ctr = (unsigned*)(p.ws + OFF_CTR);
    LAS int* sitem = (LAS int*)((LAS unsigned char*)smem + LDS_BYTES - 16);
    auto fetch = [&]() -> int {
        __syncthreads();
        if (threadIdx.x == 0) *sitem = (int)atomicAdd(ctr, 1u);
        __syncthreads();
        return *sitem;
    };
    int item = fetch();
    while (item < 512) { attnA_item(p, smem, item); item = fetch(); }
    while (item < 1024) { attnC_item(p, smem, item - 512); item = fetch(); }
    if (blockIdx.x >= 128 && p.G == 256) {
        if (threadIdx.x == 0) { while (__hip_atomic_load((unsigned*)(p.ws + OFF_CTR + 64), __ATOMIC_RELAXED, __HIP_MEMORY_SCOPE_AGENT) < 512u) __builtin_amdgcn_s_sleep(8); }
        __syncthreads();
        gemm_phase<5>((LAS unsigned char*)smem, p);
    }
}

__global__ void __launch_bounds__(NTHREADS) hybrid_fwd(Params p) {
    extern __shared__ __attribute__((aligned(16))) unsigned char smem[];
    cg::grid_group grid = cg::this_grid();
#ifndef PHMASK
#define PHMASK 31
#endif
    if (PHMASK & 1) phase0(p, smem);
    grid.sync();
    if (PHMASK & 2) { gemm_phase<1>((LAS unsigned char*)smem, p); gemm_phase<7>((LAS unsigned char*)smem, p); }
    grid.sync();
    if (PHMASK & 4) phase2(p, smem);
    grid.sync();
    if (PHMASK & 8) gemm_phase<3>((LAS unsigned char*)smem, p);
    grid.sync();
    if (PHMASK & 16) gemm_phase<4>((LAS unsigned char*)smem, p);
}

extern "C" void kernel_launch(void* const* d_in, const int* in_sizes, int n_in, void* d_out, int out_size, void* d_ws, size_t ws_size, hipStream_t stream) {
    static int grid_blocks = 0;
    if (grid_blocks == 0) {
        if (n_in != 27 || ws_size < WS_END || out_size != T_TOK * DM) { fprintf(stderr, "kernel_launch: unexpected shapes (n_in %d ws %zu out %d)\n", n_in, ws_size, out_size); grid_blocks = -1; return; }
        int dev = 0, cus = 0, per_cu = 0;
        hipGetDevice(&dev);
        hipDeviceGetAttribute(&cus, hipDeviceAttributeMultiprocessorCount, dev);
        if (hipFuncSetAttribute((const void*)hybrid_fwd, hipFuncAttributeMaxDynamicSharedMemorySize, LDS_BYTES) != hipSuccess) { fprintf(stderr, "kernel_launch: hipFuncSetAttribute failed\n"); grid_blocks = -1; return; }
        if (hipOccupancyMaxActiveBlocksPerMultiprocessor(&per_cu, (const void*)hybrid_fwd, NTHREADS, LDS_BYTES) != hipSuccess || per_cu < 1) { fprintf(stderr, "kernel_launch: occupancy query failed (%d)\n", per_cu); grid_blocks = -1; return; }
        grid_blocks = cus * 1;
        if (grid_blocks != 256) { fprintf(stderr, "kernel_launch: built for 256 CUs, found %d\n", cus); grid_blocks = -1; return; }
    }
    if (grid_blocks < 0) return;
    Params p{};
    for (int i = 0; i < 27; ++i) p.in[i] = (const float*)d_in[i];
    p.out = (float*)d_out; p.ws = (unsigned char*)d_ws; p.G = grid_blocks; p.pad = 0;
    void* args[] = {&p};
    hipError_t e = hipLaunchCooperativeKernel((const void*)hybrid_fwd, dim3(grid_blocks), dim3(NTHREADS), args, LDS_BYTES, stream);
    if (e != hipSuccess) fprintf(stderr, "cooperative launch failed: %s (grid %d)\n", hipGetErrorString(e), grid_blocks);
}
```

```cpp
#include <hip/hip_runtime.h>
#include <hip/hip_cooperative_groups.h>
#include <cstdio>
namespace cg = cooperative_groups;

#define DI __device__ __forceinline__
#define LAS __attribute__((address_space(3)))
typedef unsigned short bf16_t;
typedef short bf16x8 __attribute__((ext_vector_type(8)));
typedef float f32x2 __attribute__((ext_vector_type(2)));
typedef float f32x4 __attribute__((ext_vector_type(4)));
typedef float f32x16 __attribute__((ext_vector_type(16)));
typedef unsigned u32x2 __attribute__((ext_vector_type(2)));
typedef unsigned u32x4 __attribute__((ext_vector_type(4)));
typedef __bf16 bf16v2 __attribute__((ext_vector_type(2)));

constexpr int T_TOK = 16384, DM = 2048, SEQ = 2048, NB = 8, NMEM = 256;
constexpr int INC = 16512;
constexpr int NTHREADS = 512;
constexpr int LDS_BYTES = 139264;

constexpr size_t SZ_WT = (size_t)INC * DM * 2;
constexpr size_t OFF_WT = 0;
constexpr size_t OFF_WMEM = OFF_WT + SZ_WT;
constexpr size_t OFF_WUA = OFF_WMEM + (size_t)2048 * 2048 * 2;
constexpr size_t OFF_WUB = OFF_WUA + (size_t)2048 * 1024 * 2;
constexpr size_t OFF_WUC = OFF_WUB + (size_t)2048 * 1024 * 2;
constexpr size_t OFF_WO = OFF_WUC + (size_t)2048 * 1024 * 2;
constexpr size_t OFF_H = OFF_WO + (size_t)2048 * 2048 * 2;
constexpr size_t OFF_M = OFF_H + (size_t)T_TOK * 2048 * 2;
constexpr size_t OFF_PA = OFF_M + (size_t)2048 * 2048 * 2;
constexpr size_t OFF_PB = OFF_PA + (size_t)T_TOK * 3072 * 2;
constexpr size_t OFF_PL = OFF_PB + (size_t)T_TOK * 4096 * 2;
constexpr size_t OFF_PC = OFF_PL + (size_t)T_TOK * 256 * 2;
constexpr size_t OFF_VT = OFF_PC + (size_t)T_TOK * 2048 * 2;
constexpr size_t OFF_MK = OFF_VT + (size_t)1024 * T_TOK * 2;
constexpr size_t OFF_MVT = OFF_MK + (size_t)2048 * 1024 * 2;
constexpr size_t OFF_CTR = OFF_MVT + (size_t)1024 * 2048 * 2;
constexpr size_t WS_END = OFF_CTR + 256;
constexpr size_t OFF_MERGED = OFF_PB;
constexpr size_t OFF_SCR = OFF_PB + (size_t)T_TOK * 2048 * 2;
constexpr size_t OFF_G = OFF_PA;
constexpr size_t SCR_PER_WG = 2 * 131072;
constexpr size_t OFF_YA = 0, OFF_YB = (size_t)T_TOK * 1024 * 2, OFF_YC = 2 * OFF_YB;
constexpr size_t OFF_G2 = 3 * OFF_YB;

struct Params {
    const float* in[27];
    float* out;
    unsigned char* ws;
    int G; int pad;
};
enum { I_X = 0, I_MEM, I_NORMG, I_WIN, I_AQG, I_AKG, I_RELB, I_WUPA, I_MURKV, I_MUW, I_MUA, I_W0, I_W2, I_A0, I_A2, I_KK, I_KA, I_RK, I_LNW, I_LNB, I_WUPB,
       I_MEMG, I_WMEMKV, I_CQG, I_CKG, I_WUPC, I_WO };

DI unsigned pack2(float lo, float hi) { f32x2 v = {lo, hi}; bf16v2 b = __builtin_convertvector(v, bf16v2); return __builtin_bit_cast(unsigned, b); }
DI float bflo(unsigned u) { return __uint_as_float(u << 16); }
DI float bfhi(unsigned u) { return __uint_as_float(u & 0xffff0000u); }
DI float sigmoidf_(float x) { return __builtin_amdgcn_rcpf(1.0f + __expf(-x)); }
DI float siluf_(float x) { return x * sigmoidf_(x); }
DI float wave_sum(float v) {
#pragma unroll
    for (int o = 32; o > 0; o >>= 1) v += __shfl_xor(v, o);
    return v;
}
template <int CTRL> DI float dpp_mov(float x) { return __int_as_float(__builtin_amdgcn_update_dpp(0, __float_as_int(x), CTRL, 0xf, 0xf, false)); }
DI float reduce8(float x) {
    x += dpp_mov<0xB1>(x);
    x += dpp_mov<0x4E>(x);
    x += dpp_mov<0x141>(x);
    return x;
}
DI int crow(int i, int h) { return (i & 3) + 8 * (i >> 2) + 4 * h; }
#define MFMA32(a, b, c) __builtin_amdgcn_mfma_f32_32x32x16_bf16((a), (b), (c), 0, 0, 0)

struct TrTile { const float* src; bf16_t* dst; int R, C, tr, tc; };
DI void tr_load(const TrTile& t, f32x4& v0, f32x4& v1, int tid) {
    const int r = tid >> 3, cs = (tid & 7) * 8;
    const float* sp = t.src + (size_t)(t.tr * 64 + r) * t.C + t.tc * 64 + cs;
    v0 = *(const f32x4*)sp; v1 = *(const f32x4*)(sp + 4);
}
DI void tr_to_lds(const f32x4& v0, const f32x4& v1, float* lds, int tid) {
    const int r = tid >> 3, cs = (tid & 7) * 8;
    float* lp = lds + r * 65 + cs;
    lp[0] = v0[0]; lp[1] = v0[1]; lp[2] = v0[2]; lp[3] = v0[3]; lp[4] = v1[0]; lp[5] = v1[1]; lp[6] = v1[2]; lp[7] = v1[3];
}
DI void tr_store(const TrTile& t, const float* lds, int tid) {
    const int c = tid >> 3, ks = (tid & 7) * 8;
    u32x4 o;
    o[0] = pack2(lds[(ks + 0) * 65 + c], lds[(ks + 1) * 65 + c]);
    o[1] = pack2(lds[(ks + 2) * 65 + c], lds[(ks + 3) * 65 + c]);
    o[2] = pack2(lds[(ks + 4) * 65 + c], lds[(ks + 5) * 65 + c]);
    o[3] = pack2(lds[(ks + 6) * 65 + c], lds[(ks + 7) * 65 + c]);
    *(u32x4*)(t.dst + (size_t)(t.tc * 64 + c) * t.R + t.tr * 64 + ks) = o;
}
DI void rms_load(f32x4 (&v)[8], const float* __restrict__ x, int lane) {
#pragma unroll
    for (int i = 0; i < 8; ++i) v[i] = ((const f32x4*)x)[i * 64 + lane];
}
DI void rms_finish(const f32x4 (&v)[8], const float* __restrict__ g, bf16_t* __restrict__ out, int lane) {
    float ss = 0.f;
#pragma unroll
    for (int i = 0; i < 8; ++i) ss += v[i][0] * v[i][0] + v[i][1] * v[i][1] + v[i][2] * v[i][2] + v[i][3] * v[i][3];
    ss = wave_sum(ss);
    const float rstd = rsqrtf(ss * (1.0f / 2048.0f) + 1e-6f);
#pragma unroll
    for (int i = 0; i < 8; ++i) {
        const f32x4 g4 = ((const f32x4*)g)[i * 64 + lane];
        u32x2 o; o[0] = pack2(v[i][0] * rstd * g4[0], v[i][1] * rstd * g4[1]); o[1] = pack2(v[i][2] * rstd * g4[2], v[i][3] * rstd * g4[3]);
        ((u32x2*)out)[i * 64 + lane] = o;
    }
}
DI void phase0(const Params& p, unsigned char* smem) {
    float* lds = (float*)smem;
    const int G = p.G, c = blockIdx.x;
    if (c == 0 && threadIdx.x == 0) { *(unsigned*)(p.ws + OFF_CTR) = 0u; *(unsigned*)(p.ws + OFF_CTR + 64) = 0u; }
    constexpr int N_WIN = 32 * 258, N_SQ = 32 * 32, N_UP = 16 * 32;
    constexpr int NTR = N_WIN + N_SQ + 3 * N_UP + N_SQ;
    const int tid = threadIdx.x;
    auto tile_of = [&](int u, TrTile& t) {
        int l = u;
        if (l < N_WIN) { t = {p.in[I_WIN], (bf16_t*)(p.ws + OFF_WT), 2048, INC, l & 31, l >> 5}; return; }
        l -= N_WIN;
        if (l < N_SQ) { t = {p.in[I_WMEMKV], (bf16_t*)(p.ws + OFF_WMEM), 2048, 2048, l & 31, l >> 5}; return; }
        l -= N_SQ;
        if (l < 3 * N_UP) {
            const int w = l / N_UP; l -= w * N_UP;
            t = {w == 0 ? p.in[I_WUPA] : (w == 1 ? p.in[I_WUPB] : p.in[I_WUPC]), (bf16_t*)(p.ws + (w == 0 ? OFF_WUA : (w == 1 ? OFF_WUB : OFF_WUC))), 1024, 2048, l & 15, l >> 4}; return;
        }
        l -= 3 * N_UP;
        t = {p.in[I_WO], (bf16_t*)(p.ws + OFF_WO), 2048, 2048, l & 31, l >> 5};
    };
    {
        TrTile cur, nxt; f32x4 v0, v1;
        int u = c, par = 0;
        if (u < NTR) { tile_of(u, cur); tr_load(cur, v0, v1, tid); }
        for (; u < NTR; u += G) {
            float* buf = lds + par * (64 * 65);
            tr_to_lds(v0, v1, buf, tid);
            const bool more = u + G < NTR;
            if (more) { tile_of(u + G, nxt); tr_load(nxt, v0, v1, tid); }
            __syncthreads();
            tr_store(cur, buf, tid);
            cur = nxt; par ^= 1;
        }
    }
    {
        const int wid = tid >> 6, lane = tid & 63;
        auto row_ptrs = [&](int row, const float*& x, const float*& g, bf16_t*& o) {
            if (row < T_TOK) { x = p.in[I_X] + (size_t)row * 2048; g = p.in[I_NORMG]; o = (bf16_t*)(p.ws + OFF_H) + (size_t)row * 2048; }
            else { x = p.in[I_MEM] + (size_t)(row - T_TOK) * 2048; g = p.in[I_MEMG]; o = (bf16_t*)(p.ws + OFF_M) + (size_t)(row - T_TOK) * 2048; }
        };
        constexpr int NRG = (T_TOK + 2048) / 8;
        f32x4 va[8], vb[8];
        const float* x; const float* g; bf16_t* o;
        int rg = c;
        if (rg < NRG) { row_ptrs(rg * 8 + wid, x, g, o); rms_load(va, x, lane); }
        for (; rg < NRG; rg += 2 * G) {
            const float* x2; const float* g2; bf16_t* o2;
            const bool m1 = rg + G < NRG;
            if (m1) { row_ptrs((rg + G) * 8 + wid, x2, g2, o2); rms_load(vb, x2, lane); }
            rms_finish(va, g, o, lane);
            const bool m2 = rg + 2 * G < NRG;
            if (m2) { row_ptrs((rg + 2 * G) * 8 + wid, x, g, o); rms_load(va, x, lane); }
            if (m1) rms_finish(vb, g2, o2, lane);
        }
    }
    __syncthreads();
}

constexpr int BM = 256, BK = 64, HALF = 128, HTB = HALF * BK * 2;
DI int lds_byte(int r, int c) { const int st = (r >> 4) * 2 + (c >> 5), rr = r & 15, cc = c & 31, ob = rr * 64 + cc * 2; return st * 1024 + (ob ^ (((ob >> 9) & 1) << 5)); }
DI void stage_rc(int b, int& R, int& C) { const int st = b / 1024, sb = b % 1024, swz = sb ^ (((sb >> 9) & 1) << 5); R = (st >> 1) * 16 + swz / 64; C = (st & 1) * 32 + (swz % 64) / 2; }

enum { EPI_BF16 = 0, EPI_UP = 1, EPI_GATE = 2, EPI_SIG = 3, EPI_OUT = 4, EPI_UPG = 5 };
struct Unit { const char* A; const char* B; char* C; int K; int ldc; int kind; int aux; const float* X; const char* Gp; };

template <int PH>
DI void epilogue(const f32x4 (&acc)[2][2][4][2], const Unit& u, int wr, int wc, int fr, int fq, int tid, char* scr) {
    if (PH == 1) {
        const int odd = fr & 1;
        bf16_t* rowe = (bf16_t*)u.C + (size_t)(wr * 64 + (fr & ~1)) * u.ldc + wc * 64 + 16 * fq + odd * 8;
        const size_t step16 = (size_t)16 * u.ldc;
#pragma unroll
        for (int ai = 0; ai < 2; ++ai)
#pragma unroll
            for (int m = 0; m < 4; ++m) {
                asm volatile("" : "+v"(rowe) : : "memory");
                u32x4 o0, o1;
                { const f32x4 a0 = acc[ai][0][m][0], a1 = acc[ai][0][m][1]; o0[0] = pack2(a0[0], a0[1]); o0[1] = pack2(a0[2], a0[3]); o0[2] = pack2(a1[0], a1[1]); o0[3] = pack2(a1[2], a1[3]); }
                { const f32x4 a0 = acc[ai][1][m][0], a1 = acc[ai][1][m][1]; o1[0] = pack2(a0[0], a0[1]); o1[1] = pack2(a0[2], a0[3]); o1[2] = pack2(a1[0], a1[1]); o1[3] = pack2(a1[2], a1[3]); }
                u32x4 snd, rcv, d1, d2;
#pragma unroll
                for (int i = 0; i < 4; ++i) {
                    snd[i] = odd ? o0[i] : o1[i];
                    rcv[i] = (unsigned)__builtin_amdgcn_update_dpp(0, (int)snd[i], 0xB1, 0xf, 0xf, false);
                    d1[i] = odd ? rcv[i] : o0[i];
                    d2[i] = odd ? o1[i] : rcv[i];
                }
                *(u32x4*)rowe = d1;
                *(u32x4*)(rowe + u.ldc) = d2;
                rowe += (m == 3) ? 5 * step16 : step16;
            }
    } else if (PH == 4) {
        const size_t ro0 = (size_t)(wr * 64 + fr) * 2048 + wc * 64 + 16 * fq;
        const float* xp = u.X + ro0; float* op = (float*)u.C + ro0;
#pragma unroll
        for (int ai = 0; ai < 2; ++ai) {
#pragma unroll
            for (int mp = 0; mp < 2; ++mp) {
                asm volatile("" : "+v"(xp), "+v"(op) : : "memory");
                f32x4 xv[2][4];
#pragma unroll
                for (int mm = 0; mm < 2; ++mm)
#pragma unroll
                    for (int q = 0; q < 4; ++q) xv[mm][q] = *(const f32x4*)(xp + mm * 16 * 2048 + q * 4);
                asm volatile("" ::: "memory");
#pragma unroll
                for (int mm = 0; mm < 2; ++mm) {
                    const int m = mp * 2 + mm;
#pragma unroll
                    for (int bj = 0; bj < 2; ++bj)
#pragma unroll
                        for (int n = 0; n < 2; ++n) *(f32x4*)(op + mm * 16 * 2048 + bj * 8 + n * 4) = acc[ai][bj][m][n] + xv[mm][bj * 2 + n];
                }
                xp += 32 * 2048; op += 32 * 2048;
            }
            xp += 64 * 2048; op += 64 * 2048;
        }
    } else if (PH == 5 || PH == 7 || (PH == 3 && u.kind == EPI_UP)) {
        const bool sg = u.kind == EPI_SIG;
        u32x2* sp = (u32x2*)(sg ? u.C : scr) + tid;
#pragma unroll
        for (int ai = 0; ai < 2; ++ai)
#pragma unroll
            for (int m = 0; m < 4; ++m) {
                asm volatile("" : "+v"(sp) : : "memory");
#pragma unroll
                for (int bj = 0; bj < 2; ++bj)
#pragma unroll
                    for (int n = 0; n < 2; ++n) {
                        f32x4 a = acc[ai][bj][m][n];
                        if (sg) { a[0] = sigmoidf_(a[0]); a[1] = sigmoidf_(a[1]); a[2] = sigmoidf_(a[2]); a[3] = sigmoidf_(a[3]); }
                        u32x2 o; o[0] = pack2(a[0], a[1]); o[1] = pack2(a[2], a[3]);
                        sp[(bj * 2 + n) * 512] = o;
                    }
                sp += 4 * 512;
            }
    } else {
        u32x2* sp = (u32x2*)scr + tid;
        const bool isg = u.kind == EPI_GATE;
        const u32x2* gp = isg ? (const u32x2*)scr + tid : (const u32x2*)u.Gp + tid;
        const int mode = u.aux;
        u32x2 uu[2][4], mm[2][4];
        auto issue = [&](int slot) {
#pragma unroll
            for (int q = 0; q < 4; ++q) { uu[slot][q] = gp[q * 512]; mm[slot][q] = (u32x2){0u, 0u}; if (mode != 0) mm[slot][q] = sp[q * 512 + 16384]; }
        };
        issue(0);
#pragma unroll
        for (int ai = 0; ai < 2; ++ai)
#pragma unroll
            for (int m = 0; m < 4; ++m) {
                const int g = ai * 4 + m, cur = g & 1;
                u32x2* spc = sp;
                sp += 4 * 512; gp += 4 * 512;
                asm volatile("" : "+v"(sp), "+v"(gp) : : "memory");
                if (g < 7) issue(cur ^ 1);
                __builtin_amdgcn_sched_barrier(0);
                bf16_t* rowp = (bf16_t*)u.C + (size_t)(ai * 128 + wr * 64 + m * 16 + fr) * u.ldc + wc * 64 + 16 * fq;
#pragma unroll
                for (int bj = 0; bj < 2; ++bj)
#pragma unroll
                    for (int n = 0; n < 2; ++n) {
                        const int q = bj * 2 + n;
                        const u32x2 u2 = uu[cur][q], m2 = mm[cur][q];
                        f32x4 a = acc[ai][bj][m][n];
                        if (isg) { a[0] = sigmoidf_(a[0]); a[1] = sigmoidf_(a[1]); a[2] = sigmoidf_(a[2]); a[3] = sigmoidf_(a[3]); }
                        const float r0 = bflo(m2[0]) + a[0] * bflo(u2[0]);
                        const float r1 = bfhi(m2[0]) + a[1] * bfhi(u2[0]);
                        const float r2 = bflo(m2[1]) + a[2] * bflo(u2[1]);
                        const float r3 = bfhi(m2[1]) + a[3] * bfhi(u2[1]);
                        u32x2 o; o[0] = pack2(r0, r1); o[1] = pack2(r2, r3);
                        if (mode == 2) *(u32x2*)(rowp + bj * 8 + n * 4) = o; else spc[q * 512 + 16384] = o;
                    }
            }
    }
}

DI void tile_pmpn(int tl, int& pm, int& pn) { pm = (tl & 7) + 8 * (tl >> 6); pn = (tl >> 3) & 7; }
DI const char* gate_tile_ptr(const Params& p, int g) {
    const unsigned long long a0 = (unsigned long long)p.out + OFF_G2 + (unsigned long long)g * 131072ull, a1 = (unsigned long long)p.ws + OFF_G + (unsigned long long)(g - 128) * 131072ull;
    return (const char*)(g < 128 ? a0 : a1);
}
DI void gate_unit(const Params& p, int g, Unit& u) {
    const int lt = g >> 1, x = g & 1;
    int pm, pn; tile_pmpn(256 + lt, pm, pn);
    const char* ws = (const char*)p.ws;
    u.X = nullptr; u.ldc = 0; u.Gp = nullptr; u.aux = 0;
    u.K = 2048; u.kind = EPI_SIG;
    u.A = ws + OFF_H + (size_t)pm * 256 * 4096;
    u.B = ws + OFF_WT + (size_t)(10368 + 2048 * x + 256 * pn) * 4096;
    u.C = (char*)gate_tile_ptr(p, g);
}
DI bool p1_unit(const Params& p, int L, Unit& u) {
    if (L >= 2688) return false;

    u.K = 2048; u.kind = EPI_BF16; u.aux = 0; u.X = nullptr; u.Gp = nullptr;
    const char* ws = (const char*)p.ws;
    if (L < 2368) {
        const int gid = L / 296, rem = L - gid * 296, pm = gid * 8 + (rem & 7), ct = rem >> 3;
        int brow, col, ldc; size_t cb;
        if (ct < 8) { brow = ct * 256; cb = OFF_PA; col = ct * 256; ldc = 3072; }
        else if (ct < 12) { brow = 3072 + (ct - 8) * 256; cb = OFF_PA; col = 2048 + (ct - 8) * 256; ldc = 3072; }
        else if (ct < 28) { brow = 4096 + (ct - 12) * 256; cb = OFF_PB; col = (ct - 12) * 256; ldc = 4096; }
        else if (ct == 28) { brow = 8192; cb = OFF_PL; col = 0; ldc = 256; }
        else { brow = 8320 + (ct - 29) * 256; cb = OFF_PC; col = (ct - 29) * 256; ldc = 2048; }
        u.A = ws + OFF_H + (size_t)pm * 256 * 4096; u.B = ws + OFF_WT + (size_t)brow * 4096;
        u.C = (char*)p.ws + cb + ((size_t)pm * 256 * ldc + col) * 2; u.ldc = ldc;
    } else if (L < 2624) {
        const int l = L - 2368, pm = l & 3, pn = l >> 2;
        u.A = ws + OFF_WT + (size_t)(2048 + pm * 256) * 4096; u.B = ws + OFF_H + (size_t)pn * 256 * 4096;
        u.C = (char*)p.ws + OFF_VT + ((size_t)pm * 256 * T_TOK + pn * 256) * 2; u.ldc = T_TOK;
    } else if (L < 2656) {
        const int l = L - 2624, pm = l & 7, pn = l >> 3;
        u.A = ws + OFF_M + (size_t)pm * 256 * 4096; u.B = ws + OFF_WMEM + (size_t)pn * 256 * 4096;
        u.C = (char*)p.ws + OFF_MK + ((size_t)pm * 256 * 1024 + pn * 256) * 2; u.ldc = 1024;
    } else {
        const int l = L - 2656, pm = l & 3, pn = l >> 2;
        u.A = ws + OFF_WMEM + (size_t)(1024 + pm * 256) * 4096; u.B = ws + OFF_M + (size_t)pn * 256 * 4096;
        u.C = (char*)p.ws + OFF_MVT + ((size_t)pm * 256 * 2048 + pn * 256) * 2; u.ldc = 2048;
    }
    return true;
}
constexpr int PG_N = 2;
DI bool p3_unit(const Params& p, int cp, int ui, Unit& u) {
    if (ui >= 12 - PG_N) return false;
    const bool light = ui >= 6;
    int x, isgate; bool pre = false;
    if (!light) { x = ui >> 1; isgate = ui & 1; }
    else { const int li = ui - 6; if (li < PG_N) { x = li; isgate = 0; pre = true; } else { const int r = li - PG_N; x = PG_N + (r >> 1); isgate = r & 1; } }
    const int tl = light ? 256 + cp : cp;
    int pm, pn; tile_pmpn(tl, pm, pn);
    const char* ws = (const char*)p.ws; const char* yo = (const char*)p.out;
    u.X = nullptr; u.ldc = 2048; u.Gp = nullptr;
    u.C = (char*)p.ws + OFF_MERGED + ((size_t)pm * 256 * 2048 + pn * 256) * 2;
    if (!isgate) {
        u.K = 1024; u.kind = pre ? EPI_UPG : EPI_UP; u.aux = pre ? x : 0;
        u.A = yo + (size_t)x * OFF_YB + (size_t)pm * 256 * 2048;
        u.B = ws + (x == 0 ? OFF_WUA : (x == 1 ? OFF_WUB : OFF_WUC)) + (size_t)pn * 256 * 2048;
        if (pre) u.Gp = gate_tile_ptr(p, 2 * cp + x);
    } else {
        u.K = 2048; u.kind = EPI_GATE; u.aux = x;
        u.A = ws + OFF_H + (size_t)pm * 256 * 4096;
        u.B = ws + OFF_WT + (size_t)(10368 + 2048 * x + 256 * pn) * 4096;
    }
    return true;
}
DI bool pg_unit(const Params& p, int ui, Unit& u) {
    if (ui >= 3) return false;
    gate_unit(p, 128 + 3 * ((int)blockIdx.x - 128) + ui, u);
    return true;
}
DI bool p4_unit(const Params& p, int cp, int ui, Unit& u) {
    const int tl = cp + p.G * ui;
    if (tl >= 512) return false;
    int pm, pn; tile_pmpn(tl, pm, pn);
    const char* ws = (const char*)p.ws;
    u.K = 2048; u.kind = EPI_OUT; u.aux = 0; u.ldc = 2048; u.Gp = nullptr;
    u.A = ws + OFF_MERGED + (size_t)pm * 256 * 4096; u.B = ws + OFF_WO + (size_t)pn * 256 * 4096;
    u.C = (char*)(p.out + (size_t)pm * 256 * 2048 + pn * 256);
    u.X = p.in[I_X] + (size_t)pm * 256 * 2048 + pn * 256;
    return true;
}
template <int PH> DI bool get_unit(const Params& p, int cp, int ui, Unit& u) {
    if (PH == 1) return p1_unit(p, ui * p.G + cp, u);
    if (PH == 3) return p3_unit(p, cp, ui, u);
    if (PH == 5) return pg_unit(p, ui, u);
    if (PH == 7) { if (ui >= 1 || cp < 128) return false; gate_unit(p, cp - 128, u); return true; }
    return p4_unit(p, cp, ui, u);
}

template <int PH>
DI void gemm_phase(LAS unsigned char* lds, const Params& p) {
    int tid = threadIdx.x; asm volatile("" : "+v"(tid));
    const int wid = __builtin_amdgcn_readfirstlane(tid >> 6), lane = tid & 63, wr = wid >> 2, wc = wid & 3, fr = lane & 15, fq = lane >> 4;
    const int c = blockIdx.x, cp = (p.G & 7) == 0 ? (c & 7) * (p.G >> 3) + (c >> 3) : c;
    char* scr = (char*)p.ws + OFF_SCR + (size_t)c * SCR_PER_WG;
    int sR[2], sC[2];
#pragma unroll
    for (int i = 0; i < 2; ++i) stage_rc(tid * 16 + i * 8192, sR[i], sC[i]);
    int sRB[2][2];
#pragma unroll
    for (int bj = 0; bj < 2; ++bj)
#pragma unroll
        for (int i = 0; i < 2; ++i) { const int R = sR[i]; sRB[bj][i] = 64 * (R >> 5) + 16 * ((R >> 2) & 3) + 8 * bj + 4 * ((R >> 4) & 1) + (R & 3); }
    const unsigned ldsw = (unsigned)wid * 1024u;
    const int aoff = lds_byte(wr * 64 + fr, fq * 8), boff = lds_byte(wc * 32 + fr, fq * 8);
#define G_SA(b, h) (((b) * 2 + (h)) * HTB)
#define G_SB(b, h) ((4 + (b) * 2 + (h)) * HTB)
#define G_STAGE(bufoff, gbase, KK) do { _Pragma("unroll") for (int _i = 0; _i < 2; ++_i) \
        __builtin_amdgcn_global_load_lds((const unsigned*)((gbase) + (size_t)(unsigned)((sR[_i] * (KK) + sC[_i]) * 2)), (LAS unsigned*)(lds + (bufoff) + ldsw + _i * 8192), 16, 0, 0); } while (0)
#define G_STAGE_B(bufoff, gbase, KK, bj) do { _Pragma("unroll") for (int _i = 0; _i < 2; ++_i) \
        __builtin_amdgcn_global_load_lds((const unsigned*)((gbase) + (size_t)(unsigned)((sRB[bj][_i] * (KK) + sC[_i]) * 2)), (LAS unsigned*)(lds + (bufoff) + ldsw + _i * 8192), 16, 0, 0); } while (0)
#define G_LDA(dst, b, h) do { _Pragma("unroll") for (int m = 0; m < 4; ++m) _Pragma("unroll") for (int k = 0; k < 2; ++k) dst[m][k] = *(const LAS bf16x8*)(lds + G_SA(b, h) + aoff + m * 2048 + k * 1024); } while (0)
#define G_LDB(dst, b, h) do { _Pragma("unroll") for (int n = 0; n < 2; ++n) _Pragma("unroll") for (int k = 0; k < 2; ++k) dst[n][k] = *(const LAS bf16x8*)(lds + G_SB(b, h) + boff + n * 2048 + k * 1024); } while (0)
#define G_MMA(ai, bj, At, Bt) do { __builtin_amdgcn_s_setprio(1); _Pragma("unroll") for (int m = 0; m < 4; ++m) _Pragma("unroll") for (int n = 0; n < 2; ++n) _Pragma("unroll") for (int k = 0; k < 2; ++k) \
        acc[ai][bj][m][n] = __builtin_amdgcn_mfma_f32_16x16x32_bf16(Bt[n][k], At[m][k], acc[ai][bj][m][n], 0, 0, 0); __builtin_amdgcn_s_setprio(0); } while (0)
#define G_WAIT_V(n) asm volatile("s_waitcnt vmcnt(" #n ")" ::: "memory")
#define G_WAIT_L(n) asm volatile("s_waitcnt lgkmcnt(" #n ")" ::: "memory")
#define G_BAR __builtin_amdgcn_s_barrier()
#define G_SCHED __builtin_amdgcn_sched_barrier(0)
    Unit cur, nxt; int ui = 0;
    if (!get_unit<PH>(p, cp, 0, cur)) return;
    f32x4 acc[2][2][4][2];
#pragma unroll
    for (int a = 0; a < 2; ++a)
#pragma unroll
        for (int b = 0; b < 2; ++b)
#pragma unroll
            for (int m = 0; m < 4; ++m)
#pragma unroll
                for (int n = 0; n < 2; ++n) acc[a][b][m][n] = (f32x4){0.f, 0.f, 0.f, 0.f};
    bf16x8 At[4][2], B0[2][2], B1[2][2];
    const char* cA = cur.A; const char* cB = cur.B; int Kc = cur.K;
    {
        const size_t hs = (size_t)HALF * Kc * 2;
        G_STAGE_B(G_SB(0, 0), cB, Kc, 0); G_STAGE(G_SA(0, 0), cA, Kc); G_STAGE_B(G_SB(0, 1), cB, Kc, 1); G_STAGE(G_SA(0, 1), cA + hs, Kc);
        if (wr == 1) G_BAR;
        G_WAIT_V(4); G_BAR;
        G_STAGE_B(G_SB(1, 0), cB + 128, Kc, 0); G_STAGE(G_SA(1, 0), cA + 128, Kc); G_STAGE_B(G_SB(1, 1), cB + 128, Kc, 1);
        G_WAIT_V(6); G_BAR;
    }
    for (;;) {
        const bool has_next = get_unit<PH>(p, cp, ui + 1, nxt);
        const char* nA = has_next ? nxt.A : cA; const char* nB = has_next ? nxt.B : cB; const int Kn = has_next ? nxt.K : Kc;
        const int nt = Kc / BK;
        const size_t hsc = (size_t)HALF * Kc * 2;
        for (int t = 0; t < nt; t += 2) {
            const bool last = (t == nt - 2);
            const char* a1 = cA + (size_t)(t + 1) * 128;
            const int K2 = last ? Kn : Kc;
            const size_t hs2 = (size_t)HALF * K2 * 2;
            const char* a2 = last ? nA : cA + (size_t)(t + 2) * 128; const char* b2 = last ? nB : cB + (size_t)(t + 2) * 128;
            const char* a3 = a2 + 128; const char* b3 = b2 + 128;
            G_LDB(B0, 0, 0); G_SCHED; G_LDA(At, 0, 0); G_STAGE(G_SA(1, 1), a1 + hsc, Kc);
            G_WAIT_L(8); G_BAR; G_WAIT_L(0); G_MMA(0, 0, At, B0); G_BAR; G_SCHED;
            G_LDB(B1, 0, 1); G_STAGE_B(G_SB(0, 0), b2, K2, 0);
            G_BAR; G_WAIT_L(0); G_MMA(0, 1, At, B1); G_BAR;
            G_LDA(At, 0, 1); G_STAGE(G_SA(0, 0), a2, K2);
            G_BAR; G_WAIT_L(0); G_MMA(1, 0, At, B0); G_BAR; G_SCHED;
            G_STAGE_B(G_SB(0, 1), b2, K2, 1);
            G_WAIT_V(6); G_BAR; G_MMA(1, 1, At, B1); G_BAR;
            G_LDB(B0, 1, 0); G_SCHED; G_LDA(At, 1, 0); G_STAGE(G_SA(0, 1), a2 + hs2, K2);
            G_WAIT_L(8); G_BAR; G_WAIT_L(0); G_MMA(0, 0, At, B0); G_BAR; G_SCHED;
            G_LDB(B1, 1, 1); G_STAGE_B(G_SB(1, 0), b3, K2, 0);
            G_BAR; G_WAIT_L(0); G_MMA(0, 1, At, B1); G_BAR;
            G_LDA(At, 1, 1); G_STAGE(G_SA(1, 0), a3, K2);
            G_BAR; G_WAIT_L(0); G_MMA(1, 0, At, B0); G_BAR; G_SCHED;
            G_STAGE_B(G_SB(1, 1), b3, K2, 1);
            G_WAIT_V(6); G_BAR; G_MMA(1, 1, At, B1); G_BAR;
        }
        epilogue<PH>(acc, cur, wr, wc, fr, fq, tid, scr);
        if (!has_next) break;
#pragma unroll
        for (int a = 0; a < 2; ++a)
#pragma unroll
            for (int b = 0; b < 2; ++b)
#pragma unroll
                for (int m = 0; m < 4; ++m)
#pragma unroll
                    for (int n = 0; n < 2; ++n) acc[a][b][m][n] = (f32x4){0.f, 0.f, 0.f, 0.f};
        cur = nxt; cA = nA; cB = nB; Kc = Kn; ++ui;
    }
    G_WAIT_V(0);
    if (wr == 0) G_BAR;
    G_BAR;
}

constexpr int SB_W = 0, SB_KK = 8192, SB_BV = 16384, SB_KP = 24576, SB_R = 32768, SB_V = 40960, SB_O = 49152, SB_SIZE = 57344;
constexpr int SC_AWD = 114688, SC_AAD = 119296;
constexpr int SC_ASTR = 144;
DI void ld8(const bf16_t* ptr, float (&f)[8]) {
    const u32x4 v = *(const u32x4*)ptr;
#pragma unroll
    for (int i = 0; i < 4; ++i) { f[2 * i] = bflo(v[i]); f[2 * i + 1] = bfhi(v[i]); }
}
struct ScanOps { f32x4 w0, w1, a0, a1, b0, b1, k0, k1, r0, r1; f32x2 v; };
DI void scan_load(ScanOps& o, const LAS unsigned char* bp, const LAS unsigned char* vp) {
    o.w0 = *(const LAS f32x4*)(bp + SB_W); o.w1 = *(const LAS f32x4*)(bp + SB_W + 16);
    o.a0 = *(const LAS f32x4*)(bp + SB_KK); o.a1 = *(const LAS f32x4*)(bp + SB_KK + 16);
    o.b0 = *(const LAS f32x4*)(bp + SB_BV); o.b1 = *(const LAS f32x4*)(bp + SB_BV + 16);
    o.k0 = *(const LAS f32x4*)(bp + SB_KP); o.k1 = *(const LAS f32x4*)(bp + SB_KP + 16);
    o.r0 = *(const LAS f32x4*)(bp + SB_R); o.r1 = *(const LAS f32x4*)(bp + SB_R + 16);
    o.v = *(const LAS f32x2*)vp;
}
DI f32x2 lo2(f32x4 x) { return (f32x2){x[0], x[1]}; }
DI f32x2 hi2(f32x4 x) { return (f32x2){x[2], x[3]}; }
DI f32x2 splat2(float x) { return (f32x2){x, x}; }
DI void reduce8x2(float& a, float& b) {
    float ra, rb;
    asm volatile("s_nop 1\n\t"
                 "v_add_f32_dpp %0, %2, %2 quad_perm:[1,0,3,2] row_mask:0xf bank_mask:0xf bound_ctrl:1\n\t"
                 "v_add_f32_dpp %1, %3, %3 quad_perm:[1,0,3,2] row_mask:0xf bank_mask:0xf bound_ctrl:1\n\t"
                 "s_nop 0\n\t"
                 "v_add_f32_dpp %0, %0, %0 quad_perm:[2,3,0,1] row_mask:0xf bank_mask:0xf bound_ctrl:1\n\t"
                 "v_add_f32_dpp %1, %1, %1 quad_perm:[2,3,0,1] row_mask:0xf bank_mask:0xf bound_ctrl:1\n\t"
                 "s_nop 0\n\t"
                 "v_add_f32_dpp %0, %0, %0 row_half_mirror row_mask:0xf bank_mask:0xf bound_ctrl:1\n\t"
                 "v_add_f32_dpp %1, %1, %1 row_half_mirror row_mask:0xf bank_mask:0xf bound_ctrl:1\n\t"
                 "s_nop 1"
                 : "=&v"(ra), "=&v"(rb) : "v"(a), "v"(b));
    a = ra; b = rb;
}
DI void scan_step(f32x2 (&S0)[4], f32x2 (&S1)[4], const ScanOps& o, LAS unsigned char* op, bool wr) {
    const f32x2 kk[4] = {lo2(o.a0), hi2(o.a0), lo2(o.a1), hi2(o.a1)};
    f32x2 p0 = S0[0] * kk[0], p1 = S1[0] * kk[0];
#pragma unroll
    for (int q = 1; q < 4; ++q) { p0 = __builtin_elementwise_fma(S0[q], kk[q], p0); p1 = __builtin_elementwise_fma(S1[q], kk[q], p1); }
    float sa0 = p0[0] + p0[1], sa1 = p1[0] + p1[1];
    reduce8x2(sa0, sa1);
    const f32x2 ww[4] = {lo2(o.w0), hi2(o.w0), lo2(o.w1), hi2(o.w1)};
    const f32x2 bb[4] = {lo2(o.b0), hi2(o.b0), lo2(o.b1), hi2(o.b1)};
    const f32x2 kv[4] = {lo2(o.k0), hi2(o.k0), lo2(o.k1), hi2(o.k1)};
    const f32x2 rr[4] = {lo2(o.r0), hi2(o.r0), lo2(o.r1), hi2(o.r1)};
    const f32x2 v0 = splat2(o.v[0]), v1 = splat2(o.v[1]), s0 = splat2(-sa0), s1 = splat2(-sa1);
#pragma unroll
    for (int q = 0; q < 4; ++q) {
        const f32x2 t0 = __builtin_elementwise_fma(bb[q], s0, kv[q] * v0), t1 = __builtin_elementwise_fma(bb[q], s1, kv[q] * v1);
        S0[q] = __builtin_elementwise_fma(S0[q], ww[q], t0); S1[q] = __builtin_elementwise_fma(S1[q], ww[q], t1);
    }
    f32x2 q0 = S0[0] * rr[0], q1 = S1[0] * rr[0];
#pragma unroll
    for (int q = 1; q < 4; ++q) { q0 = __builtin_elementwise_fma(S0[q], rr[q], q0); q1 = __builtin_elementwise_fma(S1[q], rr[q], q1); }
    float o0 = q0[0] + q0[1], o1 = q1[0] + q1[1];
    reduce8x2(o0, o1);
    (void)wr;
    *(LAS f32x2*)op = (f32x2){o0, o1};
}
DI void scan_item(const Params& p, unsigned char* smem, int item) {
    const int b = item >> 4, h = item & 15;
    int tid = threadIdx.x; asm volatile("" : "+v"(tid));
    const int wid = __builtin_amdgcn_readfirstlane(tid >> 6), lane = tid & 63;
    const bf16_t* PB = (const bf16_t*)(p.ws + OFF_PB);
    const bf16_t* PL = (const bf16_t*)(p.ws + OFF_PL);
    bf16_t* YB = (bf16_t*)((char*)p.out + OFF_YB);
    LAS unsigned char* lds = (LAS unsigned char*)smem;
    const bool helper = wid >= 4;
    const int hw = wid & 3, mat = hw >> 1, tn = hw & 1, mr = lane & 31, mh = lane >> 5;
    bf16x8 Bf[4];
    float w0c = 0.f, a0c = 0.f, kac = 0.f;
    if (helper) {
        const float* Wx = (mat == 0 ? p.in[I_W2] : p.in[I_A2]) + h * 64 + tn * 32 + mr;
#pragma unroll
        for (int s = 0; s < 4; ++s) {
            u32x4 pk;
#pragma unroll
            for (int jj = 0; jj < 4; ++jj) pk[jj] = pack2(Wx[(size_t)(16 * s + 8 * mh + 2 * jj) * 1024], Wx[(size_t)(16 * s + 8 * mh + 2 * jj + 1) * 1024]);
            Bf[s] = __builtin_bit_cast(bf16x8, pk);
        }
        const int cj = h * 64 + tn * 32 + mr;
        w0c = p.in[I_W0][cj]; a0c = p.in[I_A0][cj]; kac = p.in[I_KA][cj];
    }
    const int ht = tid & 255, et = ht >> 3, eg = ht & 7, ec = h * 64 + eg * 8;
    float muw[8], mua[8], mur[8], muk[8], muv[8], kkc[8], rkc[8], lnw[8], lnb[8];
    {
        auto ldc = [&](const float* src, float (&d)[8]) { const f32x4 a = *(const f32x4*)src, bq = *(const f32x4*)(src + 4); d[0] = a[0]; d[1] = a[1]; d[2] = a[2]; d[3] = a[3]; d[4] = bq[0]; d[5] = bq[1]; d[6] = bq[2]; d[7] = bq[3]; };
        ldc(p.in[I_MUW] + eg * 8, muw); ldc(p.in[I_MUA] + eg * 8, mua);
        ldc(p.in[I_MURKV] + ec, mur); ldc(p.in[I_MURKV] + 1024 + ec, muk); ldc(p.in[I_MURKV] + 2048 + ec, muv);
        ldc(p.in[I_KK] + ec, kkc); ldc(p.in[I_RK] + ec, rkc); ldc(p.in[I_LNW] + ec, lnw); ldc(p.in[I_LNB] + ec, lnb);
    }
    u32x4 L[10]; u32x4 Z;
#pragma unroll
    for (int i = 0; i < 10; ++i) L[i] = (u32x4){0u, 0u, 0u, 0u};
    Z = (u32x4){0u, 0u, 0u, 0u};
    auto loadA = [&](int ch) {
        const size_t row = (size_t)b * SEQ + ch * 32 + et;
        const size_t prow = (ch * 32 + et) > 0 ? row - 1 : row;
        L[0] = *(const u32x4*)(PL + row * 256 + eg * 8); L[1] = *(const u32x4*)(PL + prow * 256 + eg * 8);
        L[2] = *(const u32x4*)(PL + row * 256 + 64 + eg * 8); L[3] = *(const u32x4*)(PL + prow * 256 + 64 + eg * 8);
#pragma unroll
        for (int q = 0; q < 3; ++q) { L[4 + 2 * q] = *(const u32x4*)(PB + row * 4096 + q * 1024 + ec); L[5 + 2 * q] = *(const u32x4*)(PB + prow * 4096 + q * 1024 + ec); }
    };
    auto loadZ = [&](int ch) { Z = *(const u32x4*)(PB + ((size_t)b * SEQ + ch * 32 + et) * 4096 + 3072 + ec); };
    auto unp = [&](const u32x4& v, float (&f)[8]) {
#pragma unroll
        for (int i = 0; i < 4; ++i) { f[2 * i] = bflo(v[i]); f[2 * i + 1] = bfhi(v[i]); } };
    auto stepA = [&](int ch, int buf) {
        const float pm = (ch * 32 + et) > 0 ? 1.0f : 0.0f;
        LAS unsigned char* bb = lds + buf * SB_SIZE;
        float cur[8], prv[8], x[8];
        unp(L[0], cur); unp(L[1], prv);
        u32x4 o;
#pragma unroll
        for (int i = 0; i < 8; ++i) { const float xx = cur[i] + muw[i] * (prv[i] * pm - cur[i]); x[i] = 1.0f - 2.0f * __builtin_amdgcn_rcpf(1.0f + __expf(2.0f * xx)); }
        o[0] = pack2(x[0], x[1]); o[1] = pack2(x[2], x[3]); o[2] = pack2(x[4], x[5]); o[3] = pack2(x[6], x[7]);
        *(LAS u32x4*)(lds + SC_AWD + et * SC_ASTR + eg * 16) = o;
        unp(L[2], cur); unp(L[3], prv);
#pragma unroll
        for (int i = 0; i < 8; ++i) x[i] = cur[i] + mua[i] * (prv[i] * pm - cur[i]);
        o[0] = pack2(x[0], x[1]); o[1] = pack2(x[2], x[3]); o[2] = pack2(x[4], x[5]); o[3] = pack2(x[6], x[7]);
        *(LAS u32x4*)(lds + SC_AAD + et * SC_ASTR + eg * 16) = o;
#pragma unroll
        for (int q = 0; q < 3; ++q) {
            unp(L[4 + 2 * q], cur); unp(L[5 + 2 * q], prv);
#pragma unroll
            for (int i = 0; i < 8; ++i) { const float m = q == 0 ? mur[i] : (q == 1 ? muk[i] : muv[i]); x[i] = cur[i] + m * (prv[i] * pm - cur[i]); }
            const int dsto = (q == 0 ? SB_R : (q == 1 ? SB_KP : SB_V)) + et * 256 + eg * 32;
            *(LAS f32x4*)(bb + dsto) = (f32x4){x[0], x[1], x[2], x[3]};
            *(LAS f32x4*)(bb + dsto + 16) = (f32x4){x[4], x[5], x[6], x[7]};
            if (q == 1) {
                float kk[8]; float ss = 0.f;
#pragma unroll
                for (int i = 0; i < 8; ++i) { kk[i] = x[i] * kkc[i]; ss += kk[i] * kk[i]; }
                ss = reduce8(ss);
                const float rn = rsqrtf(fmaxf(ss, 1e-24f));
                *(LAS f32x4*)(bb + SB_KK + et * 256 + eg * 32) = (f32x4){kk[0] * rn, kk[1] * rn, kk[2] * rn, kk[3] * rn};
                *(LAS f32x4*)(bb + SB_KK + et * 256 + eg * 32 + 16) = (f32x4){kk[4] * rn, kk[5] * rn, kk[6] * rn, kk[7] * rn};
            }
        }
    };
    auto stepB = [&](int buf) {
        LAS unsigned char* bb = lds + buf * SB_SIZE;
        f32x16 acc;
#pragma unroll
        for (int i = 0; i < 16; ++i) acc[i] = 0.f;
        const int abase = (mat == 0 ? SC_AWD : SC_AAD) + mr * SC_ASTR + mh * 16;
#pragma unroll
        for (int s = 0; s < 4; ++s) { const bf16x8 a = *(const LAS bf16x8*)(lds + abase + s * 32); acc = MFMA32(a, Bf[s], acc); }
        const int jcol = tn * 32 + mr;
#pragma unroll
        for (int i = 0; i < 16; ++i) {
            const int t = crow(i, mh);
            if (mat == 0) {
                const float y = -(w0c + acc[i]);
                const float sp = fmaxf(y, 0.f) + __logf(1.0f + __expf(-fabsf(y)));
                const float w = -sp - 0.5f;
                *(LAS float*)(bb + SB_W + t * 256 + jcol * 4) = __expf(-__expf(w));
            } else {
                const float a = sigmoidf_(a0c + acc[i]);
                const float kl = *(LAS float*)(bb + SB_KP + t * 256 + jcol * 4);
                const float kk = *(LAS float*)(bb + SB_KK + t * 256 + jcol * 4);
                *(LAS float*)(bb + SB_KP + t * 256 + jcol * 4) = kl * (1.0f + (a - 1.0f) * kac);
                *(LAS float*)(bb + SB_BV + t * 256 + jcol * 4) = kk * a;
            }
        }
    };
    auto epi = [&](int ch, int buf) {
        const size_t row = (size_t)b * SEQ + ch * 32 + et;
        LAS unsigned char* bb = lds + buf * SB_SIZE;
        const f32x4 o0 = *(const LAS f32x4*)(bb + SB_O + et * 256 + eg * 32), o1 = *(const LAS f32x4*)(bb + SB_O + et * 256 + eg * 32 + 16);
        float o[8] = {o0[0], o0[1], o0[2], o0[3], o1[0], o1[1], o1[2], o1[3]};
        float sm = 0.f;
#pragma unroll
        for (int i = 0; i < 8; ++i) sm += o[i];
        const float mean = reduce8(sm) * (1.0f / 64.0f);
        float sv = 0.f;
#pragma unroll
        for (int i = 0; i < 8; ++i) { const float d = o[i] - mean; sv += d * d; }
        const float rstd = rsqrtf(reduce8(sv) * (1.0f / 64.0f) + 64e-5f);
        const f32x4 r0 = *(const LAS f32x4*)(bb + SB_R + et * 256 + eg * 32), r1 = *(const LAS f32x4*)(bb + SB_R + et * 256 + eg * 32 + 16);
        const f32x4 k0 = *(const LAS f32x4*)(bb + SB_KP + et * 256 + eg * 32), k1 = *(const LAS f32x4*)(bb + SB_KP + et * 256 + eg * 32 + 16);
        float bs = r0[0] * k0[0] * rkc[0] + r0[1] * k0[1] * rkc[1] + r0[2] * k0[2] * rkc[2] + r0[3] * k0[3] * rkc[3]
                 + r1[0] * k1[0] * rkc[4] + r1[1] * k1[1] * rkc[5] + r1[2] * k1[2] * rkc[6] + r1[3] * k1[3] * rkc[7];
        bs = reduce8(bs);
        const f32x4 v0 = *(const LAS f32x4*)(bb + SB_V + et * 256 + eg * 32), v1 = *(const LAS f32x4*)(bb + SB_V + et * 256 + eg * 32 + 16);
        float z[8]; unp(Z, z);
        float y[8];
#pragma unroll
        for (int i = 0; i < 8; ++i) {
            const float vv = i < 4 ? v0[i] : v1[i - 4];
            y[i] = ((o[i] - mean) * rstd * lnw[i] + lnb[i] + bs * vv) * siluf_(z[i]);
        }
        u32x4 ov; ov[0] = pack2(y[0], y[1]); ov[1] = pack2(y[2], y[3]); ov[2] = pack2(y[4], y[5]); ov[3] = pack2(y[6], y[7]);
        *(u32x4*)(YB + row * 1024 + ec) = ov;
    };

    if (helper) {
        loadA(0); stepA(0, 0); loadA(1);
        __syncthreads();
        stepB(0);
        __syncthreads();
#pragma unroll 1
        for (int ch = 0; ch < SEQ / 32; ++ch) {
            const int buf = ch & 1;
            if (ch > 0) epi(ch - 1, buf ^ 1);
            if (ch + 1 < SEQ / 32) stepA(ch + 1, buf ^ 1);
            if (ch + 2 < SEQ / 32) loadA(ch + 2);
            __syncthreads();
            if (ch + 1 < SEQ / 32) stepB(buf ^ 1);
            loadZ(ch);
            __syncthreads();
        }
        epi(SEQ / 32 - 1, 1);
        __syncthreads();
    } else {
        const int il = lane >> 3, jl = lane & 7, row0 = (wid & 3) * 16 + il * 2;
        f32x2 S0[4], S1[4];
#pragma unroll
        for (int q = 0; q < 4; ++q) { S0[q] = (f32x2){0.f, 0.f}; S1[q] = (f32x2){0.f, 0.f}; }
        __syncthreads();
        __syncthreads();
#pragma unroll 1
        for (int ch = 0; ch < SEQ / 32; ++ch) {
            const int buf = ch & 1;
            const LAS unsigned char* bp = lds + buf * SB_SIZE + jl * 32;
            const LAS unsigned char* vp = lds + buf * SB_SIZE + SB_V + row0 * 4;
            LAS unsigned char* op = lds + buf * SB_SIZE + SB_O + row0 * 4;
#pragma unroll 1
            for (int half = 0; half < 2; ++half) {
                ScanOps oa, ob;
                scan_load(oa, bp + half * 16 * 256, vp + half * 16 * 256);
#pragma unroll 1
                for (int t = half * 16; t < half * 16 + 16; t += 2) {
                    scan_load(ob, bp + (t + 1) * 256, vp + (t + 1) * 256);
                    scan_step(S0, S1, oa, op + t * 256, jl == 0);
                    scan_load(oa, bp + (t + 2) * 256, vp + (t + 2) * 256);
                    scan_step(S0, S1, ob, op + (t + 1) * 256, jl == 0);
                }
                __syncthreads();
            }
        }
        __syncthreads();
    }
}

template <int HD> struct AttnCfg { static constexpr int KSTR = HD * 2 + 16, VSTR = 136, VROWS = HD, K_OFF = 0, V_OFF = 64 * KSTR, BIAS_OFF = V_OFF + VROWS * VSTR; };

template <int HD>
DI void attn_load_q(bf16x8 (&Qf)[HD / 16], const bf16_t* qrow, const float* g, float scale, int mh) {
    u32x4 raw[HD / 16]; float ss = 0.f;
#pragma unroll
    for (int s = 0; s < HD / 16; ++s) {
        raw[s] = *(const u32x4*)(qrow + 16 * s + 8 * mh);
#pragma unroll
        for (int i = 0; i < 4; ++i) { const float a = bflo(raw[s][i]), bb = bfhi(raw[s][i]); ss += a * a + bb * bb; }
    }
    ss += __shfl_xor(ss, 32);
    const float rstd = rsqrtf(ss * (1.0f / HD) + 1e-6f) * scale;
#pragma unroll
    for (int s = 0; s < HD / 16; ++s) {
        const f32x4 g0 = *(const f32x4*)(g + 16 * s + 8 * mh), g1 = *(const f32x4*)(g + 16 * s + 8 * mh + 4);
        u32x4 o;
        o[0] = pack2(bflo(raw[s][0]) * rstd * g0[0], bfhi(raw[s][0]) * rstd * g0[1]);
        o[1] = pack2(bflo(raw[s][1]) * rstd * g0[2], bfhi(raw[s][1]) * rstd * g0[3]);
        o[2] = pack2(bflo(raw[s][2]) * rstd * g1[0], bfhi(raw[s][2]) * rstd * g1[1]);
        o[3] = pack2(bflo(raw[s][3]) * rstd * g1[2], bfhi(raw[s][3]) * rstd * g1[3]);
        Qf[s] = __builtin_bit_cast(bf16x8, o);
    }
}
template <int HD> struct KVRegs { u32x4 k[HD / 64]; u32x4 v[HD == 128 ? 2 : 4]; };
template <int HD>
DI void attn_fetch(KVRegs<HD>& R, const bf16_t* ksrc, size_t ldk, const bf16_t* vsrc, size_t ldv, int tid) {
    constexpr int EPT = HD / 8;
    const int key = tid >> 3, part = tid & 7;
    const bf16_t* src = ksrc + (size_t)key * ldk + part * EPT;
#pragma unroll
    for (int v = 0; v < EPT / 8; ++v) R.k[v] = *(const u32x4*)(src + v * 8);
    constexpr int TPR = 512 / HD, KPT = 64 / TPR;
    const int d = tid / TPR, vpart = tid % TPR;
    const bf16_t* vs = vsrc + (size_t)d * ldv + vpart * KPT;
#pragma unroll
    for (int v = 0; v < KPT / 8; ++v) R.v[v] = *(const u32x4*)(vs + v * 8);
}
template <int HD>
DI void attn_commit(const KVRegs<HD>& R, LAS unsigned char* lds, const float (&gkr)[HD / 8], int tid) {
    constexpr int EPT = HD / 8;
    const int key = tid >> 3, part = tid & 7;
    float ss = 0.f;
#pragma unroll
    for (int v = 0; v < EPT / 8; ++v)
#pragma unroll
        for (int i = 0; i < 4; ++i) { const float a = bflo(R.k[v][i]), bb = bfhi(R.k[v][i]); ss += a * a + bb * bb; }
    ss = reduce8(ss);
    const float rstd = rsqrtf(ss * (1.0f / HD) + 1e-6f);
#pragma unroll
    for (int v = 0; v < EPT / 8; ++v) {
        u32x4 o;
        o[0] = pack2(bflo(R.k[v][0]) * rstd * gkr[v * 8 + 0], bfhi(R.k[v][0]) * rstd * gkr[v * 8 + 1]);
        o[1] = pack2(bflo(R.k[v][1]) * rstd * gkr[v * 8 + 2], bfhi(R.k[v][1]) * rstd * gkr[v * 8 + 3]);
        o[2] = pack2(bflo(R.k[v][2]) * rstd * gkr[v * 8 + 4], bfhi(R.k[v][2]) * rstd * gkr[v * 8 + 5]);
        o[3] = pack2(bflo(R.k[v][3]) * rstd * gkr[v * 8 + 6], bfhi(R.k[v][3]) * rstd * gkr[v * 8 + 7]);
        *(LAS u32x4*)(lds + AttnCfg<HD>::K_OFF + key * AttnCfg<HD>::KSTR + (part * EPT + v * 8) * 2) = o;
    }
    constexpr int TPR = 512 / HD, KPT = 64 / TPR;
    const int d = tid / TPR, vpart = tid % TPR;
#pragma unroll
    for (int v = 0; v < KPT / 8; ++v) {
        LAS unsigned char* dp = lds + AttnCfg<HD>::V_OFF + d * AttnCfg<HD>::VSTR + (vpart * KPT + v * 8) * 2;
        *(LAS u32x2*)dp = (u32x2){R.v[v][0], R.v[v][1]};
        *(LAS u32x2*)(dp + 8) = (u32x2){R.v[v][2], R.v[v][3]};
    }
}
template <int HD, bool BIAS, bool QLDS>
DI void attn_chunk(const bf16x8 (&Qf)[HD / 16], const LAS unsigned char* qp, f32x16 (&O)[4], float& m_run, float& l_run, const LAS unsigned char* lds, int dbase, int mr, int mh, int qk_delta) {
#pragma unroll 1
    for (int kt = 0; kt < 2; ++kt) {
        f32x16 sc;
#pragma unroll
        for (int i = 0; i < 16; ++i) sc[i] = 0.f;
        const LAS unsigned char* kp = lds + AttnCfg<HD>::K_OFF + (kt * 32 + mr) * AttnCfg<HD>::KSTR + mh * 16;
        f32x16 sc2;
#pragma unroll
        for (int i = 0; i < 16; ++i) sc2[i] = 0.f;
#pragma unroll
        for (int s = 0; s < HD / 16; s += 2) {
            if ((s & 3) == 0) __builtin_amdgcn_sched_barrier(0);
            const bf16x8 a0 = *(const LAS bf16x8*)(kp + s * 32), a1 = *(const LAS bf16x8*)(kp + s * 32 + 32);
            const bf16x8 qb0 = QLDS ? *(const LAS bf16x8*)(qp + s * 32) : Qf[s], qb1 = QLDS ? *(const LAS bf16x8*)(qp + s * 32 + 32) : Qf[s + 1];
            sc = MFMA32(a0, qb0, sc); sc2 = MFMA32(a1, qb1, sc2);
        }
#pragma unroll
        for (int i = 0; i < 16; ++i) sc[i] += sc2[i];
        float mx = -1e30f;
        if (BIAS) {
            if (qk_delta >= 192) {
                const float cb = *(const LAS float*)(lds + AttnCfg<HD>::BIAS_OFF + 256 * 4);
#pragma unroll
                for (int i = 0; i < 16; ++i) sc[i] += cb;
            } else {
#pragma unroll
                for (int i = 0; i < 16; ++i) {
                    int dist = qk_delta + mr - (kt * 32 + crow(i, mh));
                    dist = dist < -128 ? -128 : (dist > 128 ? 128 : dist);
                    sc[i] += *(const LAS float*)(lds + AttnCfg<HD>::BIAS_OFF + (dist + 128) * 4);
                }
            }
        }
#pragma unroll
        for (int i = 0; i < 16; ++i) mx = fmaxf(mx, sc[i]);
        mx = fmaxf(mx, __shfl_xor(mx, 32));
        const float m_new = fmaxf(m_run, mx), alpha = __builtin_amdgcn_exp2f(m_run - m_new);
        float ls = 0.f;
#pragma unroll
        for (int i = 0; i < 16; ++i) { const float pv = __builtin_amdgcn_exp2f(sc[i] - m_new); sc[i] = pv; ls += pv; }
        l_run = l_run * alpha + ls;
        if (__builtin_amdgcn_ballot_w64(m_new > m_run) != 0ull) {
#pragma unroll
            for (int dt = 0; dt < 4; ++dt)
#pragma unroll
                for (int i = 0; i < 16; ++i) O[dt][i] *= alpha;
        }
        m_run = m_new;
#pragma unroll
        for (int s2 = 0; s2 < 2; ++s2) {
            u32x4 pk;
#pragma unroll
            for (int j = 0; j < 4; ++j) pk[j] = pack2(sc[8 * s2 + 2 * j], sc[8 * s2 + 2 * j + 1]);
            const bf16x8 pb = __builtin_bit_cast(bf16x8, pk);
#pragma unroll
            for (int dt = 0; dt < 4; ++dt) {
                const LAS unsigned char* vp = lds + AttnCfg<HD>::V_OFF + (dbase + dt * 32 + mr) * AttnCfg<HD>::VSTR + (kt * 32 + 16 * s2 + 4 * mh) * 2;
                const u32x2 lo = *(const LAS u32x2*)vp, hi = *(const LAS u32x2*)(vp + 16);
                const u32x4 va = {lo[0], lo[1], hi[0], hi[1]};
                O[dt] = MFMA32(__builtin_bit_cast(bf16x8, va), pb, O[dt]);
            }
        }
    }
}
DI void attn_store(const f32x16 (&O)[4], float l_run, const bf16_t* zrow, bf16_t* yrow, int mh) {
    const float lt = l_run + __shfl_xor(l_run, 32);
    const float inv = 1.0f / lt;
#pragma unroll
    for (int dt = 0; dt < 4; ++dt)
#pragma unroll
        for (int g = 0; g < 4; ++g) {
            const int d = dt * 32 + 8 * g + 4 * mh;
            const u32x2 zz = *(const u32x2*)(zrow + d);
            u32x2 o;
            o[0] = pack2(O[dt][4 * g] * inv * siluf_(bflo(zz[0])), O[dt][4 * g + 1] * inv * siluf_(bfhi(zz[0])));
            o[1] = pack2(O[dt][4 * g + 2] * inv * siluf_(bflo(zz[1])), O[dt][4 * g + 3] * inv * siluf_(bfhi(zz[1])));
            *(u32x2*)(yrow + d) = o;
        }
}

DI void attnA_item(const Params& p, unsigned char* smem, int item) {
    const int b = item >> 6, head = (item >> 3) & 7, cgp = item & 7;
    int tid = threadIdx.x; asm volatile("" : "+v"(tid));
    const int wid = tid >> 6, lane = tid & 63, mr = lane & 31, mh = lane >> 5;
    LAS unsigned char* lds = (LAS unsigned char*)smem;
    const bf16_t* PA = (const bf16_t*)(p.ws + OFF_PA);
    const bf16_t* VT = (const bf16_t*)(p.ws + OFF_VT);
    bf16_t* YA = (bf16_t*)((char*)p.out + OFF_YA);
    const int cw = cgp * 4 + (wid >> 1), qt = wid & 1;
    const size_t qrow = (size_t)b * SEQ + cw * 64 + qt * 32 + mr;
    if (tid < 257) *(LAS float*)(lds + AttnCfg<128>::BIAS_OFF + tid * 4) = p.in[I_RELB][head * 257 + tid] * 1.4426950408889634f;
    bf16x8 Qf[8];
    attn_load_q<128>(Qf, PA + qrow * 3072 + head * 128, p.in[I_AQG], 0.08838834764831845f * 1.4426950408889634f, mh);
    f32x16 O[4];
#pragma unroll
    for (int dt = 0; dt < 4; ++dt)
#pragma unroll
        for (int i = 0; i < 16; ++i) O[dt][i] = 0.f;
    float m_run = -1e30f, l_run = 0.f;
    const int kc0 = cgp * 4 - 8 < 0 ? 0 : cgp * 4 - 8, kc1 = cgp * 4 + 3;
    const bf16_t* kbase = PA + (size_t)b * SEQ * 3072 + 1024 + head * 128;
    const bf16_t* vbase = VT + (size_t)(head * 128) * T_TOK + (size_t)b * SEQ;
    float gkr[16];
    {
#pragma unroll
        for (int i = 0; i < 4; ++i) { const f32x4 g4 = *(const f32x4*)(p.in[I_AKG] + (tid & 7) * 16 + i * 4); gkr[4 * i] = g4[0]; gkr[4 * i + 1] = g4[1]; gkr[4 * i + 2] = g4[2]; gkr[4 * i + 3] = g4[3]; }
    }
    KVRegs<128> R;
    attn_fetch<128>(R, kbase + (size_t)kc0 * 64 * 3072, 3072, vbase + kc0 * 64, T_TOK, tid);
    for (int kc = kc0; kc <= kc1; ++kc) {
        __syncthreads();
        attn_commit<128>(R, lds, gkr, tid);
        __syncthreads();
        if (kc < kc1) attn_fetch<128>(R, kbase + (size_t)(kc + 1) * 64 * 3072, 3072, vbase + (kc + 1) * 64, T_TOK, tid);
        if (kc >= cw - 8 && kc <= cw)
            attn_chunk<128, true, false>(Qf, lds, O, m_run, l_run, lds, 0, mr, mh, (cw - kc) * 64 + qt * 32);
    }
    attn_store(O, l_run, PA + qrow * 3072 + 2048 + head * 128, YA + qrow * 1024 + head * 128, mh);
    __syncthreads();
    if (tid == 0) __hip_atomic_fetch_add((unsigned*)(p.ws + OFF_CTR + 64), 1u, __ATOMIC_RELAXED, __HIP_MEMORY_SCOPE_AGENT);
}
DI void attnC_item(const Params& p, unsigned char* smem, int item) {
    const int b = item >> 6, hc = (item >> 4) & 3, qg = item & 15;
    int tid = threadIdx.x; asm volatile("" : "+v"(tid));
    const int wid = tid >> 6, lane = tid & 63, mr = lane & 31, mh = lane >> 5;
    LAS unsigned char* lds = (LAS unsigned char*)smem;
    const bf16_t* PC = (const bf16_t*)(p.ws + OFF_PC);
    const bf16_t* MK = (const bf16_t*)(p.ws + OFF_MK);
    const bf16_t* MVT = (const bf16_t*)(p.ws + OFF_MVT);
    bf16_t* YC = (bf16_t*)((char*)p.out + OFF_YC);
    const int qt = wid >> 1, dh = wid & 1;
    const size_t qrow = (size_t)b * SEQ + qg * 128 + qt * 32 + mr;
    constexpr int Q_OFF = AttnCfg<256>::V_OFF + 256 * AttnCfg<256>::VSTR;
    __syncthreads();
    {
        bf16x8 Qf[16];
        attn_load_q<256>(Qf, PC + qrow * 2048 + hc * 256, p.in[I_CQG], 0.0625f * 1.4426950408889634f, mh);
        if (dh == 0) {
#pragma unroll
            for (int s = 0; s < 16; ++s) *(LAS bf16x8*)(lds + Q_OFF + (qt * 32 + mr) * 528 + s * 32 + mh * 16) = Qf[s];
        }
    }
    const LAS unsigned char* qp = lds + Q_OFF + (qt * 32 + mr) * 528 + mh * 16;
    bf16x8 Qd[16];
    f32x16 O[4];
#pragma unroll
    for (int dt = 0; dt < 4; ++dt)
#pragma unroll
        for (int i = 0; i < 16; ++i) O[dt][i] = 0.f;
    float m_run = -1e30f, l_run = 0.f;
    const bf16_t* kbase = MK + (size_t)b * NMEM * 1024 + hc * 256;
    const bf16_t* vbase = MVT + (size_t)(hc * 256) * 2048 + (size_t)b * NMEM;
    float gkr[32];
    {
#pragma unroll
        for (int i = 0; i < 8; ++i) { const f32x4 g4 = *(const f32x4*)(p.in[I_CKG] + (tid & 7) * 32 + i * 4); gkr[4 * i] = g4[0]; gkr[4 * i + 1] = g4[1]; gkr[4 * i + 2] = g4[2]; gkr[4 * i + 3] = g4[3]; }
    }
    KVRegs<256> R;
    attn_fetch<256>(R, kbase, 1024, vbase, 2048, tid);
    for (int kc = 0; kc < 4; ++kc) {
        __syncthreads();
        attn_commit<256>(R, lds, gkr, tid);
        __syncthreads();
        if (kc < 3) attn_fetch<256>(R, kbase + (size_t)(kc + 1) * 64 * 1024, 1024, vbase + (kc + 1) * 64, 2048, tid);
        attn_chunk<256, false, true>(Qd, qp, O, m_run, l_run, lds, dh * 128, mr, mh, 0);
    }
    attn_store(O, l_run, PC + qrow * 2048 + 1024 + hc * 256 + dh * 128, YC + qrow * 1024 + hc * 256 + dh * 128, mh);
    __syncthreads();
}
DI void phase2(const Params& p, unsigned char* smem) {
    const int c = blockIdx.x;
    if (c < 128) scan_item(p, smem, c);
    for (int it = c + p.G; it < 128 && c < 128; it += p.G) scan_item(p, smem, it);
    unsigned* ctr = (unsigned*)(p.ws + OFF_CTR);
    LAS int* sitem = (LAS int*)((LAS unsigned char*)smem + LDS_BYTES - 16);
    auto fetch = [&]() -> int {
        __syncthreads();
        if (threadIdx.x == 0) *sitem = (int)atomicAdd(ctr, 1u);
        __syncthreads();
        return *sitem;
    };
    int item = fetch();
    while (item < 512) { attnA_item(p, smem, item); item = fetch(); }
    while (item < 1024) { attnC_item(p, smem, item - 512); item = fetch(); }
    if (blockIdx.x >= 128 && p.G == 256) {
        if (threadIdx.x == 0) { while (__hip_atomic_load((unsigned*)(p.ws + OFF_CTR + 64), __ATOMIC_RELAXED, __HIP_MEMORY_SCOPE_AGENT) < 512u) __builtin_amdgcn_s_sleep(8); }
        __syncthreads();
        gemm_phase<5>((LAS unsigned char*)smem, p);
    }
}

__global__ void __launch_bounds__(NTHREADS) hybrid_fwd(Params p) {
    extern __shared__ __attribute__((aligned(16))) unsigned char smem[];
    cg::grid_group grid = cg::this_grid();
#ifndef PHMASK
#define PHMASK 31
#endif
    if (PHMASK & 1) phase0(p, smem);
    grid.sync();
    if (PHMASK & 2) { gemm_phase<1>((LAS unsigned char*)smem, p); gemm_phase<7>((LAS unsigned char*)smem, p); }
    grid.sync();
    if (PHMASK & 4) phase2(p, smem);
    grid.sync();
    if (PHMASK & 8) gemm_phase<3>((LAS unsigned char*)smem, p);
    grid.sync();
    if (PHMASK & 16) gemm_phase<4>((LAS unsigned char*)smem, p);
}

extern "C" void kernel_launch(void* const* d_in, const int* in_sizes, int n_in, void* d_out, int out_size, void* d_ws, size_t ws_size, hipStream_t stream) {
    static int grid_blocks = 0;
    if (grid_blocks == 0) {
        if (n_in != 27 || ws_size < WS_END || out_size != T_TOK * DM) { fprintf(stderr, "kernel_launch: unexpected shapes (n_in %d ws %zu out %d)\n", n_in, ws_size, out_size); grid_blocks = -1; return; }
        int dev = 0, cus = 0, per_cu = 0;
        hipGetDevice(&dev);
        hipDeviceGetAttribute(&cus, hipDeviceAttributeMultiprocessorCount, dev);
        if (hipFuncSetAttribute((const void*)hybrid_fwd, hipFuncAttributeMaxDynamicSharedMemorySize, LDS_BYTES) != hipSuccess) { fprintf(stderr, "kernel_launch: hipFuncSetAttribute failed\n"); grid_blocks = -1; return; }
        if (hipOccupancyMaxActiveBlocksPerMultiprocessor(&per_cu, (const void*)hybrid_fwd, NTHREADS, LDS_BYTES) != hipSuccess || per_cu < 1) { fprintf(stderr, "kernel_launch: occupancy query failed (%d)\n", per_cu); grid_blocks = -1; return; }
        grid_blocks = cus * 1;
        if (grid_blocks != 256) { fprintf(stderr, "kernel_launch: built for 256 CUs, found %d\n", cus); grid_blocks = -1; return; }
    }
    if (grid_blocks < 0) return;
    Params p{};
    for (int i = 0; i < 27; ++i) p.in[i] = (const float*)d_in[i];
    p.out = (float*)d_out; p.ws = (unsigned char*)d_ws; p.G = grid_blocks; p.pad = 0;
    void* args[] = {&p};
    hipError_t e = hipLaunchCooperativeKernel((const void*)hybrid_fwd, dim3(grid_blocks), dim3(NTHREADS), args, LDS_BYTES, stream);
    if (e != hipSuccess) fprintf(stderr, "cooperative launch failed: %s (grid %d)\n", hipGetErrorString(e), grid_blocks);
}
```

```cpp
#include <hip/hip_runtime.h>
#include <hip/hip_cooperative_groups.h>
#include <cstdio>
namespace cg = cooperative_groups;

#define DI __device__ __forceinline__
#define LAS __attribute__((address_space(3)))
typedef unsigned short bf16_t;
typedef short bf16x8 __attribute__((ext_vector_type(8)));
typedef float f32x2 __attribute__((ext_vector_type(2)));
typedef float f32x4 __attribute__((ext_vector_type(4)));
typedef float f32x16 __attribute__((ext_vector_type(16)));
typedef unsigned u32x2 __attribute__((ext_vector_type(2)));
typedef unsigned u32x4 __attribute__((ext_vector_type(4)));
typedef __bf16 bf16v2 __attribute__((ext_vector_type(2)));

constexpr int T_TOK = 16384, DM = 2048, SEQ = 2048, NB = 8, NMEM = 256;
constexpr int INC = 16512;
constexpr int NTHREADS = 512;
constexpr int LDS_BYTES = 139264;

constexpr size_t SZ_WT = (size_t)INC * DM * 2;
constexpr size_t OFF_WT = 0;
constexpr size_t OFF_WMEM = OFF_WT + SZ_WT;
constexpr size_t OFF_WUA = OFF_WMEM + (size_t)2048 * 2048 * 2;
constexpr size_t OFF_WUB = OFF_WUA + (size_t)2048 * 1024 * 2;
constexpr size_t OFF_WUC = OFF_WUB + (size_t)2048 * 1024 * 2;
constexpr size_t OFF_WO = OFF_WUC + (size_t)2048 * 1024 * 2;
constexpr size_t OFF_H = OFF_WO + (size_t)2048 * 2048 * 2;
constexpr size_t OFF_M = OFF_H + (size_t)T_TOK * 2048 * 2;
constexpr size_t OFF_PA = OFF_M + (size_t)2048 * 2048 * 2;
constexpr size_t OFF_PB = OFF_PA + (size_t)T_TOK * 3072 * 2;
constexpr size_t OFF_PL = OFF_PB + (size_t)T_TOK * 4096 * 2;
constexpr size_t OFF_PC = OFF_PL + (size_t)T_TOK * 256 * 2;
constexpr size_t OFF_VT = OFF_PC + (size_t)T_TOK * 2048 * 2;
constexpr size_t OFF_MK = OFF_VT + (size_t)1024 * T_TOK * 2;
constexpr size_t OFF_MVT = OFF_MK + (size_t)2048 * 1024 * 2;
constexpr size_t OFF_CTR = OFF_MVT + (size_t)1024 * 2048 * 2;
constexpr size_t WS_END = OFF_CTR + 256;
constexpr size_t OFF_MERGED = OFF_PB;
constexpr size_t OFF_SCR = OFF_PB + (size_t)T_TOK * 2048 * 2;
constexpr size_t OFF_G = OFF_PA;
constexpr size_t SCR_PER_WG = 2 * 131072;
constexpr size_t OFF_YA = 0, OFF_YB = (size_t)T_TOK * 1024 * 2, OFF_YC = 2 * OFF_YB;
constexpr size_t OFF_G2 = 3 * OFF_YB;

struct Params {
    const float* in[27];
    float* out;
    unsigned char* ws;
    int G; int pad;
};
enum { I_X = 0, I_MEM, I_NORMG, I_WIN, I_AQG, I_AKG, I_RELB, I_WUPA, I_MURKV, I_MUW, I_MUA, I_W0, I_W2, I_A0, I_A2, I_KK, I_KA, I_RK, I_LNW, I_LNB, I_WUPB,
       I_MEMG, I_WMEMKV, I_CQG, I_CKG, I_WUPC, I_WO };

DI unsigned pack2(float lo, float hi) { f32x2 v = {lo, hi}; bf16v2 b = __builtin_convertvector(v, bf16v2); return __builtin_bit_cast(unsigned, b); }
DI float bflo(unsigned u) { return __uint_as_float(u << 16); }
DI float bfhi(unsigned u) { return __uint_as_float(u & 0xffff0000u); }
DI float sigmoidf_(float x) { return __builtin_amdgcn_rcpf(1.0f + __expf(-x)); }
DI float siluf_(float x) { return x * sigmoidf_(x); }
DI float wave_sum(float v) {
#pragma unroll
    for (int o = 32; o > 0; o >>= 1) v += __shfl_xor(v, o);
    return v;
}
template <int CTRL> DI float dpp_mov(float x) { return __int_as_float(__builtin_amdgcn_update_dpp(0, __float_as_int(x), CTRL, 0xf, 0xf, false)); }
DI float reduce8(float x) {
    x += dpp_mov<0xB1>(x);
    x += dpp_mov<0x4E>(x);
    x += dpp_mov<0x141>(x);
    return x;
}
DI int crow(int i, int h) { return (i & 3) + 8 * (i >> 2) + 4 * h; }
#define MFMA32(a, b, c) __builtin_amdgcn_mfma_f32_32x32x16_bf16((a), (b), (c), 0, 0, 0)

struct TrTile { const float* src; bf16_t* dst; int R, C, tr, tc; };
DI void tr_load(const TrTile& t, f32x4& v0, f32x4& v1, int tid) {
    const int r = tid >> 3, cs = (tid & 7) * 8;
    const float* sp = t.src + (size_t)(t.tr * 64 + r) * t.C + t.tc * 64 + cs;
    v0 = __builtin_nontemporal_load((const f32x4*)sp); v1 = __builtin_nontemporal_load((const f32x4*)(sp + 4));
}
DI void tr_to_lds(const f32x4& v0, const f32x4& v1, float* lds, int tid) {
    const int r = tid >> 3, cs = (tid & 7) * 8;
    float* lp = lds + r * 65 + cs;
    lp[0] = v0[0]; lp[1] = v0[1]; lp[2] = v0[2]; lp[3] = v0[3]; lp[4] = v1[0]; lp[5] = v1[1]; lp[6] = v1[2]; lp[7] = v1[3];
}
DI void tr_store(const TrTile& t, const float* lds, int tid) {
    const int c = tid >> 3, ks = (tid & 7) * 8;
    u32x4 o;
    o[0] = pack2(lds[(ks + 0) * 65 + c], lds[(ks + 1) * 65 + c]);
    o[1] = pack2(lds[(ks + 2) * 65 + c], lds[(ks + 3) * 65 + c]);
    o[2] = pack2(lds[(ks + 4) * 65 + c], lds[(ks + 5) * 65 + c]);
    o[3] = pack2(lds[(ks + 6) * 65 + c], lds[(ks + 7) * 65 + c]);
    *(u32x4*)(t.dst + (size_t)(t.tc * 64 + c) * t.R + t.tr * 64 + ks) = o;
}
DI void rms_load(f32x4 (&v)[8], const float* __restrict__ x, int lane) {
#pragma unroll
    for (int i = 0; i < 8; ++i) v[i] = __builtin_nontemporal_load((const f32x4*)x + i * 64 + lane);
}
DI void rms_finish(const f32x4 (&v)[8], const float* __restrict__ g, bf16_t* __restrict__ out, int lane) {
    float ss = 0.f;
#pragma unroll
    for (int i = 0; i < 8; ++i) ss += v[i][0] * v[i][0] + v[i][1] * v[i][1] + v[i][2] * v[i][2] + v[i][3] * v[i][3];
    ss = wave_sum(ss);
    const float rstd = rsqrtf(ss * (1.0f / 2048.0f) + 1e-6f);
#pragma unroll
    for (int i = 0; i < 8; ++i) {
        const f32x4 g4 = ((const f32x4*)g)[i * 64 + lane];
        u32x2 o; o[0] = pack2(v[i][0] * rstd * g4[0], v[i][1] * rstd * g4[1]); o[1] = pack2(v[i][2] * rstd * g4[2], v[i][3] * rstd * g4[3]);
        ((u32x2*)out)[i * 64 + lane] = o;
    }
}
DI void phase0(const Params& p, unsigned char* smem) {
    float* lds = (float*)smem;
    const int G = p.G, c = blockIdx.x;
    if (c == 0 && threadIdx.x == 0) { *(unsigned*)(p.ws + OFF_CTR) = 0u; *(unsigned*)(p.ws + OFF_CTR + 64) = 0u; }
    constexpr int N_WIN = 32 * 258, N_SQ = 32 * 32, N_UP = 16 * 32;
    constexpr int NTR = N_WIN + N_SQ + 3 * N_UP + N_SQ;
    const int tid = threadIdx.x;
    auto tile_of = [&](int u, TrTile& t) {
        int l = u;
        if (l < N_WIN) { t = {p.in[I_WIN], (bf16_t*)(p.ws + OFF_WT), 2048, INC, l & 31, l >> 5}; return; }
        l -= N_WIN;
        if (l < N_SQ) { t = {p.in[I_WMEMKV], (bf16_t*)(p.ws + OFF_WMEM), 2048, 2048, l & 31, l >> 5}; return; }
        l -= N_SQ;
        if (l < 3 * N_UP) {
            const int w = l / N_UP; l -= w * N_UP;
            t = {w == 0 ? p.in[I_WUPA] : (w == 1 ? p.in[I_WUPB] : p.in[I_WUPC]), (bf16_t*)(p.ws + (w == 0 ? OFF_WUA : (w == 1 ? OFF_WUB : OFF_WUC))), 1024, 2048, l & 15, l >> 4}; return;
        }
        l -= 3 * N_UP;
        t = {p.in[I_WO], (bf16_t*)(p.ws + OFF_WO), 2048, 2048, l & 31, l >> 5};
    };
    {
        TrTile cur, nxt; f32x4 v0, v1;
        int u = c, par = 0;
        if (u < NTR) { tile_of(u, cur); tr_load(cur, v0, v1, tid); }
        for (; u < NTR; u += G) {
            float* buf = lds + par * (64 * 65);
            tr_to_lds(v0, v1, buf, tid);
            const bool more = u + G < NTR;
            if (more) { tile_of(u + G, nxt); tr_load(nxt, v0, v1, tid); }
            __syncthreads();
            tr_store(cur, buf, tid);
            cur = nxt; par ^= 1;
        }
    }
    {
        const int wid = tid >> 6, lane = tid & 63;
        auto row_ptrs = [&](int row, const float*& x, const float*& g, bf16_t*& o) {
            if (row < T_TOK) { x = p.in[I_X] + (size_t)row * 2048; g = p.in[I_NORMG]; o = (bf16_t*)(p.ws + OFF_H) + (size_t)row * 2048; }
            else { x = p.in[I_MEM] + (size_t)(row - T_TOK) * 2048; g = p.in[I_MEMG]; o = (bf16_t*)(p.ws + OFF_M) + (size_t)(row - T_TOK) * 2048; }
        };
        constexpr int NRG = (T_TOK + 2048) / 8;
        f32x4 va[8], vb[8];
        const float* x; const float* g; bf16_t* o;
        int rg = c;
        if (rg < NRG) { row_ptrs(rg * 8 + wid, x, g, o); rms_load(va, x, lane); }
        for (; rg < NRG; rg += 2 * G) {
            const float* x2; const float* g2; bf16_t* o2;
            const bool m1 = rg + G < NRG;
            if (m1) { row_ptrs((rg + G) * 8 + wid, x2, g2, o2); rms_load(vb, x2, lane); }
            rms_finish(va, g, o, lane);
            const bool m2 = rg + 2 * G < NRG;
            if (m2) { row_ptrs((rg + 2 * G) * 8 + wid, x, g, o); rms_load(va, x, lane); }
            if (m1) rms_finish(vb, g2, o2, lane);
        }
    }
    __syncthreads();
}

constexpr int BM = 256, BK = 64, HALF = 128, HTB = HALF * BK * 2;
DI int lds_byte(int r, int c) { const int st = (r >> 4) * 2 + (c >> 5), rr = r & 15, cc = c & 31, ob = rr * 64 + cc * 2; return st * 1024 + (ob ^ (((ob >> 9) & 1) << 5)); }
DI void stage_rc(int b, int& R, int& C) { const int st = b / 1024, sb = b % 1024, swz = sb ^ (((sb >> 9) & 1) << 5); R = (st >> 1) * 16 + swz / 64; C = (st & 1) * 32 + (swz % 64) / 2; }

enum { EPI_BF16 = 0, EPI_UP = 1, EPI_GATE = 2, EPI_SIG = 3, EPI_OUT = 4, EPI_UPG = 5 };
struct Unit { const char* A; const char* B; char* C; int K; int ldc; int kind; int aux; const float* X; const char* Gp; };

template <int PH>
DI void epilogue(const f32x4 (&acc)[2][2][4][2], const Unit& u, int wr, int wc, int fr, int fq, int tid, char* scr) {
    if (PH == 1) {
        const int odd = fr & 1;
        bf16_t* rowe = (bf16_t*)u.C + (size_t)(wr * 64 + (fr & ~1)) * u.ldc + wc * 64 + 16 * fq + odd * 8;
        const size_t step16 = (size_t)16 * u.ldc;
#pragma unroll
        for (int ai = 0; ai < 2; ++ai)
#pragma unroll
            for (int m = 0; m < 4; ++m) {
                asm volatile("" : "+v"(rowe) : : "memory");
                u32x4 o0, o1;
                { const f32x4 a0 = acc[ai][0][m][0], a1 = acc[ai][0][m][1]; o0[0] = pack2(a0[0], a0[1]); o0[1] = pack2(a0[2], a0[3]); o0[2] = pack2(a1[0], a1[1]); o0[3] = pack2(a1[2], a1[3]); }
                { const f32x4 a0 = acc[ai][1][m][0], a1 = acc[ai][1][m][1]; o1[0] = pack2(a0[0], a0[1]); o1[1] = pack2(a0[2], a0[3]); o1[2] = pack2(a1[0], a1[1]); o1[3] = pack2(a1[2], a1[3]); }
                u32x4 snd, rcv, d1, d2;
#pragma unroll
                for (int i = 0; i < 4; ++i) {
                    snd[i] = odd ? o0[i] : o1[i];
                    rcv[i] = (unsigned)__builtin_amdgcn_update_dpp(0, (int)snd[i], 0xB1, 0xf, 0xf, false);
                    d1[i] = odd ? rcv[i] : o0[i];
                    d2[i] = odd ? o1[i] : rcv[i];
                }
                *(u32x4*)rowe = d1;
                *(u32x4*)(rowe + u.ldc) = d2;
                rowe += (m == 3) ? 5 * step16 : step16;
            }
    } else if (PH == 4) {
        const size_t ro0 = (size_t)(wr * 64 + fr) * 2048 + wc * 64 + 16 * fq;
        const float* xp = u.X + ro0; float* op = (float*)u.C + ro0;
#pragma unroll
        for (int ai = 0; ai < 2; ++ai) {
#pragma unroll
            for (int mp = 0; mp < 2; ++mp) {
                asm volatile("" : "+v"(xp), "+v"(op) : : "memory");
                f32x4 xv[2][4];
#pragma unroll
                for (int mm = 0; mm < 2; ++mm)
#pragma unroll
                    for (int q = 0; q < 4; ++q) xv[mm][q] = *(const f32x4*)(xp + mm * 16 * 2048 + q * 4);
                asm volatile("" ::: "memory");
#pragma unroll
                for (int mm = 0; mm < 2; ++mm) {
                    const int m = mp * 2 + mm;
#pragma unroll
                    for (int bj = 0; bj < 2; ++bj)
#pragma unroll
                        for (int n = 0; n < 2; ++n) *(f32x4*)(op + mm * 16 * 2048 + bj * 8 + n * 4) = acc[ai][bj][m][n] + xv[mm][bj * 2 + n];
                }
                xp += 32 * 2048; op += 32 * 2048;
            }
            xp += 64 * 2048; op += 64 * 2048;
        }
    } else if (PH == 5 || PH == 7 || (PH == 3 && u.kind == EPI_UP)) {
        const bool sg = u.kind == EPI_SIG;
        u32x2* sp = (u32x2*)(sg ? u.C : scr) + tid;
#pragma unroll
        for (int ai = 0; ai < 2; ++ai)
#pragma unroll
            for (int m = 0; m < 4; ++m) {
                asm volatile("" : "+v"(sp) : : "memory");
#pragma unroll
                for (int bj = 0; bj < 2; ++bj)
#pragma unroll
                    for (int n = 0; n < 2; ++n) {
                        f32x4 a = acc[ai][bj][m][n];
                        if (sg) { a[0] = sigmoidf_(a[0]); a[1] = sigmoidf_(a[1]); a[2] = sigmoidf_(a[2]); a[3] = sigmoidf_(a[3]); }
                        u32x2 o; o[0] = pack2(a[0], a[1]); o[1] = pack2(a[2], a[3]);
                        sp[(bj * 2 + n) * 512] = o;
                    }
                sp += 4 * 512;
            }
    } else {
        u32x2* sp = (u32x2*)scr + tid;
        const bool isg = u.kind == EPI_GATE;
        const u32x2* gp = isg ? (const u32x2*)scr + tid : (const u32x2*)u.Gp + tid;
        const int mode = u.aux;
        u32x2 uu[2][4], mm[2][4];
        auto issue = [&](int slot) {
#pragma unroll
            for (int q = 0; q < 4; ++q) { uu[slot][q] = gp[q * 512]; mm[slot][q] = (u32x2){0u, 0u}; if (mode != 0) mm[slot][q] = sp[q * 512 + 16384]; }
        };
        issue(0);
#pragma unroll
        for (int ai = 0; ai < 2; ++ai)
#pragma unroll
            for (int m = 0; m < 4; ++m) {
                const int g = ai * 4 + m, cur = g & 1;
                u32x2* spc = sp;
                sp += 4 * 512; gp += 4 * 512;
                asm volatile("" : "+v"(sp), "+v"(gp) : : "memory");
                if (g < 7) issue(cur ^ 1);
                __builtin_amdgcn_sched_barrier(0);
                bf16_t* rowp = (bf16_t*)u.C + (size_t)(ai * 128 + wr * 64 + m * 16 + fr) * u.ldc + wc * 64 + 16 * fq;
#pragma unroll
                for (int bj = 0; bj < 2; ++bj)
#pragma unroll
                    for (int n = 0; n < 2; ++n) {
                        const int q = bj * 2 + n;
                        const u32x2 u2 = uu[cur][q], m2 = mm[cur][q];
                        f32x4 a = acc[ai][bj][m][n];
                        if (isg) { a[0] = sigmoidf_(a[0]); a[1] = sigmoidf_(a[1]); a[2] = sigmoidf_(a[2]); a[3] = sigmoidf_(a[3]); }
                        const float r0 = bflo(m2[0]) + a[0] * bflo(u2[0]);
                        const float r1 = bfhi(m2[0]) + a[1] * bfhi(u2[0]);
                        const float r2 = bflo(m2[1]) + a[2] * bflo(u2[1]);
                        const float r3 = bfhi(m2[1]) + a[3] * bfhi(u2[1]);
                        u32x2 o; o[0] = pack2(r0, r1); o[1] = pack2(r2, r3);
                        if (mode == 2) *(u32x2*)(rowp + bj * 8 + n * 4) = o; else spc[q * 512 + 16384] = o;
                    }
            }
    }
}

DI void tile_pmpn(int tl, int& pm, int& pn) { pm = (tl & 7) + 8 * (tl >> 6); pn = (tl >> 3) & 7; }
DI const char* gate_tile_ptr(const Params& p, int g) {
    const unsigned long long a0 = (unsigned long long)p.out + OFF_G2 + (unsigned long long)g * 131072ull, a1 = (unsigned long long)p.ws + OFF_G + (unsigned long long)(g - 128) * 131072ull;
    return (const char*)(g < 128 ? a0 : a1);
}
DI void gate_unit(const Params& p, int g, Unit& u) {
    const int lt = g >> 1, x = g & 1;
    int pm, pn; tile_pmpn(256 + lt, pm, pn);
    const char* ws = (const char*)p.ws;
    u.X = nullptr; u.ldc = 0; u.Gp = nullptr; u.aux = 0;
    u.K = 2048; u.kind = EPI_SIG;
    u.A = ws + OFF_H + (size_t)pm * 256 * 4096;
    u.B = ws + OFF_WT + (size_t)(10368 + 2048 * x + 256 * pn) * 4096;
    u.C = (char*)gate_tile_ptr(p, g);
}
DI bool p1_unit(const Params& p, int L, Unit& u) {
    if (L >= 2688) return false;

    u.K = 2048; u.kind = EPI_BF16; u.aux = 0; u.X = nullptr; u.Gp = nullptr;
    const char* ws = (const char*)p.ws;
    if (L < 2368) {
        const int gid = L / 296, rem = L - gid * 296, pm = gid * 8 + (rem & 7), ct = rem >> 3;
        int brow, col, ldc; size_t cb;
        if (ct < 8) { brow = ct * 256; cb = OFF_PA; col = ct * 256; ldc = 3072; }
        else if (ct < 12) { brow = 3072 + (ct - 8) * 256; cb = OFF_PA; col = 2048 + (ct - 8) * 256; ldc = 3072; }
        else if (ct < 28) { brow = 4096 + (ct - 12) * 256; cb = OFF_PB; col = (ct - 12) * 256; ldc = 4096; }
        else if (ct == 28) { brow = 8192; cb = OFF_PL; col = 0; ldc = 256; }
        else { brow = 8320 + (ct - 29) * 256; cb = OFF_PC; col = (ct - 29) * 256; ldc = 2048; }
        u.A = ws + OFF_H + (size_t)pm * 256 * 4096; u.B = ws + OFF_WT + (size_t)brow * 4096;
        u.C = (char*)p.ws + cb + ((size_t)pm * 256 * ldc + col) * 2; u.ldc = ldc;
    } else if (L < 2624) {
        const int l = L - 2368, pm = l & 3, pn = l >> 2;
        u.A = ws + OFF_WT + (size_t)(2048 + pm * 256) * 4096; u.B = ws + OFF_H + (size_t)pn * 256 * 4096;
        u.C = (char*)p.ws + OFF_VT + ((size_t)pm * 256 * T_TOK + pn * 256) * 2; u.ldc = T_TOK;
    } else if (L < 2656) {
        const int l = L - 2624, pm = l & 7, pn = l >> 3;
        u.A = ws + OFF_M + (size_t)pm * 256 * 4096; u.B = ws + OFF_WMEM + (size_t)pn * 256 * 4096;
        u.C = (char*)p.ws + OFF_MK + ((size_t)pm * 256 * 1024 + pn * 256) * 2; u.ldc = 1024;
    } else {
        const int l = L - 2656, pm = l & 3, pn = l >> 2;
        u.A = ws + OFF_WMEM + (size_t)(1024 + pm * 256) * 4096; u.B = ws + OFF_M + (size_t)pn * 256 * 4096;
        u.C = (char*)p.ws + OFF_MVT + ((size_t)pm * 256 * 2048 + pn * 256) * 2; u.ldc = 2048;
    }
    return true;
}
constexpr int PG_N = 2;
DI bool p3_unit(const Params& p, int cp, int ui, Unit& u) {
    if (ui >= 12 - PG_N) return false;
    const bool light = ui >= 6;
    int x, isgate; bool pre = false;
    if (!light) { x = ui >> 1; isgate = ui & 1; }
    else { const int li = ui - 6; if (li < PG_N) { x = li; isgate = 0; pre = true; } else { const int r = li - PG_N; x = PG_N + (r >> 1); isgate = r & 1; } }
    const int tl = light ? 256 + cp : cp;
    int pm, pn; tile_pmpn(tl, pm, pn);
    const char* ws = (const char*)p.ws; const char* yo = (const char*)p.out;
    u.X = nullptr; u.ldc = 2048; u.Gp = nullptr;
    u.C = (char*)p.ws + OFF_MERGED + ((size_t)pm * 256 * 2048 + pn * 256) * 2;
    if (!isgate) {
        u.K = 1024; u.kind = pre ? EPI_UPG : EPI_UP; u.aux = pre ? x : 0;
        u.A = yo + (size_t)x * OFF_YB + (size_t)pm * 256 * 2048;
        u.B = ws + (x == 0 ? OFF_WUA : (x == 1 ? OFF_WUB : OFF_WUC)) + (size_t)pn * 256 * 2048;
        if (pre) u.Gp = gate_tile_ptr(p, 2 * cp + x);
    } else {
        u.K = 2048; u.kind = EPI_GATE; u.aux = x;
        u.A = ws + OFF_H + (size_t)pm * 256 * 4096;
        u.B = ws + OFF_WT + (size_t)(10368 + 2048 * x + 256 * pn) * 4096;
    }
    return true;
}
DI bool pg_unit(const Params& p, int ui, Unit& u) {
    if (ui >= 3) return false;
    gate_unit(p, 128 + 3 * ((int)blockIdx.x - 128) + ui, u);
    return true;
}
DI bool p4_unit(const Params& p, int cp, int ui, Unit& u) {
    const int tl = cp + p.G * ui;
    if (tl >= 512) return false;
    int pm, pn; tile_pmpn(tl, pm, pn);
    const char* ws = (const char*)p.ws;
    u.K = 2048; u.kind = EPI_OUT; u.aux = 0; u.ldc = 2048; u.Gp = nullptr;
    u.A = ws + OFF_MERGED + (size_t)pm * 256 * 4096; u.B = ws + OFF_WO + (size_t)pn * 256 * 4096;
    u.C = (char*)(p.out + (size_t)pm * 256 * 2048 + pn * 256);
    u.X = p.in[I_X] + (size_t)pm * 256 * 2048 + pn * 256;
    return true;
}
template <int PH> DI bool get_unit(const Params& p, int cp, int ui, Unit& u) {
    if (PH == 1) return p1_unit(p, ui * p.G + cp, u);
    if (PH == 3) return p3_unit(p, cp, ui, u);
    if (PH == 5) return pg_unit(p, ui, u);
    if (PH == 7) { if (ui >= 1 || cp < 128) return false; gate_unit(p, cp - 128, u); return true; }
    return p4_unit(p, cp, ui, u);
}

template <int PH>
DI void gemm_phase(LAS unsigned char* lds, const Params& p) {
    int tid = threadIdx.x; asm volatile("" : "+v"(tid));
    const int wid = __builtin_amdgcn_readfirstlane(tid >> 6), lane = tid & 63, wr = wid >> 2, wc = wid & 3, fr = lane & 15, fq = lane >> 4;
    const int c = blockIdx.x, cp = (p.G & 7) == 0 ? (c & 7) * (p.G >> 3) + (c >> 3) : c;
    char* scr = (char*)p.ws + OFF_SCR + (size_t)c * SCR_PER_WG;
    int sR[2], sC[2];
#pragma unroll
    for (int i = 0; i < 2; ++i) stage_rc(tid * 16 + i * 8192, sR[i], sC[i]);
    int sRB[2][2];
#pragma unroll
    for (int bj = 0; bj < 2; ++bj)
#pragma unroll
        for (int i = 0; i < 2; ++i) { const int R = sR[i]; sRB[bj][i] = 64 * (R >> 5) + 16 * ((R >> 2) & 3) + 8 * bj + 4 * ((R >> 4) & 1) + (R & 3); }
    const unsigned ldsw = (unsigned)wid * 1024u;
    const int aoff = lds_byte(wr * 64 + fr, fq * 8), boff = lds_byte(wc * 32 + fr, fq * 8);
#define G_SA(b, h) (((b) * 2 + (h)) * HTB)
#define G_SB(b, h) ((4 + (b) * 2 + (h)) * HTB)
#define G_STAGE(bufoff, gbase, KK) do { _Pragma("unroll") for (int _i = 0; _i < 2; ++_i) \
        __builtin_amdgcn_global_load_lds((const unsigned*)((gbase) + (size_t)(unsigned)((sR[_i] * (KK) + sC[_i]) * 2)), (LAS unsigned*)(lds + (bufoff) + ldsw + _i * 8192), 16, 0, 0); } while (0)
#define G_STAGE_B(bufoff, gbase, KK, bj) do { _Pragma("unroll") for (int _i = 0; _i < 2; ++_i) \
        __builtin_amdgcn_global_load_lds((const unsigned*)((gbase) + (size_t)(unsigned)((sRB[bj][_i] * (KK) + sC[_i]) * 2)), (LAS unsigned*)(lds + (bufoff) + ldsw + _i * 8192), 16, 0, 0); } while (0)
#define G_LDA(dst, b, h) do { _Pragma("unroll") for (int m = 0; m < 4; ++m) _Pragma("unroll") for (int k = 0; k < 2; ++k) dst[m][k] = *(const LAS bf16x8*)(lds + G_SA(b, h) + aoff + m * 2048 + k * 1024); } while (0)
#define G_LDB(dst, b, h) do { _Pragma("unroll") for (int n = 0; n < 2; ++n) _Pragma("unroll") for (int k = 0; k < 2; ++k) dst[n][k] = *(const LAS bf16x8*)(lds + G_SB(b, h) + boff + n * 2048 + k * 1024); } while (0)
#define G_MMA(ai, bj, At, Bt) do { __builtin_amdgcn_s_setprio(1); _Pragma("unroll") for (int m = 0; m < 4; ++m) _Pragma("unroll") for (int n = 0; n < 2; ++n) _Pragma("unroll") for (int k = 0; k < 2; ++k) \
        acc[ai][bj][m][n] = __builtin_amdgcn_mfma_f32_16x16x32_bf16(Bt[n][k], At[m][k], acc[ai][bj][m][n], 0, 0, 0); __builtin_amdgcn_s_setprio(0); } while (0)
#define G_WAIT_V(n) asm volatile("s_waitcnt vmcnt(" #n ")" ::: "memory")
#define G_WAIT_L(n) asm volatile("s_waitcnt lgkmcnt(" #n ")" ::: "memory")
#define G_BAR __builtin_amdgcn_s_barrier()
#define G_SCHED __builtin_amdgcn_sched_barrier(0)
    Unit cur, nxt; int ui = 0;
    if (!get_unit<PH>(p, cp, 0, cur)) return;
    f32x4 acc[2][2][4][2];
#pragma unroll
    for (int a = 0; a < 2; ++a)
#pragma unroll
        for (int b = 0; b < 2; ++b)
#pragma unroll
            for (int m = 0; m < 4; ++m)
#pragma unroll
                for (int n = 0; n < 2; ++n) acc[a][b][m][n] = (f32x4){0.f, 0.f, 0.f, 0.f};
    bf16x8 At[4][2], B0[2][2], B1[2][2];
    const char* cA = cur.A; const char* cB = cur.B; int Kc = cur.K;
    {
        const size_t hs = (size_t)HALF * Kc * 2;
        G_STAGE_B(G_SB(0, 0), cB, Kc, 0); G_STAGE(G_SA(0, 0), cA, Kc); G_STAGE_B(G_SB(0, 1), cB, Kc, 1); G_STAGE(G_SA(0, 1), cA + hs, Kc);
        if (wr == 1) G_BAR;
        G_WAIT_V(4); G_BAR;
        G_STAGE_B(G_SB(1, 0), cB + 128, Kc, 0); G_STAGE(G_SA(1, 0), cA + 128, Kc); G_STAGE_B(G_SB(1, 1), cB + 128, Kc, 1);
        G_WAIT_V(6); G_BAR;
    }
    for (;;) {
        const bool has_next = get_unit<PH>(p, cp, ui + 1, nxt);
        const char* nA = has_next ? nxt.A : cA; const char* nB = has_next ? nxt.B : cB; const int Kn = has_next ? nxt.K : Kc;
        const int nt = Kc / BK;
        const size_t hsc = (size_t)HALF * Kc * 2;
        for (int t = 0; t < nt; t += 2) {
            const bool last = (t == nt - 2);
            const char* a1 = cA + (size_t)(t + 1) * 128;
            const int K2 = last ? Kn : Kc;
            const size_t hs2 = (size_t)HALF * K2 * 2;
            const char* a2 = last ? nA : cA + (size_t)(t + 2) * 128; const char* b2 = last ? nB : cB + (size_t)(t + 2) * 128;
            const char* a3 = a2 + 128; const char* b3 = b2 + 128;
            G_LDB(B0, 0, 0); G_SCHED; G_LDA(At, 0, 0); G_STAGE(G_SA(1, 1), a1 + hsc, Kc);
            G_WAIT_L(8); G_BAR; G_WAIT_L(0); G_MMA(0, 0, At, B0); G_BAR; G_SCHED;
            G_LDB(B1, 0, 1); G_STAGE_B(G_SB(0, 0), b2, K2, 0);
            G_BAR; G_WAIT_L(0); G_MMA(0, 1, At, B1); G_BAR;
            G_LDA(At, 0, 1); G_STAGE(G_SA(0, 0), a2, K2);
            G_BAR; G_WAIT_L(0); G_MMA(1, 0, At, B0); G_BAR; G_SCHED;
            G_STAGE_B(G_SB(0, 1), b2, K2, 1);
            G_WAIT_V(6); G_BAR; G_MMA(1, 1, At, B1); G_BAR;
            G_LDB(B0, 1, 0); G_SCHED; G_LDA(At, 1, 0); G_STAGE(G_SA(0, 1), a2 + hs2, K2);
            G_WAIT_L(8); G_BAR; G_WAIT_L(0); G_MMA(0, 0, At, B0); G_BAR; G_SCHED;
            G_LDB(B1, 1, 1); G_STAGE_B(G_SB(1, 0), b3, K2, 0);
            G_BAR; G_WAIT_L(0); G_MMA(0, 1, At, B1); G_BAR;
            G_LDA(At, 1, 1); G_STAGE(G_SA(1, 0), a3, K2);
            G_BAR; G_WAIT_L(0); G_MMA(1, 0, At, B0); G_BAR; G_SCHED;
            G_STAGE_B(G_SB(1, 1), b3, K2, 1);
            G_WAIT_V(6); G_BAR; G_MMA(1, 1, At, B1); G_BAR;
        }
        epilogue<PH>(acc, cur, wr, wc, fr, fq, tid, scr);
        if (!has_next) break;
#pragma unroll
        for (int a = 0; a < 2; ++a)
#pragma unroll
            for (int b = 0; b < 2; ++b)
#pragma unroll
                for (int m = 0; m < 4; ++m)
#pragma unroll
                    for (int n = 0; n < 2; ++n) acc[a][b][m][n] = (f32x4){0.f, 0.f, 0.f, 0.f};
        cur = nxt; cA = nA; cB = nB; Kc = Kn; ++ui;
    }
    G_WAIT_V(0);
    if (wr == 0) G_BAR;
    G_BAR;
}

constexpr int SB_W = 0, SB_KK = 8192, SB_BV = 16384, SB_KP = 24576, SB_R = 32768, SB_V = 40960, SB_O = 49152, SB_SIZE = 57344;
constexpr int SC_AWD = 114688, SC_AAD = 119296;
constexpr int SC_ASTR = 144;
DI void ld8(const bf16_t* ptr, float (&f)[8]) {
    const u32x4 v = *(const u32x4*)ptr;
#pragma unroll
    for (int i = 0; i < 4; ++i) { f[2 * i] = bflo(v[i]); f[2 * i + 1] = bfhi(v[i]); }
}
struct ScanOps { f32x4 w0, w1, a0, a1, b0, b1, k0, k1, r0, r1; f32x2 v; };
DI void scan_load(ScanOps& o, const LAS unsigned char* bp, const LAS unsigned char* vp) {
    o.w0 = *(const LAS f32x4*)(bp + SB_W); o.w1 = *(const LAS f32x4*)(bp + SB_W + 16);
    o.a0 = *(const LAS f32x4*)(bp + SB_KK); o.a1 = *(const LAS f32x4*)(bp + SB_KK + 16);
    o.b0 = *(const LAS f32x4*)(bp + SB_BV); o.b1 = *(const LAS f32x4*)(bp + SB_BV + 16);
    o.k0 = *(const LAS f32x4*)(bp + SB_KP); o.k1 = *(const LAS f32x4*)(bp + SB_KP + 16);
    o.r0 = *(const LAS f32x4*)(bp + SB_R); o.r1 = *(const LAS f32x4*)(bp + SB_R + 16);
    o.v = *(const LAS f32x2*)vp;
}
DI f32x2 lo2(f32x4 x) { return (f32x2){x[0], x[1]}; }
DI f32x2 hi2(f32x4 x) { return (f32x2){x[2], x[3]}; }
DI f32x2 splat2(float x) { return (f32x2){x, x}; }
DI void reduce8x2(float& a, float& b) {
    float ra, rb;
    asm volatile("s_nop 1\n\t"
                 "v_add_f32_dpp %0, %2, %2 quad_perm:[1,0,3,2] row_mask:0xf bank_mask:0xf bound_ctrl:1\n\t"
                 "v_add_f32_dpp %1, %3, %3 quad_perm:[1,0,3,2] row_mask:0xf bank_mask:0xf bound_ctrl:1\n\t"
                 "s_nop 0\n\t"
                 "v_add_f32_dpp %0, %0, %0 quad_perm:[2,3,0,1] row_mask:0xf bank_mask:0xf bound_ctrl:1\n\t"
                 "v_add_f32_dpp %1, %1, %1 quad_perm:[2,3,0,1] row_mask:0xf bank_mask:0xf bound_ctrl:1\n\t"
                 "s_nop 0\n\t"
                 "v_add_f32_dpp %0, %0, %0 row_half_mirror row_mask:0xf bank_mask:0xf bound_ctrl:1\n\t"
                 "v_add_f32_dpp %1, %1, %1 row_half_mirror row_mask:0xf bank_mask:0xf bound_ctrl:1\n\t"
                 "s_nop 1"
                 : "=&v"(ra), "=&v"(rb) : "v"(a), "v"(b));
    a = ra; b = rb;
}
DI void scan_step(f32x2 (&S0)[4], f32x2 (&S1)[4], const ScanOps& o, LAS unsigned char* op, bool wr) {
    const f32x2 kk[4] = {lo2(o.a0), hi2(o.a0), lo2(o.a1), hi2(o.a1)};
    f32x2 p0 = S0[0] * kk[0], p1 = S1[0] * kk[0];
#pragma unroll
    for (int q = 1; q < 4; ++q) { p0 = __builtin_elementwise_fma(S0[q], kk[q], p0); p1 = __builtin_elementwise_fma(S1[q], kk[q], p1); }
    float sa0 = p0[0] + p0[1], sa1 = p1[0] + p1[1];
    reduce8x2(sa0, sa1);
    const f32x2 ww[4] = {lo2(o.w0), hi2(o.w0), lo2(o.w1), hi2(o.w1)};
    const f32x2 bb[4] = {lo2(o.b0), hi2(o.b0), lo2(o.b1), hi2(o.b1)};
    const f32x2 kv[4] = {lo2(o.k0), hi2(o.k0), lo2(o.k1), hi2(o.k1)};
    const f32x2 rr[4] = {lo2(o.r0), hi2(o.r0), lo2(o.r1), hi2(o.r1)};
    const f32x2 v0 = splat2(o.v[0]), v1 = splat2(o.v[1]), s0 = splat2(-sa0), s1 = splat2(-sa1);
#pragma unroll
    for (int q = 0; q < 4; ++q) {
        const f32x2 t0 = __builtin_elementwise_fma(bb[q], s0, kv[q] * v0), t1 = __builtin_elementwise_fma(bb[q], s1, kv[q] * v1);
        S0[q] = __builtin_elementwise_fma(S0[q], ww[q], t0); S1[q] = __builtin_elementwise_fma(S1[q], ww[q], t1);
    }
    f32x2 q0 = S0[0] * rr[0], q1 = S1[0] * rr[0];
#pragma unroll
    for (int q = 1; q < 4; ++q) { q0 = __builtin_elementwise_fma(S0[q], rr[q], q0); q1 = __builtin_elementwise_fma(S1[q], rr[q], q1); }
    float o0 = q0[0] + q0[1], o1 = q1[0] + q1[1];
    reduce8x2(o0, o1);
    (void)wr;
    *(LAS f32x2*)op = (f32x2){o0, o1};
}
DI void scan_item(const Params& p, unsigned char* smem, int item) {
    const int b = item >> 4, h = item & 15;
    int tid = threadIdx.x; asm volatile("" : "+v"(tid));
    const int wid = __builtin_amdgcn_readfirstlane(tid >> 6), lane = tid & 63;
    const bf16_t* PB = (const bf16_t*)(p.ws + OFF_PB);
    const bf16_t* PL = (const bf16_t*)(p.ws + OFF_PL);
    bf16_t* YB = (bf16_t*)((char*)p.out + OFF_YB);
    LAS unsigned char* lds = (LAS unsigned char*)smem;
    const bool helper = wid >= 4;
    const int hw = wid & 3, mat = hw >> 1, tn = hw & 1, mr = lane & 31, mh = lane >> 5;
    bf16x8 Bf[4];
    float w0c = 0.f, a0c = 0.f, kac = 0.f;
    if (helper) {
        const float* Wx = (mat == 0 ? p.in[I_W2] : p.in[I_A2]) + h * 64 + tn * 32 + mr;
#pragma unroll
        for (int s = 0; s < 4; ++s) {
            u32x4 pk;
#pragma unroll
            for (int jj = 0; jj < 4; ++jj) pk[jj] = pack2(Wx[(size_t)(16 * s + 8 * mh + 2 * jj) * 1024], Wx[(size_t)(16 * s + 8 * mh + 2 * jj + 1) * 1024]);
            Bf[s] = __builtin_bit_cast(bf16x8, pk);
        }
        const int cj = h * 64 + tn * 32 + mr;
        w0c = p.in[I_W0][cj]; a0c = p.in[I_A0][cj]; kac = p.in[I_KA][cj];
    }
    const int ht = tid & 255, et = ht >> 3, eg = ht & 7, ec = h * 64 + eg * 8;
    float muw[8], mua[8], mur[8], muk[8], muv[8], kkc[8], rkc[8], lnw[8], lnb[8];
    {
        auto ldc = [&](const float* src, float (&d)[8]) { const f32x4 a = *(const f32x4*)src, bq = *(const f32x4*)(src + 4); d[0] = a[0]; d[1] = a[1]; d[2] = a[2]; d[3] = a[3]; d[4] = bq[0]; d[5] = bq[1]; d[6] = bq[2]; d[7] = bq[3]; };
        ldc(p.in[I_MUW] + eg * 8, muw); ldc(p.in[I_MUA] + eg * 8, mua);
        ldc(p.in[I_MURKV] + ec, mur); ldc(p.in[I_MURKV] + 1024 + ec, muk); ldc(p.in[I_MURKV] + 2048 + ec, muv);
        ldc(p.in[I_KK] + ec, kkc); ldc(p.in[I_RK] + ec, rkc); ldc(p.in[I_LNW] + ec, lnw); ldc(p.in[I_LNB] + ec, lnb);
    }
    u32x4 L[10]; u32x4 Z;
#pragma unroll
    for (int i = 0; i < 10; ++i) L[i] = (u32x4){0u, 0u, 0u, 0u};
    Z = (u32x4){0u, 0u, 0u, 0u};
    auto loadA = [&](int ch) {
        const size_t row = (size_t)b * SEQ + ch * 32 + et;
        const size_t prow = (ch * 32 + et) > 0 ? row - 1 : row;
        L[0] = *(const u32x4*)(PL + row * 256 + eg * 8); L[1] = *(const u32x4*)(PL + prow * 256 + eg * 8);
        L[2] = *(const u32x4*)(PL + row * 256 + 64 + eg * 8); L[3] = *(const u32x4*)(PL + prow * 256 + 64 + eg * 8);
#pragma unroll
        for (int q = 0; q < 3; ++q) { L[4 + 2 * q] = *(const u32x4*)(PB + row * 4096 + q * 1024 + ec); L[5 + 2 * q] = *(const u32x4*)(PB + prow * 4096 + q * 1024 + ec); }
    };
    auto loadZ = [&](int ch) { Z = *(const u32x4*)(PB + ((size_t)b * SEQ + ch * 32 + et) * 4096 + 3072 + ec); };
    auto unp = [&](const u32x4& v, float (&f)[8]) {
#pragma unroll
        for (int i = 0; i < 4; ++i) { f[2 * i] = bflo(v[i]); f[2 * i + 1] = bfhi(v[i]); } };
    auto stepA = [&](int ch, int buf) {
        const float pm = (ch * 32 + et) > 0 ? 1.0f : 0.0f;
        LAS unsigned char* bb = lds + buf * SB_SIZE;
        float cur[8], prv[8], x[8];
        unp(L[0], cur); unp(L[1], prv);
        u32x4 o;
#pragma unroll
        for (int i = 0; i < 8; ++i) { const float xx = cur[i] + muw[i] * (prv[i] * pm - cur[i]); x[i] = 1.0f - 2.0f * __builtin_amdgcn_rcpf(1.0f + __expf(2.0f * xx)); }
        o[0] = pack2(x[0], x[1]); o[1] = pack2(x[2], x[3]); o[2] = pack2(x[4], x[5]); o[3] = pack2(x[6], x[7]);
        *(LAS u32x4*)(lds + SC_AWD + et * SC_ASTR + eg * 16) = o;
        unp(L[2], cur); unp(L[3], prv);
#pragma unroll
        for (int i = 0; i < 8; ++i) x[i] = cur[i] + mua[i] * (prv[i] * pm - cur[i]);
        o[0] = pack2(x[0], x[1]); o[1] = pack2(x[2], x[3]); o[2] = pack2(x[4], x[5]); o[3] = pack2(x[6], x[7]);
        *(LAS u32x4*)(lds + SC_AAD + et * SC_ASTR + eg * 16) = o;
#pragma unroll
        for (int q = 0; q < 3; ++q) {
            unp(L[4 + 2 * q], cur); unp(L[5 + 2 * q], prv);
#pragma unroll
            for (int i = 0; i < 8; ++i) { const float m = q == 0 ? mur[i] : (q == 1 ? muk[i] : muv[i]); x[i] = cur[i] + m * (prv[i] * pm - cur[i]); }
            const int dsto = (q == 0 ? SB_R : (q == 1 ? SB_KP : SB_V)) + et * 256 + eg * 32;
            *(LAS f32x4*)(bb + dsto) = (f32x4){x[0], x[1], x[2], x[3]};
            *(LAS f32x4*)(bb + dsto + 16) = (f32x4){x[4], x[5], x[6], x[7]};
            if (q == 1) {
                float kk[8]; float ss = 0.f;
#pragma unroll
                for (int i = 0; i < 8; ++i) { kk[i] = x[i] * kkc[i]; ss += kk[i] * kk[i]; }
                ss = reduce8(ss);
                const float rn = rsqrtf(fmaxf(ss, 1e-24f));
                *(LAS f32x4*)(bb + SB_KK + et * 256 + eg * 32) = (f32x4){kk[0] * rn, kk[1] * rn, kk[2] * rn, kk[3] * rn};
                *(LAS f32x4*)(bb + SB_KK + et * 256 + eg * 32 + 16) = (f32x4){kk[4] * rn, kk[5] * rn, kk[6] * rn, kk[7] * rn};
            }
        }
    };
    auto stepB = [&](int buf) {
        LAS unsigned char* bb = lds + buf * SB_SIZE;
        f32x16 acc;
#pragma unroll
        for (int i = 0; i < 16; ++i) acc[i] = 0.f;
        const int abase = (mat == 0 ? SC_AWD : SC_AAD) + mr * SC_ASTR + mh * 16;
#pragma unroll
        for (int s = 0; s < 4; ++s) { const bf16x8 a = *(const LAS bf16x8*)(lds + abase + s * 32); acc = MFMA32(a, Bf[s], acc); }
        const int jcol = tn * 32 + mr;
#pragma unroll
        for (int i = 0; i < 16; ++i) {
            const int t = crow(i, mh);
            if (mat == 0) {
                const float y = -(w0c + acc[i]);
                const float sp = fmaxf(y, 0.f) + __logf(1.0f + __expf(-fabsf(y)));
                const float w = -sp - 0.5f;
                *(LAS float*)(bb + SB_W + t * 256 + jcol * 4) = __expf(-__expf(w));
            } else {
                const float a = sigmoidf_(a0c + acc[i]);
                const float kl = *(LAS float*)(bb + SB_KP + t * 256 + jcol * 4);
                const float kk = *(LAS float*)(bb + SB_KK + t * 256 + jcol * 4);
                *(LAS float*)(bb + SB_KP + t * 256 + jcol * 4) = kl * (1.0f + (a - 1.0f) * kac);
                *(LAS float*)(bb + SB_BV + t * 256 + jcol * 4) = kk * a;
            }
        }
    };
    auto epi = [&](int ch, int buf) {
        const size_t row = (size_t)b * SEQ + ch * 32 + et;
        LAS unsigned char* bb = lds + buf * SB_SIZE;
        const f32x4 o0 = *(const LAS f32x4*)(bb + SB_O + et * 256 + eg * 32), o1 = *(const LAS f32x4*)(bb + SB_O + et * 256 + eg * 32 + 16);
        float o[8] = {o0[0], o0[1], o0[2], o0[3], o1[0], o1[1], o1[2], o1[3]};
        float sm = 0.f;
#pragma unroll
        for (int i = 0; i < 8; ++i) sm += o[i];
        const float mean = reduce8(sm) * (1.0f / 64.0f);
        float sv = 0.f;
#pragma unroll
        for (int i = 0; i < 8; ++i) { const float d = o[i] - mean; sv += d * d; }
        const float rstd = rsqrtf(reduce8(sv) * (1.0f / 64.0f) + 64e-5f);
        const f32x4 r0 = *(const LAS f32x4*)(bb + SB_R + et * 256 + eg * 32), r1 = *(const LAS f32x4*)(bb + SB_R + et * 256 + eg * 32 + 16);
        const f32x4 k0 = *(const LAS f32x4*)(bb + SB_KP + et * 256 + eg * 32), k1 = *(const LAS f32x4*)(bb + SB_KP + et * 256 + eg * 32 + 16);
        float bs = r0[0] * k0[0] * rkc[0] + r0[1] * k0[1] * rkc[1] + r0[2] * k0[2] * rkc[2] + r0[3] * k0[3] * rkc[3]
                 + r1[0] * k1[0] * rkc[4] + r1[1] * k1[1] * rkc[5] + r1[2] * k1[2] * rkc[6] + r1[3] * k1[3] * rkc[7];
        bs = reduce8(bs);
        const f32x4 v0 = *(const LAS f32x4*)(bb + SB_V + et * 256 + eg * 32), v1 = *(const LAS f32x4*)(bb + SB_V + et * 256 + eg * 32 + 16);
        float z[8]; unp(Z, z);
        float y[8];
#pragma unroll
        for (int i = 0; i < 8; ++i) {
            const float vv = i < 4 ? v0[i] : v1[i - 4];
            y[i] = ((o[i] - mean) * rstd * lnw[i] + lnb[i] + bs * vv) * siluf_(z[i]);
        }
        u32x4 ov; ov[0] = pack2(y[0], y[1]); ov[1] = pack2(y[2], y[3]); ov[2] = pack2(y[4], y[5]); ov[3] = pack2(y[6], y[7]);
        *(u32x4*)(YB + row * 1024 + ec) = ov;
    };

    if (helper) {
        loadA(0); stepA(0, 0); loadA(1);
        __syncthreads();
        stepB(0);
        __syncthreads();
#pragma unroll 1
        for (int ch = 0; ch < SEQ / 32; ++ch) {
            const int buf = ch & 1;
            if (ch > 0) epi(ch - 1, buf ^ 1);
            if (ch + 1 < SEQ / 32) stepA(ch + 1, buf ^ 1);
            if (ch + 2 < SEQ / 32) loadA(ch + 2);
            __syncthreads();
            if (ch + 1 < SEQ / 32) stepB(buf ^ 1);
            loadZ(ch);
            __syncthreads();
        }
        epi(SEQ / 32 - 1, 1);
        __syncthreads();
    } else {
        const int il = lane >> 3, jl = lane & 7, row0 = (wid & 3) * 16 + il * 2;
        f32x2 S0[4], S1[4];
#pragma unroll
        for (int q = 0; q < 4; ++q) { S0[q] = (f32x2){0.f, 0.f}; S1[q] = (f32x2){0.f, 0.f}; }
        __syncthreads();
        __syncthreads();
#pragma unroll 1
        for (int ch = 0; ch < SEQ / 32; ++ch) {
            const int buf = ch & 1;
            const LAS unsigned char* bp = lds + buf * SB_SIZE + jl * 32;
            const LAS unsigned char* vp = lds + buf * SB_SIZE + SB_V + row0 * 4;
            LAS unsigned char* op = lds + buf * SB_SIZE + SB_O + row0 * 4;
#pragma unroll 1
            for (int half = 0; half < 2; ++half) {
                ScanOps oa, ob;
                scan_load(oa, bp + half * 16 * 256, vp + half * 16 * 256);
#pragma unroll 1
                for (int t = half * 16; t < half * 16 + 16; t += 2) {
                    scan_load(ob, bp + (t + 1) * 256, vp + (t + 1) * 256);
                    scan_step(S0, S1, oa, op + t * 256, jl == 0);
                    scan_load(oa, bp + (t + 2) * 256, vp + (t + 2) * 256);
                    scan_step(S0, S1, ob, op + (t + 1) * 256, jl == 0);
                }
                __syncthreads();
            }
        }
        __syncthreads();
    }
}

template <int HD> struct AttnCfg { static constexpr int KSTR = HD * 2 + 16, VSTR = 136, VROWS = HD, K_OFF = 0, V_OFF = 64 * KSTR, BIAS_OFF = V_OFF + VROWS * VSTR; };

template <int HD>
DI void attn_load_q(bf16x8 (&Qf)[HD / 16], const bf16_t* qrow, const float* g, float scale, int mh) {
    u32x4 raw[HD / 16]; float ss = 0.f;
#pragma unroll
    for (int s = 0; s < HD / 16; ++s) {
        raw[s] = *(const u32x4*)(qrow + 16 * s + 8 * mh);
#pragma unroll
        for (int i = 0; i < 4; ++i) { const float a = bflo(raw[s][i]), bb = bfhi(raw[s][i]); ss += a * a + bb * bb; }
    }
    ss += __shfl_xor(ss, 32);
    const float rstd = rsqrtf(ss * (1.0f / HD) + 1e-6f) * scale;
#pragma unroll
    for (int s = 0; s < HD / 16; ++s) {
        const f32x4 g0 = *(const f32x4*)(g + 16 * s + 8 * mh), g1 = *(const f32x4*)(g + 16 * s + 8 * mh + 4);
        u32x4 o;
        o[0] = pack2(bflo(raw[s][0]) * rstd * g0[0], bfhi(raw[s][0]) * rstd * g0[1]);
        o[1] = pack2(bflo(raw[s][1]) * rstd * g0[2], bfhi(raw[s][1]) * rstd * g0[3]);
        o[2] = pack2(bflo(raw[s][2]) * rstd * g1[0], bfhi(raw[s][2]) * rstd * g1[1]);
        o[3] = pack2(bflo(raw[s][3]) * rstd * g1[2], bfhi(raw[s][3]) * rstd * g1[3]);
        Qf[s] = __builtin_bit_cast(bf16x8, o);
    }
}
template <int HD> struct KVRegs { u32x4 k[HD / 64]; u32x4 v[HD == 128 ? 2 : 4]; };
template <int HD>
DI void attn_fetch(KVRegs<HD>& R, const bf16_t* ksrc, size_t ldk, const bf16_t* vsrc, size_t ldv, int tid) {
    constexpr int EPT = HD / 8;
    const int key = tid >> 3, part = tid & 7;
    const bf16_t* src = ksrc + (size_t)key * ldk + part * EPT;
#pragma unroll
    for (int v = 0; v < EPT / 8; ++v) R.k[v] = *(const u32x4*)(src + v * 8);
    constexpr int TPR = 512 / HD, KPT = 64 / TPR;
    const int d = tid / TPR, vpart = tid % TPR;
    const bf16_t* vs = vsrc + (size_t)d * ldv + vpart * KPT;
#pragma unroll
    for (int v = 0; v < KPT / 8; ++v) R.v[v] = *(const u32x4*)(vs + v * 8);
}
template <int HD>
DI void attn_commit(const KVRegs<HD>& R, LAS unsigned char* lds, const float (&gkr)[HD / 8], int tid) {
    constexpr int EPT = HD / 8;
    const int key = tid >> 3, part = tid & 7;
    float ss = 0.f;
#pragma unroll
    for (int v = 0; v < EPT / 8; ++v)
#pragma unroll
        for (int i = 0; i < 4; ++i) { const float a = bflo(R.k[v][i]), bb = bfhi(R.k[v][i]); ss += a * a + bb * bb; }
    ss = reduce8(ss);
    const float rstd = rsqrtf(ss * (1.0f / HD) + 1e-6f);
#pragma unroll
    for (int v = 0; v < EPT / 8; ++v) {
        u32x4 o;
        o[0] = pack2(bflo(R.k[v][0]) * rstd * gkr[v * 8 + 0], bfhi(R.k[v][0]) * rstd * gkr[v * 8 + 1]);
        o[1] = pack2(bflo(R.k[v][1]) * rstd * gkr[v * 8 + 2], bfhi(R.k[v][1]) * rstd * gkr[v * 8 + 3]);
        o[2] = pack2(bflo(R.k[v][2]) * rstd * gkr[v * 8 + 4], bfhi(R.k[v][2]) * rstd * gkr[v * 8 + 5]);
        o[3] = pack2(bflo(R.k[v][3]) * rstd * gkr[v * 8 + 6], bfhi(R.k[v][3]) * rstd * gkr[v * 8 + 7]);
        *(LAS u32x4*)(lds + AttnCfg<HD>::K_OFF + key * AttnCfg<HD>::KSTR + (part * EPT + v * 8) * 2) = o;
    }
    constexpr int TPR = 512 / HD, KPT = 64 / TPR;
    const int d = tid / TPR, vpart = tid % TPR;
#pragma unroll
    for (int v = 0; v < KPT / 8; ++v) {
        LAS unsigned char* dp = lds + AttnCfg<HD>::V_OFF + d * AttnCfg<HD>::VSTR + (vpart * KPT + v * 8) * 2;
        *(LAS u32x2*)dp = (u32x2){R.v[v][0], R.v[v][1]};
        *(LAS u32x2*)(dp + 8) = (u32x2){R.v[v][2], R.v[v][3]};
    }
}
template <int HD, bool BIAS, bool QLDS>
DI void attn_chunk(const bf16x8 (&Qf)[HD / 16], const LAS unsigned char* qp, f32x16 (&O)[4], float& m_run, float& l_run, const LAS unsigned char* lds, int dbase, int mr, int mh, int qk_delta) {
#pragma unroll 1
    for (int kt = 0; kt < 2; ++kt) {
        f32x16 sc;
#pragma unroll
        for (int i = 0; i < 16; ++i) sc[i] = 0.f;
        const LAS unsigned char* kp = lds + AttnCfg<HD>::K_OFF + (kt * 32 + mr) * AttnCfg<HD>::KSTR + mh * 16;
        f32x16 sc2;
#pragma unroll
        for (int i = 0; i < 16; ++i) sc2[i] = 0.f;
#pragma unroll
        for (int s = 0; s < HD / 16; s += 2) {
            if ((s & 3) == 0) __builtin_amdgcn_sched_barrier(0);
            const bf16x8 a0 = *(const LAS bf16x8*)(kp + s * 32), a1 = *(const LAS bf16x8*)(kp + s * 32 + 32);
            const bf16x8 qb0 = QLDS ? *(const LAS bf16x8*)(qp + s * 32) : Qf[s], qb1 = QLDS ? *(const LAS bf16x8*)(qp + s * 32 + 32) : Qf[s + 1];
            sc = MFMA32(a0, qb0, sc); sc2 = MFMA32(a1, qb1, sc2);
        }
#pragma unroll
        for (int i = 0; i < 16; ++i) sc[i] += sc2[i];
        float mx = -1e30f;
        if (BIAS) {
            if (qk_delta >= 192) {
                const float cb = *(const LAS float*)(lds + AttnCfg<HD>::BIAS_OFF + 256 * 4);
#pragma unroll
                for (int i = 0; i < 16; ++i) sc[i] += cb;
            } else {
#pragma unroll
                for (int i = 0; i < 16; ++i) {
                    int dist = qk_delta + mr - (kt * 32 + crow(i, mh));
                    dist = dist < -128 ? -128 : (dist > 128 ? 128 : dist);
                    sc[i] += *(const LAS float*)(lds + AttnCfg<HD>::BIAS_OFF + (dist + 128) * 4);
                }
            }
        }
#pragma unroll
        for (int i = 0; i < 16; ++i) mx = fmaxf(mx, sc[i]);
        mx = fmaxf(mx, __shfl_xor(mx, 32));
        const float m_new = fmaxf(m_run, mx), alpha = __builtin_amdgcn_exp2f(m_run - m_new);
        float ls = 0.f;
#pragma unroll
        for (int i = 0; i < 16; ++i) { const float pv = __builtin_amdgcn_exp2f(sc[i] - m_new); sc[i] = pv; ls += pv; }
        l_run = l_run * alpha + ls;
        if (__builtin_amdgcn_ballot_w64(m_new > m_run) != 0ull) {
#pragma unroll
            for (int dt = 0; dt < 4; ++dt)
#pragma unroll
                for (int i = 0; i < 16; ++i) O[dt][i] *= alpha;
        }
        m_run = m_new;
#pragma unroll
        for (int s2 = 0; s2 < 2; ++s2) {
            u32x4 pk;
#pragma unroll
            for (int j = 0; j < 4; ++j) pk[j] = pack2(sc[8 * s2 + 2 * j], sc[8 * s2 + 2 * j + 1]);
            const bf16x8 pb = __builtin_bit_cast(bf16x8, pk);
#pragma unroll
            for (int dt = 0; dt < 4; ++dt) {
                const LAS unsigned char* vp = lds + AttnCfg<HD>::V_OFF + (dbase + dt * 32 + mr) * AttnCfg<HD>::VSTR + (kt * 32 + 16 * s2 + 4 * mh) * 2;
                const u32x2 lo = *(const LAS u32x2*)vp, hi = *(const LAS u32x2*)(vp + 16);
                const u32x4 va = {lo[0], lo[1], hi[0], hi[1]};
                O[dt] = MFMA32(__builtin_bit_cast(bf16x8, va), pb, O[dt]);
            }
        }
    }
}
DI void attn_store(const f32x16 (&O)[4], float l_run, const bf16_t* zrow, bf16_t* yrow, int mh) {
    const float lt = l_run + __shfl_xor(l_run, 32);
    const float inv = 1.0f / lt;
#pragma unroll
    for (int dt = 0; dt < 4; ++dt)
#pragma unroll
        for (int g = 0; g < 4; ++g) {
            const int d = dt * 32 + 8 * g + 4 * mh;
            const u32x2 zz = *(const u32x2*)(zrow + d);
            u32x2 o;
            o[0] = pack2(O[dt][4 * g] * inv * siluf_(bflo(zz[0])), O[dt][4 * g + 1] * inv * siluf_(bfhi(zz[0])));
            o[1] = pack2(O[dt][4 * g + 2] * inv * siluf_(bflo(zz[1])), O[dt][4 * g + 3] * inv * siluf_(bfhi(zz[1])));
            *(u32x2*)(yrow + d) = o;
        }
}

DI void attnA_item(const Params& p, unsigned char* smem, int item) {
    const int b = item >> 6, head = (item >> 3) & 7, cgp = item & 7;
    int tid = threadIdx.x; asm volatile("" : "+v"(tid));
    const int wid = tid >> 6, lane = tid & 63, mr = lane & 31, mh = lane >> 5;
    LAS unsigned char* lds = (LAS unsigned char*)smem;
    const bf16_t* PA = (const bf16_t*)(p.ws + OFF_PA);
    const bf16_t* VT = (const bf16_t*)(p.ws + OFF_VT);
    bf16_t* YA = (bf16_t*)((char*)p.out + OFF_YA);
    const int cw = cgp * 4 + (wid >> 1), qt = wid & 1;
    const size_t qrow = (size_t)b * SEQ + cw * 64 + qt * 32 + mr;
    if (tid < 257) *(LAS float*)(lds + AttnCfg<128>::BIAS_OFF + tid * 4) = p.in[I_RELB][head * 257 + tid] * 1.4426950408889634f;
    bf16x8 Qf[8];
    attn_load_q<128>(Qf, PA + qrow * 3072 + head * 128, p.in[I_AQG], 0.08838834764831845f * 1.4426950408889634f, mh);
    f32x16 O[4];
#pragma unroll
    for (int dt = 0; dt < 4; ++dt)
#pragma unroll
        for (int i = 0; i < 16; ++i) O[dt][i] = 0.f;
    float m_run = -1e30f, l_run = 0.f;
    const int kc0 = cgp * 4 - 8 < 0 ? 0 : cgp * 4 - 8, kc1 = cgp * 4 + 3;
    const bf16_t* kbase = PA + (size_t)b * SEQ * 3072 + 1024 + head * 128;
    const bf16_t* vbase = VT + (size_t)(head * 128) * T_TOK + (size_t)b * SEQ;
    float gkr[16];
    {
#pragma unroll
        for (int i = 0; i < 4; ++i) { const f32x4 g4 = *(const f32x4*)(p.in[I_AKG] + (tid & 7) * 16 + i * 4); gkr[4 * i] = g4[0]; gkr[4 * i + 1] = g4[1]; gkr[4 * i + 2] = g4[2]; gkr[4 * i + 3] = g4[3]; }
    }
    KVRegs<128> R;
    attn_fetch<128>(R, kbase + (size_t)kc0 * 64 * 3072, 3072, vbase + kc0 * 64, T_TOK, tid);
    for (int kc = kc0; kc <= kc1; ++kc) {
        __syncthreads();
        attn_commit<128>(R, lds, gkr, tid);
        __syncthreads();
        if (kc < kc1) attn_fetch<128>(R, kbase + (size_t)(kc + 1) * 64 * 3072, 3072, vbase + (kc + 1) * 64, T_TOK, tid);
        if (kc >= cw - 8 && kc <= cw)
            attn_chunk<128, true, false>(Qf, lds, O, m_run, l_run, lds, 0, mr, mh, (cw - kc) * 64 + qt * 32);
    }
    attn_store(O, l_run, PA + qrow * 3072 + 2048 + head * 128, YA + qrow * 1024 + head * 128, mh);
    __syncthreads();
    if (tid == 0) __hip_atomic_fetch_add((unsigned*)(p.ws + OFF_CTR + 64), 1u, __ATOMIC_RELAXED, __HIP_MEMORY_SCOPE_AGENT);
}
DI void attnC_item(const Params& p, unsigned char* smem, int item) {
    const int b = item >> 6, hc = (item >> 4) & 3, qg = item & 15;
    int tid = threadIdx.x; asm volatile("" : "+v"(tid));
    const int wid = tid >> 6, lane = tid & 63, mr = lane & 31, mh = lane >> 5;
    LAS unsigned char* lds = (LAS unsigned char*)smem;
    const bf16_t* PC = (const bf16_t*)(p.ws + OFF_PC);
    const bf16_t* MK = (const bf16_t*)(p.ws + OFF_MK);
    const bf16_t* MVT = (const bf16_t*)(p.ws + OFF_MVT);
    bf16_t* YC = (bf16_t*)((char*)p.out + OFF_YC);
    const int qt = wid >> 1, dh = wid & 1;
    const size_t qrow = (size_t)b * SEQ + qg * 128 + qt * 32 + mr;
    constexpr int Q_OFF = AttnCfg<256>::V_OFF + 256 * AttnCfg<256>::VSTR;
    __syncthreads();
    {
        bf16x8 Qf[16];
        attn_load_q<256>(Qf, PC + qrow * 2048 + hc * 256, p.in[I_CQG], 0.0625f * 1.4426950408889634f, mh);
        if (dh == 0) {
#pragma unroll
            for (int s = 0; s < 16; ++s) *(LAS bf16x8*)(lds + Q_OFF + (qt * 32 + mr) * 528 + s * 32 + mh * 16) = Qf[s];
        }
    }
    const LAS unsigned char* qp = lds + Q_OFF + (qt * 32 + mr) * 528 + mh * 16;
    bf16x8 Qd[16];
    f32x16 O[4];
#pragma unroll
    for (int dt = 0; dt < 4; ++dt)
#pragma unroll
        for (int i = 0; i < 16; ++i) O[dt][i] = 0.f;
    float m_run = -1e30f, l_run = 0.f;
    const bf16_t* kbase = MK + (size_t)b * NMEM * 1024 + hc * 256;
    const bf16_t* vbase = MVT + (size_t)(hc * 256) * 2048 + (size_t)b * NMEM;
    float gkr[32];
    {
#pragma unroll
        for (int i = 0; i < 8; ++i) { const f32x4 g4 = *(const f32x4*)(p.in[I_CKG] + (tid & 7) * 32 + i * 4); gkr[4 * i] = g4[0]; gkr[4 * i + 1] = g4[1]; gkr[4 * i + 2] = g4[2]; gkr[4 * i + 3] = g4[3]; }
    }
    KVRegs<256> R;
    attn_fetch<256>(R, kbase, 1024, vbase, 2048, tid);
    for (int kc = 0; kc < 4; ++kc) {
        __syncthreads();
        attn_commit<256>(R, lds, gkr, tid);
        __syncthreads();
        if (kc < 3) attn_fetch<256>(R, kbase + (size_t)(kc + 1) * 64 * 1024, 1024, vbase + (kc + 1) * 64, 2048, tid);
        attn_chunk<256, false, true>(Qd, qp, O, m_run, l_run, lds, dh * 128, mr, mh, 0);
    }
    attn_store(O, l_run, PC + qrow * 2048 + 1024 + hc * 256 + dh * 128, YC + qrow * 1024 + hc * 256 + dh * 128, mh);
    __syncthreads();
}
DI void phase2(const Params& p, unsigned char* smem) {
    const int c = blockIdx.x;
    if (c < 128) scan_item(p, smem, c);
    for (int it = c + p.G; it < 128 && c < 128; it += p.G) scan_item(p, smem, it);
    unsigned* ctr = (unsigned*)(p.ws + OFF_CTR);
    LAS int* sitem = (LAS int*)((LAS unsigned char*)smem + LDS_BYTES - 16);
    auto fetch = [&]() -> int {
        __syncthreads();
        if (threadIdx.x == 0) *sitem = (int)atomicAdd(ctr, 1u);
        __syncthreads();
        return *sitem;
    };
    int item = fetch();
    while (item < 512) { attnA_item(p, smem, item); item = fetch(); }
    while (item < 1024) { attnC_item(p, smem, item - 512); item = fetch(); }
    if (blockIdx.x >= 128 && p.G == 256) {
        if (threadIdx.x == 0) { while (__hip_atomic_load((unsigned*)(p.ws + OFF_CTR + 64), __ATOMIC_RELAXED, __HIP_MEMORY_SCOPE_AGENT) < 512u) __builtin_amdgcn_s_sleep(8); }
        __syncthreads();
        gemm_phase<5>((LAS unsigned char*)smem, p);
    }
}

__global__ void __launch_bounds__(NTHREADS) hybrid_fwd(Params p) {
    extern __shared__ __attribute__((aligned(16))) unsigned char smem[];
    cg::grid_group grid = cg::this_grid();
#ifndef PHMASK
#define PHMASK 31
#endif
    if (PHMASK & 1) phase0(p, smem);
    grid.sync();
    if (PHMASK & 2) { gemm_phase<1>((LAS unsigned char*)smem, p); gemm_phase<7>((LAS unsigned char*)smem, p); }
    grid.sync();
    if (PHMASK & 4) phase2(p, smem);
    grid.sync();
    if (PHMASK & 8) gemm_phase<3>((LAS unsigned char*)smem, p);
    grid.sync();
    if (PHMASK & 16) gemm_phase<4>((LAS unsigned char*)smem, p);
}

extern "C" void kernel_launch(void* const* d_in, const int* in_sizes, int n_in, void* d_out, int out_size, void* d_ws, size_t ws_size, hipStream_t stream) {
    static int grid_blocks = 0;
    if (grid_blocks == 0) {
        if (n_in != 27 || ws_size < WS_END || out_size != T_TOK * DM) { fprintf(stderr, "kernel_launch: unexpected shapes (n_in %d ws %zu out %d)\n", n_in, ws_size, out_size); grid_blocks = -1; return; }
        int dev = 0, cus = 0, per_cu = 0;
        hipGetDevice(&dev);
        hipDeviceGetAttribute(&cus, hipDeviceAttributeMultiprocessorCount, dev);
        if (hipFuncSetAttribute((const void*)hybrid_fwd, hipFuncAttributeMaxDynamicSharedMemorySize, LDS_BYTES) != hipSuccess) { fprintf(stderr, "kernel_launch: hipFuncSetAttribute failed\n"); grid_blocks = -1; return; }
        if (hipOccupancyMaxActiveBlocksPerMultiprocessor(&per_cu, (const void*)hybrid_fwd, NTHREADS, LDS_BYTES) != hipSuccess || per_cu < 1) { fprintf(stderr, "kernel_launch: occupancy query failed (%d)\n", per_cu); grid_blocks = -1; return; }
        grid_blocks = cus * 1;
        if (grid_blocks != 256) { fprintf(stderr, "kernel_launch: built for 256 CUs, found %d\n", cus); grid_blocks = -1; return; }
    }
    if (grid_blocks < 0) return;
    Params p{};
    for (int i = 0; i < 27; ++i) p.in[i] = (const float*)d_in[i];
    p.out = (float*)d_out; p.ws = (unsigned char*)d_ws; p.G = grid_blocks; p.pad = 0;
    void* args[] = {&p};
    hipError_t e = hipLaunchCooperativeKernel((const void*)hybrid_fwd, dim3(grid_blocks), dim3(NTHREADS), args, LDS_BYTES, stream);
    if (e != hipSuccess) fprintf(stderr, "cooperative launch failed: %s (grid %d)\n", hipGetErrorString(e), grid_blocks);
}
```

```cpp
#include <hip/hip_runtime.h>
#include <hip/hip_cooperative_groups.h>
#include <cstdio>
namespace cg = cooperative_groups;

#define DI __device__ __forceinline__
#define LAS __attribute__((address_space(3)))
typedef unsigned short bf16_t;
typedef short bf16x8 __attribute__((ext_vector_type(8)));
typedef float f32x2 __attribute__((ext_vector_type(2)));
typedef float f32x4 __attribute__((ext_vector_type(4)));
typedef float f32x16 __attribute__((ext_vector_type(16)));
typedef unsigned u32x2 __attribute__((ext_vector_type(2)));
typedef unsigned u32x4 __attribute__((ext_vector_type(4)));
typedef __bf16 bf16v2 __attribute__((ext_vector_type(2)));

constexpr int T_TOK = 16384, DM = 2048, SEQ = 2048, NB = 8, NMEM = 256;
constexpr int INC = 16512;
constexpr int NTHREADS = 512;
constexpr int LDS_BYTES = 139264;

constexpr size_t SZ_WT = (size_t)INC * DM * 2;
constexpr size_t OFF_WT = 0;
constexpr size_t OFF_WMEM = OFF_WT + SZ_WT;
constexpr size_t OFF_WUA = OFF_WMEM + (size_t)2048 * 2048 * 2;
constexpr size_t OFF_WUB = OFF_WUA + (size_t)2048 * 1024 * 2;
constexpr size_t OFF_WUC = OFF_WUB + (size_t)2048 * 1024 * 2;
constexpr size_t OFF_WO = OFF_WUC + (size_t)2048 * 1024 * 2;
constexpr size_t OFF_H = OFF_WO + (size_t)2048 * 2048 * 2;
constexpr size_t OFF_M = OFF_H + (size_t)T_TOK * 2048 * 2;
constexpr size_t OFF_PA = OFF_M + (size_t)2048 * 2048 * 2;
constexpr size_t OFF_PB = OFF_PA + (size_t)T_TOK * 3072 * 2;
constexpr size_t OFF_PL = OFF_PB + (size_t)T_TOK * 4096 * 2;
constexpr size_t OFF_PC = OFF_PL + (size_t)T_TOK * 256 * 2;
constexpr size_t OFF_VT = OFF_PC + (size_t)T_TOK * 2048 * 2;
constexpr size_t OFF_MK = OFF_VT + (size_t)1024 * T_TOK * 2;
constexpr size_t OFF_MVT = OFF_MK + (size_t)2048 * 1024 * 2;
constexpr size_t OFF_CTR = OFF_MVT + (size_t)1024 * 2048 * 2;
constexpr size_t OFF_BAR = OFF_CTR + 256;
constexpr size_t BAR_BYTES = 3456 * 4;
constexpr size_t WS_END = OFF_BAR + BAR_BYTES;
constexpr size_t OFF_MERGED = OFF_PB;
constexpr size_t OFF_SCR = OFF_PB + (size_t)T_TOK * 2048 * 2;
constexpr size_t OFF_G = OFF_PA;
constexpr size_t SCR_PER_WG = 2 * 131072;
constexpr size_t OFF_YA = 0, OFF_YB = (size_t)T_TOK * 1024 * 2, OFF_YC = 2 * OFF_YB;
constexpr size_t OFF_G2 = 3 * OFF_YB;

struct Params {
    const float* in[27];
    float* out;
    unsigned char* ws;
    int G; int pad;
};
enum { I_X = 0, I_MEM, I_NORMG, I_WIN, I_AQG, I_AKG, I_RELB, I_WUPA, I_MURKV, I_MUW, I_MUA, I_W0, I_W2, I_A0, I_A2, I_KK, I_KA, I_RK, I_LNW, I_LNB, I_WUPB,
       I_MEMG, I_WMEMKV, I_CQG, I_CKG, I_WUPC, I_WO };

DI unsigned pack2(float lo, float hi) { f32x2 v = {lo, hi}; bf16v2 b = __builtin_convertvector(v, bf16v2); return __builtin_bit_cast(unsigned, b); }
DI float bflo(unsigned u) { return __uint_as_float(u << 16); }
DI float bfhi(unsigned u) { return __uint_as_float(u & 0xffff0000u); }
DI float sigmoidf_(float x) { return __builtin_amdgcn_rcpf(1.0f + __expf(-x)); }
DI float siluf_(float x) { return x * sigmoidf_(x); }
DI float wave_sum(float v) {
#pragma unroll
    for (int o = 32; o > 0; o >>= 1) v += __shfl_xor(v, o);
    return v;
}
template <int CTRL> DI float dpp_mov(float x) { return __int_as_float(__builtin_amdgcn_update_dpp(0, __float_as_int(x), CTRL, 0xf, 0xf, false)); }
DI float reduce8(float x) {
    x += dpp_mov<0xB1>(x);
    x += dpp_mov<0x4E>(x);
    x += dpp_mov<0x141>(x);
    return x;
}
DI int crow(int i, int h) { return (i & 3) + 8 * (i >> 2) + 4 * h; }
#define MFMA32(a, b, c) __builtin_amdgcn_mfma_f32_32x32x16_bf16((a), (b), (c), 0, 0, 0)

struct TrTile { const float* src; bf16_t* dst; int R, C, tr, tc; };
DI void tr_load(const TrTile& t, f32x4& v0, f32x4& v1, int tid) {
    const int r = tid >> 3, cs = (tid & 7) * 8;
    const float* sp = t.src + (size_t)(t.tr * 64 + r) * t.C + t.tc * 64 + cs;
    v0 = __builtin_nontemporal_load((const f32x4*)sp); v1 = __builtin_nontemporal_load((const f32x4*)(sp + 4));
}
DI void tr_to_lds(const f32x4& v0, const f32x4& v1, float* lds, int tid) {
    const int r = tid >> 3, cs = (tid & 7) * 8;
    float* lp = lds + r * 65 + cs;
    lp[0] = v0[0]; lp[1] = v0[1]; lp[2] = v0[2]; lp[3] = v0[3]; lp[4] = v1[0]; lp[5] = v1[1]; lp[6] = v1[2]; lp[7] = v1[3];
}
DI void tr_store(const TrTile& t, const float* lds, int tid) {
    const int c = tid >> 3, ks = (tid & 7) * 8;
    u32x4 o;
    o[0] = pack2(lds[(ks + 0) * 65 + c], lds[(ks + 1) * 65 + c]);
    o[1] = pack2(lds[(ks + 2) * 65 + c], lds[(ks + 3) * 65 + c]);
    o[2] = pack2(lds[(ks + 4) * 65 + c], lds[(ks + 5) * 65 + c]);
    o[3] = pack2(lds[(ks + 6) * 65 + c], lds[(ks + 7) * 65 + c]);
    *(u32x4*)(t.dst + (size_t)(t.tc * 64 + c) * t.R + t.tr * 64 + ks) = o;
}
DI void rms_load(f32x4 (&v)[8], const float* __restrict__ x, int lane) {
#pragma unroll
    for (int i = 0; i < 8; ++i) v[i] = __builtin_nontemporal_load((const f32x4*)x + i * 64 + lane);
}
DI void rms_finish(const f32x4 (&v)[8], const float* __restrict__ g, bf16_t* __restrict__ out, int lane) {
    float ss = 0.f;
#pragma unroll
    for (int i = 0; i < 8; ++i) ss += v[i][0] * v[i][0] + v[i][1] * v[i][1] + v[i][2] * v[i][2] + v[i][3] * v[i][3];
    ss = wave_sum(ss);
    const float rstd = rsqrtf(ss * (1.0f / 2048.0f) + 1e-6f);
#pragma unroll
    for (int i = 0; i < 8; ++i) {
        const f32x4 g4 = ((const f32x4*)g)[i * 64 + lane];
        u32x2 o; o[0] = pack2(v[i][0] * rstd * g4[0], v[i][1] * rstd * g4[1]); o[1] = pack2(v[i][2] * rstd * g4[2], v[i][3] * rstd * g4[3]);
        ((u32x2*)out)[i * 64 + lane] = o;
    }
}
DI void phase0(const Params& p, unsigned char* smem) {
    float* lds = (float*)smem;
    const int G = p.G, c = blockIdx.x;
    if (c == 0 && threadIdx.x == 0) { *(unsigned*)(p.ws + OFF_CTR) = 0u; *(unsigned*)(p.ws + OFF_CTR + 64) = 0u; }
    constexpr int N_WIN = 32 * 258, N_SQ = 32 * 32, N_UP = 16 * 32;
    constexpr int NTR = N_WIN + N_SQ + 3 * N_UP + N_SQ;
    const int tid = threadIdx.x;
    auto tile_of = [&](int u, TrTile& t) {
        int l = u;
        if (l < N_WIN) { t = {p.in[I_WIN], (bf16_t*)(p.ws + OFF_WT), 2048, INC, l & 31, l >> 5}; return; }
        l -= N_WIN;
        if (l < N_SQ) { t = {p.in[I_WMEMKV], (bf16_t*)(p.ws + OFF_WMEM), 2048, 2048, l & 31, l >> 5}; return; }
        l -= N_SQ;
        if (l < 3 * N_UP) {
            const int w = l / N_UP; l -= w * N_UP;
            t = {w == 0 ? p.in[I_WUPA] : (w == 1 ? p.in[I_WUPB] : p.in[I_WUPC]), (bf16_t*)(p.ws + (w == 0 ? OFF_WUA : (w == 1 ? OFF_WUB : OFF_WUC))), 1024, 2048, l & 15, l >> 4}; return;
        }
        l -= 3 * N_UP;
        t = {p.in[I_WO], (bf16_t*)(p.ws + OFF_WO), 2048, 2048, l & 31, l >> 5};
    };
    {
        TrTile cur, nxt; f32x4 v0, v1;
        int u = c, par = 0;
        if (u < NTR) { tile_of(u, cur); tr_load(cur, v0, v1, tid); }
        for (; u < NTR; u += G) {
            float* buf = lds + par * (64 * 65);
            tr_to_lds(v0, v1, buf, tid);
            const bool more = u + G < NTR;
            if (more) { tile_of(u + G, nxt); tr_load(nxt, v0, v1, tid); }
            __syncthreads();
            tr_store(cur, buf, tid);
            cur = nxt; par ^= 1;
        }
    }
    {
        const int wid = tid >> 6, lane = tid & 63;
        auto row_ptrs = [&](int row, const float*& x, const float*& g, bf16_t*& o) {
            if (row < T_TOK) { x = p.in[I_X] + (size_t)row * 2048; g = p.in[I_NORMG]; o = (bf16_t*)(p.ws + OFF_H) + (size_t)row * 2048; }
            else { x = p.in[I_MEM] + (size_t)(row - T_TOK) * 2048; g = p.in[I_MEMG]; o = (bf16_t*)(p.ws + OFF_M) + (size_t)(row - T_TOK) * 2048; }
        };
        constexpr int NRG = (T_TOK + 2048) / 8;
        f32x4 va[8], vb[8];
        const float* x; const float* g; bf16_t* o;
        int rg = c;
        if (rg < NRG) { row_ptrs(rg * 8 + wid, x, g, o); rms_load(va, x, lane); }
        for (; rg < NRG; rg += 2 * G) {
            const float* x2; const float* g2; bf16_t* o2;
            const bool m1 = rg + G < NRG;
            if (m1) { row_ptrs((rg + G) * 8 + wid, x2, g2, o2); rms_load(vb, x2, lane); }
            rms_finish(va, g, o, lane);
            const bool m2 = rg + 2 * G < NRG;
            if (m2) { row_ptrs((rg + 2 * G) * 8 + wid, x, g, o); rms_load(va, x, lane); }
            if (m1) rms_finish(vb, g2, o2, lane);
        }
    }
    __syncthreads();
}

constexpr int BM = 256, BK = 64, HALF = 128, HTB = HALF * BK * 2;
DI int lds_byte(int r, int c) { const int st = (r >> 4) * 2 + (c >> 5), rr = r & 15, cc = c & 31, ob = rr * 64 + cc * 2; return st * 1024 + (ob ^ (((ob >> 9) & 1) << 5)); }
DI void stage_rc(int b, int& R, int& C) { const int st = b / 1024, sb = b % 1024, swz = sb ^ (((sb >> 9) & 1) << 5); R = (st >> 1) * 16 + swz / 64; C = (st & 1) * 32 + (swz % 64) / 2; }

enum { EPI_BF16 = 0, EPI_UP = 1, EPI_GATE = 2, EPI_SIG = 3, EPI_OUT = 4, EPI_UPG = 5 };
struct Unit { const char* A; const char* B; char* C; int K; int ldc; int kind; int aux; const float* X; const char* Gp; };

template <int PH>
DI void epilogue(const f32x4 (&acc)[2][2][4][2], const Unit& u, int wr, int wc, int fr, int fq, int tid, char* scr) {
    if (PH == 1) {
        const int odd = fr & 1;
        bf16_t* rowe = (bf16_t*)u.C + (size_t)(wr * 64 + (fr & ~1)) * u.ldc + wc * 64 + 16 * fq + odd * 8;
        const size_t step16 = (size_t)16 * u.ldc;
#pragma unroll
        for (int ai = 0; ai < 2; ++ai)
#pragma unroll
            for (int m = 0; m < 4; ++m) {
                asm volatile("" : "+v"(rowe) : : "memory");
                u32x4 o0, o1;
                { const f32x4 a0 = acc[ai][0][m][0], a1 = acc[ai][0][m][1]; o0[0] = pack2(a0[0], a0[1]); o0[1] = pack2(a0[2], a0[3]); o0[2] = pack2(a1[0], a1[1]); o0[3] = pack2(a1[2], a1[3]); }
                { const f32x4 a0 = acc[ai][1][m][0], a1 = acc[ai][1][m][1]; o1[0] = pack2(a0[0], a0[1]); o1[1] = pack2(a0[2], a0[3]); o1[2] = pack2(a1[0], a1[1]); o1[3] = pack2(a1[2], a1[3]); }
                u32x4 snd, rcv, d1, d2;
#pragma unroll
                for (int i = 0; i < 4; ++i) {
                    snd[i] = odd ? o0[i] : o1[i];
                    rcv[i] = (unsigned)__builtin_amdgcn_update_dpp(0, (int)snd[i], 0xB1, 0xf, 0xf, false);
                    d1[i] = odd ? rcv[i] : o0[i];
                    d2[i] = odd ? o1[i] : rcv[i];
                }
                *(u32x4*)rowe = d1;
                *(u32x4*)(rowe + u.ldc) = d2;
                rowe += (m == 3) ? 5 * step16 : step16;
            }
    } else if (PH == 4) {
        const size_t ro0 = (size_t)(wr * 64 + fr) * 2048 + wc * 64 + 16 * fq;
        const float* xp = u.X + ro0; float* op = (float*)u.C + ro0;
#pragma unroll
        for (int ai = 0; ai < 2; ++ai) {
#pragma unroll
            for (int mp = 0; mp < 2; ++mp) {
                asm volatile("" : "+v"(xp), "+v"(op) : : "memory");
                f32x4 xv[2][4];
#pragma unroll
                for (int mm = 0; mm < 2; ++mm)
#pragma unroll
                    for (int q = 0; q < 4; ++q) xv[mm][q] = *(const f32x4*)(xp + mm * 16 * 2048 + q * 4);
                asm volatile("" ::: "memory");
#pragma unroll
                for (int mm = 0; mm < 2; ++mm) {
                    const int m = mp * 2 + mm;
#pragma unroll
                    for (int bj = 0; bj < 2; ++bj)
#pragma unroll
                        for (int n = 0; n < 2; ++n) *(f32x4*)(op + mm * 16 * 2048 + bj * 8 + n * 4) = acc[ai][bj][m][n] + xv[mm][bj * 2 + n];
                }
                xp += 32 * 2048; op += 32 * 2048;
            }
            xp += 64 * 2048; op += 64 * 2048;
        }
    } else if (PH == 5 || PH == 7 || (PH == 3 && u.kind == EPI_UP)) {
        const bool sg = u.kind == EPI_SIG;
        u32x2* sp = (u32x2*)(sg ? u.C : scr) + tid;
#pragma unroll
        for (int ai = 0; ai < 2; ++ai)
#pragma unroll
            for (int m = 0; m < 4; ++m) {
                asm volatile("" : "+v"(sp) : : "memory");
#pragma unroll
                for (int bj = 0; bj < 2; ++bj)
#pragma unroll
                    for (int n = 0; n < 2; ++n) {
                        f32x4 a = acc[ai][bj][m][n];
                        if (sg) { a[0] = sigmoidf_(a[0]); a[1] = sigmoidf_(a[1]); a[2] = sigmoidf_(a[2]); a[3] = sigmoidf_(a[3]); }
                        u32x2 o; o[0] = pack2(a[0], a[1]); o[1] = pack2(a[2], a[3]);
                        sp[(bj * 2 + n) * 512] = o;
                    }
                sp += 4 * 512;
            }
    } else {
        u32x2* sp = (u32x2*)scr + tid;
        const bool isg = u.kind == EPI_GATE;
        const u32x2* gp = isg ? (const u32x2*)scr + tid : (const u32x2*)u.Gp + tid;
        const int mode = u.aux;
        u32x2 uu[2][4], mm[2][4];
        auto issue = [&](int slot) {
#pragma unroll
            for (int q = 0; q < 4; ++q) { uu[slot][q] = gp[q * 512]; mm[slot][q] = (u32x2){0u, 0u}; if (mode != 0) mm[slot][q] = sp[q * 512 + 16384]; }
        };
        issue(0);
#pragma unroll
        for (int ai = 0; ai < 2; ++ai)
#pragma unroll
            for (int m = 0; m < 4; ++m) {
                const int g = ai * 4 + m, cur = g & 1;
                u32x2* spc = sp;
                sp += 4 * 512; gp += 4 * 512;
                asm volatile("" : "+v"(sp), "+v"(gp) : : "memory");
                if (g < 7) issue(cur ^ 1);
                __builtin_amdgcn_sched_barrier(0);
                bf16_t* rowp = (bf16_t*)u.C + (size_t)(ai * 128 + wr * 64 + m * 16 + fr) * u.ldc + wc * 64 + 16 * fq;
#pragma unroll
                for (int bj = 0; bj < 2; ++bj)
#pragma unroll
                    for (int n = 0; n < 2; ++n) {
                        const int q = bj * 2 + n;
                        const u32x2 u2 = uu[cur][q], m2 = mm[cur][q];
                        f32x4 a = acc[ai][bj][m][n];
                        if (isg) { a[0] = sigmoidf_(a[0]); a[1] = sigmoidf_(a[1]); a[2] = sigmoidf_(a[2]); a[3] = sigmoidf_(a[3]); }
                        const float r0 = bflo(m2[0]) + a[0] * bflo(u2[0]);
                        const float r1 = bfhi(m2[0]) + a[1] * bfhi(u2[0]);
                        const float r2 = bflo(m2[1]) + a[2] * bflo(u2[1]);
                        const float r3 = bfhi(m2[1]) + a[3] * bfhi(u2[1]);
                        u32x2 o; o[0] = pack2(r0, r1); o[1] = pack2(r2, r3);
                        if (mode == 2) *(u32x2*)(rowp + bj * 8 + n * 4) = o; else spc[q * 512 + 16384] = o;
                    }
            }
    }
}

DI void tile_pmpn(int tl, int& pm, int& pn) { pm = (tl & 7) + 8 * (tl >> 6); pn = (tl >> 3) & 7; }
DI const char* gate_tile_ptr(const Params& p, int g) {
    const unsigned long long a0 = (unsigned long long)p.out + OFF_G2 + (unsigned long long)g * 131072ull, a1 = (unsigned long long)p.ws + OFF_G + (unsigned long long)(g - 128) * 131072ull;
    return (const char*)(g < 128 ? a0 : a1);
}
DI void gate_unit(const Params& p, int g, Unit& u) {
    const int lt = g >> 1, x = g & 1;
    int pm, pn; tile_pmpn(256 + lt, pm, pn);
    const char* ws = (const char*)p.ws;
    u.X = nullptr; u.ldc = 0; u.Gp = nullptr; u.aux = 0;
    u.K = 2048; u.kind = EPI_SIG;
    u.A = ws + OFF_H + (size_t)pm * 256 * 4096;
    u.B = ws + OFF_WT + (size_t)(10368 + 2048 * x + 256 * pn) * 4096;
    u.C = (char*)gate_tile_ptr(p, g);
}
DI bool p1_unit(const Params& p, int L, Unit& u) {
    if (L >= 2688) return false;

    u.K = 2048; u.kind = EPI_BF16; u.aux = 0; u.X = nullptr; u.Gp = nullptr;
    const char* ws = (const char*)p.ws;
    if (L < 2368) {
        const int gid = L / 296, rem = L - gid * 296, pm = gid * 8 + (rem & 7), ct = rem >> 3;
        int brow, col, ldc; size_t cb;
        if (ct < 8) { brow = ct * 256; cb = OFF_PA; col = ct * 256; ldc = 3072; }
        else if (ct < 12) { brow = 3072 + (ct - 8) * 256; cb = OFF_PA; col = 2048 + (ct - 8) * 256; ldc = 3072; }
        else if (ct < 28) { brow = 4096 + (ct - 12) * 256; cb = OFF_PB; col = (ct - 12) * 256; ldc = 4096; }
        else if (ct == 28) { brow = 8192; cb = OFF_PL; col = 0; ldc = 256; }
        else { brow = 8320 + (ct - 29) * 256; cb = OFF_PC; col = (ct - 29) * 256; ldc = 2048; }
        u.A = ws + OFF_H + (size_t)pm * 256 * 4096; u.B = ws + OFF_WT + (size_t)brow * 4096;
        u.C = (char*)p.ws + cb + ((size_t)pm * 256 * ldc + col) * 2; u.ldc = ldc;
    } else if (L < 2624) {
        const int l = L - 2368, pm = l & 3, pn = l >> 2;
        u.A = ws + OFF_WT + (size_t)(2048 + pm * 256) * 4096; u.B = ws + OFF_H + (size_t)pn * 256 * 4096;
        u.C = (char*)p.ws + OFF_VT + ((size_t)pm * 256 * T_TOK + pn * 256) * 2; u.ldc = T_TOK;
    } else if (L < 2656) {
        const int l = L - 2624, pm = l & 7, pn = l >> 3;
        u.A = ws + OFF_M + (size_t)pm * 256 * 4096; u.B = ws + OFF_WMEM + (size_t)pn * 256 * 4096;
        u.C = (char*)p.ws + OFF_MK + ((size_t)pm * 256 * 1024 + pn * 256) * 2; u.ldc = 1024;
    } else {
        const int l = L - 2656, pm = l & 3, pn = l >> 2;
        u.A = ws + OFF_WMEM + (size_t)(1024 + pm * 256) * 4096; u.B = ws + OFF_M + (size_t)pn * 256 * 4096;
        u.C = (char*)p.ws + OFF_MVT + ((size_t)pm * 256 * 2048 + pn * 256) * 2; u.ldc = 2048;
    }
    return true;
}
constexpr int PG_N = 2;
DI bool p3_unit(const Params& p, int cp, int ui, Unit& u) {
    if (ui >= 12 - PG_N) return false;
    const bool light = ui >= 6;
    int x, isgate; bool pre = false;
    if (!light) { x = ui >> 1; isgate = ui & 1; }
    else { const int li = ui - 6; if (li < PG_N) { x = li; isgate = 0; pre = true; } else { const int r = li - PG_N; x = PG_N + (r >> 1); isgate = r & 1; } }
    const int tl = light ? 256 + cp : cp;
    int pm, pn; tile_pmpn(tl, pm, pn);
    const char* ws = (const char*)p.ws; const char* yo = (const char*)p.out;
    u.X = nullptr; u.ldc = 2048; u.Gp = nullptr;
    u.C = (char*)p.ws + OFF_MERGED + ((size_t)pm * 256 * 2048 + pn * 256) * 2;
    if (!isgate) {
        u.K = 1024; u.kind = pre ? EPI_UPG : EPI_UP; u.aux = pre ? x : 0;
        u.A = yo + (size_t)x * OFF_YB + (size_t)pm * 256 * 2048;
        u.B = ws + (x == 0 ? OFF_WUA : (x == 1 ? OFF_WUB : OFF_WUC)) + (size_t)pn * 256 * 2048;
        if (pre) u.Gp = gate_tile_ptr(p, 2 * cp + x);
    } else {
        u.K = 2048; u.kind = EPI_GATE; u.aux = x;
        u.A = ws + OFF_H + (size_t)pm * 256 * 4096;
        u.B = ws + OFF_WT + (size_t)(10368 + 2048 * x + 256 * pn) * 4096;
    }
    return true;
}
DI bool pg_unit(const Params& p, int ui, Unit& u) {
    if (ui >= 3) return false;
    gate_unit(p, 128 + 3 * ((int)blockIdx.x - 128) + ui, u);
    return true;
}
DI bool p4_unit(const Params& p, int cp, int ui, Unit& u) {
    const int tl = cp + p.G * ui;
    if (tl >= 512) return false;
    int pm, pn; tile_pmpn(tl, pm, pn);
    const char* ws = (const char*)p.ws;
    u.K = 2048; u.kind = EPI_OUT; u.aux = 0; u.ldc = 2048; u.Gp = nullptr;
    u.A = ws + OFF_MERGED + (size_t)pm * 256 * 4096; u.B = ws + OFF_WO + (size_t)pn * 256 * 4096;
    u.C = (char*)(p.out + (size_t)pm * 256 * 2048 + pn * 256);
    u.X = p.in[I_X] + (size_t)pm * 256 * 2048 + pn * 256;
    return true;
}
template <int PH> DI bool get_unit(const Params& p, int cp, int ui, Unit& u) {
    if (PH == 1) return p1_unit(p, ui * p.G + cp, u);
    if (PH == 3) return p3_unit(p, cp, ui, u);
    if (PH == 5) return pg_unit(p, ui, u);
    if (PH == 7) { if (ui >= 1 || cp < 128) return false; gate_unit(p, cp - 128, u); return true; }
    return p4_unit(p, cp, ui, u);
}

template <int PH>
DI void gemm_phase(LAS unsigned char* lds, const Params& p) {
    int tid = threadIdx.x; asm volatile("" : "+v"(tid));
    const int wid = __builtin_amdgcn_readfirstlane(tid >> 6), lane = tid & 63, wr = wid >> 2, wc = wid & 3, fr = lane & 15, fq = lane >> 4;
    const int c = blockIdx.x, cp = (p.G & 7) == 0 ? (c & 7) * (p.G >> 3) + (c >> 3) : c;
    char* scr = (char*)p.ws + OFF_SCR + (size_t)c * SCR_PER_WG;
    int sR[2], sC[2];
#pragma unroll
    for (int i = 0; i < 2; ++i) stage_rc(tid * 16 + i * 8192, sR[i], sC[i]);
    int sRB[2][2];
#pragma unroll
    for (int bj = 0; bj < 2; ++bj)
#pragma unroll
        for (int i = 0; i < 2; ++i) { const int R = sR[i]; sRB[bj][i] = 64 * (R >> 5) + 16 * ((R >> 2) & 3) + 8 * bj + 4 * ((R >> 4) & 1) + (R & 3); }
    const unsigned ldsw = (unsigned)wid * 1024u;
    const int aoff = lds_byte(wr * 64 + fr, fq * 8), boff = lds_byte(wc * 32 + fr, fq * 8);
#define G_SA(b, h) (((b) * 2 + (h)) * HTB)
#define G_SB(b, h) ((4 + (b) * 2 + (h)) * HTB)
#define G_STAGE(bufoff, gbase, KK) do { _Pragma("unroll") for (int _i = 0; _i < 2; ++_i) \
        __builtin_amdgcn_global_load_lds((const unsigned*)((gbase) + (size_t)(unsigned)((sR[_i] * (KK) + sC[_i]) * 2)), (LAS unsigned*)(lds + (bufoff) + ldsw + _i * 8192), 16, 0, 0); } while (0)
#define G_STAGE_B(bufoff, gbase, KK, bj) do { _Pragma("unroll") for (int _i = 0; _i < 2; ++_i) \
        __builtin_amdgcn_global_load_lds((const unsigned*)((gbase) + (size_t)(unsigned)((sRB[bj][_i] * (KK) + sC[_i]) * 2)), (LAS unsigned*)(lds + (bufoff) + ldsw + _i * 8192), 16, 0, 0); } while (0)
#define G_LDA(dst, b, h) do { _Pragma("unroll") for (int m = 0; m < 4; ++m) _Pragma("unroll") for (int k = 0; k < 2; ++k) dst[m][k] = *(const LAS bf16x8*)(lds + G_SA(b, h) + aoff + m * 2048 + k * 1024); } while (0)
#define G_LDB(dst, b, h) do { _Pragma("unroll") for (int n = 0; n < 2; ++n) _Pragma("unroll") for (int k = 0; k < 2; ++k) dst[n][k] = *(const LAS bf16x8*)(lds + G_SB(b, h) + boff + n * 2048 + k * 1024); } while (0)
#define G_MMA(ai, bj, At, Bt) do { __builtin_amdgcn_s_setprio(1); _Pragma("unroll") for (int m = 0; m < 4; ++m) _Pragma("unroll") for (int n = 0; n < 2; ++n) _Pragma("unroll") for (int k = 0; k < 2; ++k) \
        acc[ai][bj][m][n] = __builtin_amdgcn_mfma_f32_16x16x32_bf16(Bt[n][k], At[m][k], acc[ai][bj][m][n], 0, 0, 0); __builtin_amdgcn_s_setprio(0); } while (0)
#define G_WAIT_V(n) asm volatile("s_waitcnt vmcnt(" #n ")" ::: "memory")
#define G_WAIT_L(n) asm volatile("s_waitcnt lgkmcnt(" #n ")" ::: "memory")
#define G_BAR __builtin_amdgcn_s_barrier()
#define G_SCHED __builtin_amdgcn_sched_barrier(0)
    Unit cur, nxt; int ui = 0;
    if (!get_unit<PH>(p, cp, 0, cur)) return;
    f32x4 acc[2][2][4][2];
#pragma unroll
    for (int a = 0; a < 2; ++a)
#pragma unroll
        for (int b = 0; b < 2; ++b)
#pragma unroll
            for (int m = 0; m < 4; ++m)
#pragma unroll
                for (int n = 0; n < 2; ++n) acc[a][b][m][n] = (f32x4){0.f, 0.f, 0.f, 0.f};
    bf16x8 At[4][2], B0[2][2], B1[2][2];
    const char* cA = cur.A; const char* cB = cur.B; int Kc = cur.K;
    {
        const size_t hs = (size_t)HALF * Kc * 2;
        G_STAGE_B(G_SB(0, 0), cB, Kc, 0); G_STAGE(G_SA(0, 0), cA, Kc); G_STAGE_B(G_SB(0, 1), cB, Kc, 1); G_STAGE(G_SA(0, 1), cA + hs, Kc);
        if (wr == 1) G_BAR;
        G_WAIT_V(4); G_BAR;
        G_STAGE_B(G_SB(1, 0), cB + 128, Kc, 0); G_STAGE(G_SA(1, 0), cA + 128, Kc); G_STAGE_B(G_SB(1, 1), cB + 128, Kc, 1);
        G_WAIT_V(6); G_BAR;
    }
    for (;;) {
        const bool has_next = get_unit<PH>(p, cp, ui + 1, nxt);
        const char* nA = has_next ? nxt.A : cA; const char* nB = has_next ? nxt.B : cB; const int Kn = has_next ? nxt.K : Kc;
        const int nt = Kc / BK;
        const size_t hsc = (size_t)HALF * Kc * 2;
        for (int t = 0; t < nt; t += 2) {
            const bool last = (t == nt - 2);
            const char* a1 = cA + (size_t)(t + 1) * 128;
            const int K2 = last ? Kn : Kc;
            const size_t hs2 = (size_t)HALF * K2 * 2;
            const char* a2 = last ? nA : cA + (size_t)(t + 2) * 128; const char* b2 = last ? nB : cB + (size_t)(t + 2) * 128;
            const char* a3 = a2 + 128; const char* b3 = b2 + 128;
            G_LDB(B0, 0, 0); G_SCHED; G_LDA(At, 0, 0); G_STAGE(G_SA(1, 1), a1 + hsc, Kc);
            G_WAIT_L(8); G_BAR; G_WAIT_L(0); G_MMA(0, 0, At, B0); G_BAR; G_SCHED;
            G_LDB(B1, 0, 1); G_STAGE_B(G_SB(0, 0), b2, K2, 0);
            G_BAR; G_WAIT_L(0); G_MMA(0, 1, At, B1); G_BAR;
            G_LDA(At, 0, 1); G_STAGE(G_SA(0, 0), a2, K2);
            G_BAR; G_WAIT_L(0); G_MMA(1, 0, At, B0); G_BAR; G_SCHED;
            G_STAGE_B(G_SB(0, 1), b2, K2, 1);
            G_WAIT_V(6); G_BAR; G_MMA(1, 1, At, B1); G_BAR;
            G_LDB(B0, 1, 0); G_SCHED; G_LDA(At, 1, 0); G_STAGE(G_SA(0, 1), a2 + hs2, K2);
            G_WAIT_L(8); G_BAR; G_WAIT_L(0); G_MMA(0, 0, At, B0); G_BAR; G_SCHED;
            G_LDB(B1, 1, 1); G_STAGE_B(G_SB(1, 0), b3, K2, 0);
            G_BAR; G_WAIT_L(0); G_MMA(0, 1, At, B1); G_BAR;
            G_LDA(At, 1, 1); G_STAGE(G_SA(1, 0), a3, K2);
            G_BAR; G_WAIT_L(0); G_MMA(1, 0, At, B0); G_BAR; G_SCHED;
            G_STAGE_B(G_SB(1, 1), b3, K2, 1);
            G_WAIT_V(6); G_BAR; G_MMA(1, 1, At, B1); G_BAR;
        }
        epilogue<PH>(acc, cur, wr, wc, fr, fq, tid, scr);
        if (!has_next) break;
#pragma unroll
        for (int a = 0; a < 2; ++a)
#pragma unroll
            for (int b = 0; b < 2; ++b)
#pragma unroll
                for (int m = 0; m < 4; ++m)
#pragma unroll
                    for (int n = 0; n < 2; ++n) acc[a][b][m][n] = (f32x4){0.f, 0.f, 0.f, 0.f};
        cur = nxt; cA = nA; cB = nB; Kc = Kn; ++ui;
    }
    G_WAIT_V(0);
    if (wr == 0) G_BAR;
    G_BAR;
}

constexpr int SB_W = 0, SB_KK = 8192, SB_BV = 16384, SB_KP = 24576, SB_R = 32768, SB_V = 40960, SB_O = 49152, SB_SIZE = 57344;
constexpr int SC_AWD = 114688, SC_AAD = 119296;
constexpr int SC_ASTR = 144;
DI void ld8(const bf16_t* ptr, float (&f)[8]) {
    const u32x4 v = *(const u32x4*)ptr;
#pragma unroll
    for (int i = 0; i < 4; ++i) { f[2 * i] = bflo(v[i]); f[2 * i + 1] = bfhi(v[i]); }
}
struct ScanOps { f32x4 w0, w1, a0, a1, b0, b1, k0, k1, r0, r1; f32x2 v; };
DI void scan_load(ScanOps& o, const LAS unsigned char* bp, const LAS unsigned char* vp) {
    o.w0 = *(const LAS f32x4*)(bp + SB_W); o.w1 = *(const LAS f32x4*)(bp + SB_W + 16);
    o.a0 = *(const LAS f32x4*)(bp + SB_KK); o.a1 = *(const LAS f32x4*)(bp + SB_KK + 16);
    o.b0 = *(const LAS f32x4*)(bp + SB_BV); o.b1 = *(const LAS f32x4*)(bp + SB_BV + 16);
    o.k0 = *(const LAS f32x4*)(bp + SB_KP); o.k1 = *(const LAS f32x4*)(bp + SB_KP + 16);
    o.r0 = *(const LAS f32x4*)(bp + SB_R); o.r1 = *(const LAS f32x4*)(bp + SB_R + 16);
    o.v = *(const LAS f32x2*)vp;
}
DI f32x2 lo2(f32x4 x) { return (f32x2){x[0], x[1]}; }
DI f32x2 hi2(f32x4 x) { return (f32x2){x[2], x[3]}; }
DI f32x2 splat2(float x) { return (f32x2){x, x}; }
DI void reduce8x2(float& a, float& b) {
    float ra, rb;
    asm volatile("s_nop 1\n\t"
                 "v_add_f32_dpp %0, %2, %2 quad_perm:[1,0,3,2] row_mask:0xf bank_mask:0xf bound_ctrl:1\n\t"
                 "v_add_f32_dpp %1, %3, %3 quad_perm:[1,0,3,2] row_mask:0xf bank_mask:0xf bound_ctrl:1\n\t"
                 "s_nop 0\n\t"
                 "v_add_f32_dpp %0, %0, %0 quad_perm:[2,3,0,1] row_mask:0xf bank_mask:0xf bound_ctrl:1\n\t"
                 "v_add_f32_dpp %1, %1, %1 quad_perm:[2,3,0,1] row_mask:0xf bank_mask:0xf bound_ctrl:1\n\t"
                 "s_nop 0\n\t"
                 "v_add_f32_dpp %0, %0, %0 row_half_mirror row_mask:0xf bank_mask:0xf bound_ctrl:1\n\t"
                 "v_add_f32_dpp %1, %1, %1 row_half_mirror row_mask:0xf bank_mask:0xf bound_ctrl:1\n\t"
                 "s_nop 1"
                 : "=&v"(ra), "=&v"(rb) : "v"(a), "v"(b));
    a = ra; b = rb;
}
DI void scan_step(f32x2 (&S0)[4], f32x2 (&S1)[4], const ScanOps& o, LAS unsigned char* op, bool wr) {
    const f32x2 kk[4] = {lo2(o.a0), hi2(o.a0), lo2(o.a1), hi2(o.a1)};
    f32x2 p0 = S0[0] * kk[0], p1 = S1[0] * kk[0];
#pragma unroll
    for (int q = 1; q < 4; ++q) { p0 = __builtin_elementwise_fma(S0[q], kk[q], p0); p1 = __builtin_elementwise_fma(S1[q], kk[q], p1); }
    float sa0 = p0[0] + p0[1], sa1 = p1[0] + p1[1];
    reduce8x2(sa0, sa1);
    const f32x2 ww[4] = {lo2(o.w0), hi2(o.w0), lo2(o.w1), hi2(o.w1)};
    const f32x2 bb[4] = {lo2(o.b0), hi2(o.b0), lo2(o.b1), hi2(o.b1)};
    const f32x2 kv[4] = {lo2(o.k0), hi2(o.k0), lo2(o.k1), hi2(o.k1)};
    const f32x2 rr[4] = {lo2(o.r0), hi2(o.r0), lo2(o.r1), hi2(o.r1)};
    const f32x2 v0 = splat2(o.v[0]), v1 = splat2(o.v[1]), s0 = splat2(-sa0), s1 = splat2(-sa1);
#pragma unroll
    for (int q = 0; q < 4; ++q) {
        const f32x2 t0 = __builtin_elementwise_fma(bb[q], s0, kv[q] * v0), t1 = __builtin_elementwise_fma(bb[q], s1, kv[q] * v1);
        S0[q] = __builtin_elementwise_fma(S0[q], ww[q], t0); S1[q] = __builtin_elementwise_fma(S1[q], ww[q], t1);
    }
    f32x2 q0 = S0[0] * rr[0], q1 = S1[0] * rr[0];
#pragma unroll
    for (int q = 1; q < 4; ++q) { q0 = __builtin_elementwise_fma(S0[q], rr[q], q0); q1 = __builtin_elementwise_fma(S1[q], rr[q], q1); }
    float o0 = q0[0] + q0[1], o1 = q1[0] + q1[1];
    reduce8x2(o0, o1);
    (void)wr;
    *(LAS f32x2*)op = (f32x2){o0, o1};
}
DI void scan_item(const Params& p, unsigned char* smem, int item) {
    const int b = item >> 4, h = item & 15;
    int tid = threadIdx.x; asm volatile("" : "+v"(tid));
    const int wid = __builtin_amdgcn_readfirstlane(tid >> 6), lane = tid & 63;
    const bf16_t* PB = (const bf16_t*)(p.ws + OFF_PB);
    const bf16_t* PL = (const bf16_t*)(p.ws + OFF_PL);
    bf16_t* YB = (bf16_t*)((char*)p.out + OFF_YB);
    LAS unsigned char* lds = (LAS unsigned char*)smem;
    const bool helper = wid >= 4;
    const int hw = wid & 3, mat = hw >> 1, tn = hw & 1, mr = lane & 31, mh = lane >> 5;
    bf16x8 Bf[4];
    float w0c = 0.f, a0c = 0.f, kac = 0.f;
    if (helper) {
        const float* Wx = (mat == 0 ? p.in[I_W2] : p.in[I_A2]) + h * 64 + tn * 32 + mr;
#pragma unroll
        for (int s = 0; s < 4; ++s) {
            u32x4 pk;
#pragma unroll
            for (int jj = 0; jj < 4; ++jj) pk[jj] = pack2(Wx[(size_t)(16 * s + 8 * mh + 2 * jj) * 1024], Wx[(size_t)(16 * s + 8 * mh + 2 * jj + 1) * 1024]);
            Bf[s] = __builtin_bit_cast(bf16x8, pk);
        }
        const int cj = h * 64 + tn * 32 + mr;
        w0c = p.in[I_W0][cj]; a0c = p.in[I_A0][cj]; kac = p.in[I_KA][cj];
    }
    const int ht = tid & 255, et = ht >> 3, eg = ht & 7, ec = h * 64 + eg * 8;
    float muw[8], mua[8], mur[8], muk[8], muv[8], kkc[8], rkc[8], lnw[8], lnb[8];
    {
        auto ldc = [&](const float* src, float (&d)[8]) { const f32x4 a = *(const f32x4*)src, bq = *(const f32x4*)(src + 4); d[0] = a[0]; d[1] = a[1]; d[2] = a[2]; d[3] = a[3]; d[4] = bq[0]; d[5] = bq[1]; d[6] = bq[2]; d[7] = bq[3]; };
        ldc(p.in[I_MUW] + eg * 8, muw); ldc(p.in[I_MUA] + eg * 8, mua);
        ldc(p.in[I_MURKV] + ec, mur); ldc(p.in[I_MURKV] + 1024 + ec, muk); ldc(p.in[I_MURKV] + 2048 + ec, muv);
        ldc(p.in[I_KK] + ec, kkc); ldc(p.in[I_RK] + ec, rkc); ldc(p.in[I_LNW] + ec, lnw); ldc(p.in[I_LNB] + ec, lnb);
    }
    u32x4 L[10]; u32x4 Z;
#pragma unroll
    for (int i = 0; i < 10; ++i) L[i] = (u32x4){0u, 0u, 0u, 0u};
    Z = (u32x4){0u, 0u, 0u, 0u};
    auto loadA = [&](int ch) {
        const size_t row = (size_t)b * SEQ + ch * 32 + et;
        const size_t prow = (ch * 32 + et) > 0 ? row - 1 : row;
        L[0] = *(const u32x4*)(PL + row * 256 + eg * 8); L[1] = *(const u32x4*)(PL + prow * 256 + eg * 8);
        L[2] = *(const u32x4*)(PL + row * 256 + 64 + eg * 8); L[3] = *(const u32x4*)(PL + prow * 256 + 64 + eg * 8);
#pragma unroll
        for (int q = 0; q < 3; ++q) { L[4 + 2 * q] = *(const u32x4*)(PB + row * 4096 + q * 1024 + ec); L[5 + 2 * q] = *(const u32x4*)(PB + prow * 4096 + q * 1024 + ec); }
    };
    auto loadZ = [&](int ch) { Z = *(const u32x4*)(PB + ((size_t)b * SEQ + ch * 32 + et) * 4096 + 3072 + ec); };
    auto unp = [&](const u32x4& v, float (&f)[8]) {
#pragma unroll
        for (int i = 0; i < 4; ++i) { f[2 * i] = bflo(v[i]); f[2 * i + 1] = bfhi(v[i]); } };
    auto stepA = [&](int ch, int buf) {
        const float pm = (ch * 32 + et) > 0 ? 1.0f : 0.0f;
        LAS unsigned char* bb = lds + buf * SB_SIZE;
        float cur[8], prv[8], x[8];
        unp(L[0], cur); unp(L[1], prv);
        u32x4 o;
#pragma unroll
        for (int i = 0; i < 8; ++i) { const float xx = cur[i] + muw[i] * (prv[i] * pm - cur[i]); x[i] = 1.0f - 2.0f * __builtin_amdgcn_rcpf(1.0f + __expf(2.0f * xx)); }
        o[0] = pack2(x[0], x[1]); o[1] = pack2(x[2], x[3]); o[2] = pack2(x[4], x[5]); o[3] = pack2(x[6], x[7]);
        *(LAS u32x4*)(lds + SC_AWD + et * SC_ASTR + eg * 16) = o;
        unp(L[2], cur); unp(L[3], prv);
#pragma unroll
        for (int i = 0; i < 8; ++i) x[i] = cur[i] + mua[i] * (prv[i] * pm - cur[i]);
        o[0] = pack2(x[0], x[1]); o[1] = pack2(x[2], x[3]); o[2] = pack2(x[4], x[5]); o[3] = pack2(x[6], x[7]);
        *(LAS u32x4*)(lds + SC_AAD + et * SC_ASTR + eg * 16) = o;
#pragma unroll
        for (int q = 0; q < 3; ++q) {
            unp(L[4 + 2 * q], cur); unp(L[5 + 2 * q], prv);
#pragma unroll
            for (int i = 0; i < 8; ++i) { const float m = q == 0 ? mur[i] : (q == 1 ? muk[i] : muv[i]); x[i] = cur[i] + m * (prv[i] * pm - cur[i]); }
            const int dsto = (q == 0 ? SB_R : (q == 1 ? SB_KP : SB_V)) + et * 256 + eg * 32;
            *(LAS f32x4*)(bb + dsto) = (f32x4){x[0], x[1], x[2], x[3]};
            *(LAS f32x4*)(bb + dsto + 16) = (f32x4){x[4], x[5], x[6], x[7]};
            if (q == 1) {
                float kk[8]; float ss = 0.f;
#pragma unroll
                for (int i = 0; i < 8; ++i) { kk[i] = x[i] * kkc[i]; ss += kk[i] * kk[i]; }
                ss = reduce8(ss);
                const float rn = rsqrtf(fmaxf(ss, 1e-24f));
                *(LAS f32x4*)(bb + SB_KK + et * 256 + eg * 32) = (f32x4){kk[0] * rn, kk[1] * rn, kk[2] * rn, kk[3] * rn};
                *(LAS f32x4*)(bb + SB_KK + et * 256 + eg * 32 + 16) = (f32x4){kk[4] * rn, kk[5] * rn, kk[6] * rn, kk[7] * rn};
            }
        }
    };
    auto stepB = [&](int buf) {
        LAS unsigned char* bb = lds + buf * SB_SIZE;
        f32x16 acc;
#pragma unroll
        for (int i = 0; i < 16; ++i) acc[i] = 0.f;
        const int abase = (mat == 0 ? SC_AWD : SC_AAD) + mr * SC_ASTR + mh * 16;
#pragma unroll
        for (int s = 0; s < 4; ++s) { const bf16x8 a = *(const LAS bf16x8*)(lds + abase + s * 32); acc = MFMA32(a, Bf[s], acc); }
        const int jcol = tn * 32 + mr;
#pragma unroll
        for (int i = 0; i < 16; ++i) {
            const int t = crow(i, mh);
            if (mat == 0) {
                const float y = -(w0c + acc[i]);
                const float sp = fmaxf(y, 0.f) + __logf(1.0f + __expf(-fabsf(y)));
                const float w = -sp - 0.5f;
                *(LAS float*)(bb + SB_W + t * 256 + jcol * 4) = __expf(-__expf(w));
            } else {
                const float a = sigmoidf_(a0c + acc[i]);
                const float kl = *(LAS float*)(bb + SB_KP + t * 256 + jcol * 4);
                const float kk = *(LAS float*)(bb + SB_KK + t * 256 + jcol * 4);
                *(LAS float*)(bb + SB_KP + t * 256 + jcol * 4) = kl * (1.0f + (a - 1.0f) * kac);
                *(LAS float*)(bb + SB_BV + t * 256 + jcol * 4) = kk * a;
            }
        }
    };
    auto epi = [&](int ch, int buf) {
        const size_t row = (size_t)b * SEQ + ch * 32 + et;
        LAS unsigned char* bb = lds + buf * SB_SIZE;
        const f32x4 o0 = *(const LAS f32x4*)(bb + SB_O + et * 256 + eg * 32), o1 = *(const LAS f32x4*)(bb + SB_O + et * 256 + eg * 32 + 16);
        float o[8] = {o0[0], o0[1], o0[2], o0[3], o1[0], o1[1], o1[2], o1[3]};
        float sm = 0.f;
#pragma unroll
        for (int i = 0; i < 8; ++i) sm += o[i];
        const float mean = reduce8(sm) * (1.0f / 64.0f);
        float sv = 0.f;
#pragma unroll
        for (int i = 0; i < 8; ++i) { const float d = o[i] - mean; sv += d * d; }
        const float rstd = rsqrtf(reduce8(sv) * (1.0f / 64.0f) + 64e-5f);
        const f32x4 r0 = *(const LAS f32x4*)(bb + SB_R + et * 256 + eg * 32), r1 = *(const LAS f32x4*)(bb + SB_R + et * 256 + eg * 32 + 16);
        const f32x4 k0 = *(const LAS f32x4*)(bb + SB_KP + et * 256 + eg * 32), k1 = *(const LAS f32x4*)(bb + SB_KP + et * 256 + eg * 32 + 16);
        float bs = r0[0] * k0[0] * rkc[0] + r0[1] * k0[1] * rkc[1] + r0[2] * k0[2] * rkc[2] + r0[3] * k0[3] * rkc[3]
                 + r1[0] * k1[0] * rkc[4] + r1[1] * k1[1] * rkc[5] + r1[2] * k1[2] * rkc[6] + r1[3] * k1[3] * rkc[7];
        bs = reduce8(bs);
        const f32x4 v0 = *(const LAS f32x4*)(bb + SB_V + et * 256 + eg * 32), v1 = *(const LAS f32x4*)(bb + SB_V + et * 256 + eg * 32 + 16);
        float z[8]; unp(Z, z);
        float y[8];
#pragma unroll
        for (int i = 0; i < 8; ++i) {
            const float vv = i < 4 ? v0[i] : v1[i - 4];
            y[i] = ((o[i] - mean) * rstd * lnw[i] + lnb[i] + bs * vv) * siluf_(z[i]);
        }
        u32x4 ov; ov[0] = pack2(y[0], y[1]); ov[1] = pack2(y[2], y[3]); ov[2] = pack2(y[4], y[5]); ov[3] = pack2(y[6], y[7]);
        *(u32x4*)(YB + row * 1024 + ec) = ov;
    };

    if (helper) {
        loadA(0); stepA(0, 0); loadA(1);
        __syncthreads();
        stepB(0);
        __syncthreads();
#pragma unroll 1
        for (int ch = 0; ch < SEQ / 32; ++ch) {
            const int buf = ch & 1;
            if (ch > 0) epi(ch - 1, buf ^ 1);
            if (ch + 1 < SEQ / 32) stepA(ch + 1, buf ^ 1);
            if (ch + 2 < SEQ / 32) loadA(ch + 2);
            __syncthreads();
            if (ch + 1 < SEQ / 32) stepB(buf ^ 1);
            loadZ(ch);
            __syncthreads();
        }
        epi(SEQ / 32 - 1, 1);
        __syncthreads();
    } else {
        const int il = lane >> 3, jl = lane & 7, row0 = (wid & 3) * 16 + il * 2;
        f32x2 S0[4], S1[4];
#pragma unroll
        for (int q = 0; q < 4; ++q) { S0[q] = (f32x2){0.f, 0.f}; S1[q] = (f32x2){0.f, 0.f}; }
        __syncthreads();
        __syncthreads();
#pragma unroll 1
        for (int ch = 0; ch < SEQ / 32; ++ch) {
            const int buf = ch & 1;
            const LAS unsigned char* bp = lds + buf * SB_SIZE + jl * 32;
            const LAS unsigned char* vp = lds + buf * SB_SIZE + SB_V + row0 * 4;
            LAS unsigned char* op = lds + buf * SB_SIZE + SB_O + row0 * 4;
#pragma unroll 1
            for (int half = 0; half < 2; ++half) {
                ScanOps oa, ob;
                scan_load(oa, bp + half * 16 * 256, vp + half * 16 * 256);
#pragma unroll 1
                for (int t = half * 16; t < half * 16 + 16; t += 2) {
                    scan_load(ob, bp + (t + 1) * 256, vp + (t + 1) * 256);
                    scan_step(S0, S1, oa, op + t * 256, jl == 0);
                    scan_load(oa, bp + (t + 2) * 256, vp + (t + 2) * 256);
                    scan_step(S0, S1, ob, op + (t + 1) * 256, jl == 0);
                }
                __syncthreads();
            }
        }
        __syncthreads();
    }
}

template <int HD> struct AttnCfg { static constexpr int KSTR = HD * 2 + 16, VSTR = 136, VROWS = HD, K_OFF = 0, V_OFF = 64 * KSTR, BIAS_OFF = V_OFF + VROWS * VSTR; };

template <int HD>
DI void attn_load_q(bf16x8 (&Qf)[HD / 16], const bf16_t* qrow, const float* g, float scale, int mh) {
    u32x4 raw[HD / 16]; float ss = 0.f;
#pragma unroll
    for (int s = 0; s < HD / 16; ++s) {
        raw[s] = *(const u32x4*)(qrow + 16 * s + 8 * mh);
#pragma unroll
        for (int i = 0; i < 4; ++i) { const float a = bflo(raw[s][i]), bb = bfhi(raw[s][i]); ss += a * a + bb * bb; }
    }
    ss += __shfl_xor(ss, 32);
    const float rstd = rsqrtf(ss * (1.0f / HD) + 1e-6f) * scale;
#pragma unroll
    for (int s = 0; s < HD / 16; ++s) {
        const f32x4 g0 = *(const f32x4*)(g + 16 * s + 8 * mh), g1 = *(const f32x4*)(g + 16 * s + 8 * mh + 4);
        u32x4 o;
        o[0] = pack2(bflo(raw[s][0]) * rstd * g0[0], bfhi(raw[s][0]) * rstd * g0[1]);
        o[1] = pack2(bflo(raw[s][1]) * rstd * g0[2], bfhi(raw[s][1]) * rstd * g0[3]);
        o[2] = pack2(bflo(raw[s][2]) * rstd * g1[0], bfhi(raw[s][2]) * rstd * g1[1]);
        o[3] = pack2(bflo(raw[s][3]) * rstd * g1[2], bfhi(raw[s][3]) * rstd * g1[3]);
        Qf[s] = __builtin_bit_cast(bf16x8, o);
    }
}
template <int HD> struct KVRegs { u32x4 k[HD / 64]; u32x4 v[HD == 128 ? 2 : 4]; };
template <int HD>
DI void attn_fetch(KVRegs<HD>& R, const bf16_t* ksrc, size_t ldk, const bf16_t* vsrc, size_t ldv, int tid) {
    constexpr int EPT = HD / 8;
    const int key = tid >> 3, part = tid & 7;
    const bf16_t* src = ksrc + (size_t)key * ldk + part * EPT;
#pragma unroll
    for (int v = 0; v < EPT / 8; ++v) R.k[v] = *(const u32x4*)(src + v * 8);
    constexpr int TPR = 512 / HD, KPT = 64 / TPR;
    const int d = tid / TPR, vpart = tid % TPR;
    const bf16_t* vs = vsrc + (size_t)d * ldv + vpart * KPT;
#pragma unroll
    for (int v = 0; v < KPT / 8; ++v) R.v[v] = *(const u32x4*)(vs + v * 8);
}
template <int HD>
DI void attn_commit(const KVRegs<HD>& R, LAS unsigned char* lds, const float (&gkr)[HD / 8], int tid) {
    constexpr int EPT = HD / 8;
    const int key = tid >> 3, part = tid & 7;
    float ss = 0.f;
#pragma unroll
    for (int v = 0; v < EPT / 8; ++v)
#pragma unroll
        for (int i = 0; i < 4; ++i) { const float a = bflo(R.k[v][i]), bb = bfhi(R.k[v][i]); ss += a * a + bb * bb; }
    ss = reduce8(ss);
    const float rstd = rsqrtf(ss * (1.0f / HD) + 1e-6f);
#pragma unroll
    for (int v = 0; v < EPT / 8; ++v) {
        u32x4 o;
        o[0] = pack2(bflo(R.k[v][0]) * rstd * gkr[v * 8 + 0], bfhi(R.k[v][0]) * rstd * gkr[v * 8 + 1]);
        o[1] = pack2(bflo(R.k[v][1]) * rstd * gkr[v * 8 + 2], bfhi(R.k[v][1]) * rstd * gkr[v * 8 + 3]);
        o[2] = pack2(bflo(R.k[v][2]) * rstd * gkr[v * 8 + 4], bfhi(R.k[v][2]) * rstd * gkr[v * 8 + 5]);
        o[3] = pack2(bflo(R.k[v][3]) * rstd * gkr[v * 8 + 6], bfhi(R.k[v][3]) * rstd * gkr[v * 8 + 7]);
        *(LAS u32x4*)(lds + AttnCfg<HD>::K_OFF + key * AttnCfg<HD>::KSTR + (part * EPT + v * 8) * 2) = o;
    }
    constexpr int TPR = 512 / HD, KPT = 64 / TPR;
    const int d = tid / TPR, vpart = tid % TPR;
#pragma unroll
    for (int v = 0; v < KPT / 8; ++v) {
        LAS unsigned char* dp = lds + AttnCfg<HD>::V_OFF + d * AttnCfg<HD>::VSTR + (vpart * KPT + v * 8) * 2;
        *(LAS u32x2*)dp = (u32x2){R.v[v][0], R.v[v][1]};
        *(LAS u32x2*)(dp + 8) = (u32x2){R.v[v][2], R.v[v][3]};
    }
}
template <int HD, bool BIAS, bool QLDS>
DI void attn_chunk(const bf16x8 (&Qf)[HD / 16], const LAS unsigned char* qp, f32x16 (&O)[4], float& m_run, float& l_run, const LAS unsigned char* lds, int dbase, int mr, int mh, int qk_delta) {
#pragma unroll 1
    for (int kt = 0; kt < 2; ++kt) {
        f32x16 sc;
#pragma unroll
        for (int i = 0; i < 16; ++i) sc[i] = 0.f;
        const LAS unsigned char* kp = lds + AttnCfg<HD>::K_OFF + (kt * 32 + mr) * AttnCfg<HD>::KSTR + mh * 16;
        f32x16 sc2;
#pragma unroll
        for (int i = 0; i < 16; ++i) sc2[i] = 0.f;
#pragma unroll
        for (int s = 0; s < HD / 16; s += 2) {
            if ((s & 3) == 0) __builtin_amdgcn_sched_barrier(0);
            const bf16x8 a0 = *(const LAS bf16x8*)(kp + s * 32), a1 = *(const LAS bf16x8*)(kp + s * 32 + 32);
            const bf16x8 qb0 = QLDS ? *(const LAS bf16x8*)(qp + s * 32) : Qf[s], qb1 = QLDS ? *(const LAS bf16x8*)(qp + s * 32 + 32) : Qf[s + 1];
            sc = MFMA32(a0, qb0, sc); sc2 = MFMA32(a1, qb1, sc2);
        }
#pragma unroll
        for (int i = 0; i < 16; ++i) sc[i] += sc2[i];
        float mx = -1e30f;
        if (BIAS) {
            if (qk_delta >= 192) {
                const float cb = *(const LAS float*)(lds + AttnCfg<HD>::BIAS_OFF + 256 * 4);
#pragma unroll
                for (int i = 0; i < 16; ++i) sc[i] += cb;
            } else {
#pragma unroll
                for (int i = 0; i < 16; ++i) {
                    int dist = qk_delta + mr - (kt * 32 + crow(i, mh));
                    dist = dist < -128 ? -128 : (dist > 128 ? 128 : dist);
                    sc[i] += *(const LAS float*)(lds + AttnCfg<HD>::BIAS_OFF + (dist + 128) * 4);
                }
            }
        }
#pragma unroll
        for (int i = 0; i < 16; ++i) mx = fmaxf(mx, sc[i]);
        mx = fmaxf(mx, __shfl_xor(mx, 32));
        const float m_new = fmaxf(m_run, mx), alpha = __builtin_amdgcn_exp2f(m_run - m_new);
        float ls = 0.f;
#pragma unroll
        for (int i = 0; i < 16; ++i) { const float pv = __builtin_amdgcn_exp2f(sc[i] - m_new); sc[i] = pv; ls += pv; }
        l_run = l_run * alpha + ls;
        if (__builtin_amdgcn_ballot_w64(m_new > m_run) != 0ull) {
#pragma unroll
            for (int dt = 0; dt < 4; ++dt)
#pragma unroll
                for (int i = 0; i < 16; ++i) O[dt][i] *= alpha;
        }
        m_run = m_new;
#pragma unroll
        for (int s2 = 0; s2 < 2; ++s2) {
            u32x4 pk;
#pragma unroll
            for (int j = 0; j < 4; ++j) pk[j] = pack2(sc[8 * s2 + 2 * j], sc[8 * s2 + 2 * j + 1]);
            const bf16x8 pb = __builtin_bit_cast(bf16x8, pk);
#pragma unroll
            for (int dt = 0; dt < 4; ++dt) {
                const LAS unsigned char* vp = lds + AttnCfg<HD>::V_OFF + (dbase + dt * 32 + mr) * AttnCfg<HD>::VSTR + (kt * 32 + 16 * s2 + 4 * mh) * 2;
                const u32x2 lo = *(const LAS u32x2*)vp, hi = *(const LAS u32x2*)(vp + 16);
                const u32x4 va = {lo[0], lo[1], hi[0], hi[1]};
                O[dt] = MFMA32(__builtin_bit_cast(bf16x8, va), pb, O[dt]);
            }
        }
    }
}
DI void attn_store(const f32x16 (&O)[4], float l_run, const bf16_t* zrow, bf16_t* yrow, int mh) {
    const float lt = l_run + __shfl_xor(l_run, 32);
    const float inv = 1.0f / lt;
#pragma unroll
    for (int dt = 0; dt < 4; ++dt)
#pragma unroll
        for (int g = 0; g < 4; ++g) {
            const int d = dt * 32 + 8 * g + 4 * mh;
            const u32x2 zz = *(const u32x2*)(zrow + d);
            u32x2 o;
            o[0] = pack2(O[dt][4 * g] * inv * siluf_(bflo(zz[0])), O[dt][4 * g + 1] * inv * siluf_(bfhi(zz[0])));
            o[1] = pack2(O[dt][4 * g + 2] * inv * siluf_(bflo(zz[1])), O[dt][4 * g + 3] * inv * siluf_(bfhi(zz[1])));
            *(u32x2*)(yrow + d) = o;
        }
}

DI void attnA_item(const Params& p, unsigned char* smem, int item) {
    const int b = item >> 6, head = (item >> 3) & 7, cgp = item & 7;
    int tid = threadIdx.x; asm volatile("" : "+v"(tid));
    const int wid = tid >> 6, lane = tid & 63, mr = lane & 31, mh = lane >> 5;
    LAS unsigned char* lds = (LAS unsigned char*)smem;
    const bf16_t* PA = (const bf16_t*)(p.ws + OFF_PA);
    const bf16_t* VT = (const bf16_t*)(p.ws + OFF_VT);
    bf16_t* YA = (bf16_t*)((char*)p.out + OFF_YA);
    const int cw = cgp * 4 + (wid >> 1), qt = wid & 1;
    const size_t qrow = (size_t)b * SEQ + cw * 64 + qt * 32 + mr;
    if (tid < 257) *(LAS float*)(lds + AttnCfg<128>::BIAS_OFF + tid * 4) = p.in[I_RELB][head * 257 + tid] * 1.4426950408889634f;
    bf16x8 Qf[8];
    attn_load_q<128>(Qf, PA + qrow * 3072 + head * 128, p.in[I_AQG], 0.08838834764831845f * 1.4426950408889634f, mh);
    f32x16 O[4];
#pragma unroll
    for (int dt = 0; dt < 4; ++dt)
#pragma unroll
        for (int i = 0; i < 16; ++i) O[dt][i] = 0.f;
    float m_run = -1e30f, l_run = 0.f;
    const int kc0 = cgp * 4 - 8 < 0 ? 0 : cgp * 4 - 8, kc1 = cgp * 4 + 3;
    const bf16_t* kbase = PA + (size_t)b * SEQ * 3072 + 1024 + head * 128;
    const bf16_t* vbase = VT + (size_t)(head * 128) * T_TOK + (size_t)b * SEQ;
    float gkr[16];
    {
#pragma unroll
        for (int i = 0; i < 4; ++i) { const f32x4 g4 = *(const f32x4*)(p.in[I_AKG] + (tid & 7) * 16 + i * 4); gkr[4 * i] = g4[0]; gkr[4 * i + 1] = g4[1]; gkr[4 * i + 2] = g4[2]; gkr[4 * i + 3] = g4[3]; }
    }
    KVRegs<128> R;
    attn_fetch<128>(R, kbase + (size_t)kc0 * 64 * 3072, 3072, vbase + kc0 * 64, T_TOK, tid);
    for (int kc = kc0; kc <= kc1; ++kc) {
        __syncthreads();
        attn_commit<128>(R, lds, gkr, tid);
        __syncthreads();
        if (kc < kc1) attn_fetch<128>(R, kbase + (size_t)(kc + 1) * 64 * 3072, 3072, vbase + (kc + 1) * 64, T_TOK, tid);
        if (kc >= cw - 8 && kc <= cw)
            attn_chunk<128, true, false>(Qf, lds, O, m_run, l_run, lds, 0, mr, mh, (cw - kc) * 64 + qt * 32);
    }
    attn_store(O, l_run, PA + qrow * 3072 + 2048 + head * 128, YA + qrow * 1024 + head * 128, mh);
    __syncthreads();
    if (tid == 0) __hip_atomic_fetch_add((unsigned*)(p.ws + OFF_CTR + 64), 1u, __ATOMIC_RELAXED, __HIP_MEMORY_SCOPE_AGENT);
}
DI void attnC_item(const Params& p, unsigned char* smem, int item) {
    const int b = item >> 6, hc = (item >> 4) & 3, qg = item & 15;
    int tid = threadIdx.x; asm volatile("" : "+v"(tid));
    const int wid = tid >> 6, lane = tid & 63, mr = lane & 31, mh = lane >> 5;
    LAS unsigned char* lds = (LAS unsigned char*)smem;
    const bf16_t* PC = (const bf16_t*)(p.ws + OFF_PC);
    const bf16_t* MK = (const bf16_t*)(p.ws + OFF_MK);
    const bf16_t* MVT = (const bf16_t*)(p.ws + OFF_MVT);
    bf16_t* YC = (bf16_t*)((char*)p.out + OFF_YC);
    const int qt = wid >> 1, dh = wid & 1;
    const size_t qrow = (size_t)b * SEQ + qg * 128 + qt * 32 + mr;
    constexpr int Q_OFF = AttnCfg<256>::V_OFF + 256 * AttnCfg<256>::VSTR;
    __syncthreads();
    {
        bf16x8 Qf[16];
        attn_load_q<256>(Qf, PC + qrow * 2048 + hc * 256, p.in[I_CQG], 0.0625f * 1.4426950408889634f, mh);
        if (dh == 0) {
#pragma unroll
            for (int s = 0; s < 16; ++s) *(LAS bf16x8*)(lds + Q_OFF + (qt * 32 + mr) * 528 + s * 32 + mh * 16) = Qf[s];
        }
    }
    const LAS unsigned char* qp = lds + Q_OFF + (qt * 32 + mr) * 528 + mh * 16;
    bf16x8 Qd[16];
    f32x16 O[4];
#pragma unroll
    for (int dt = 0; dt < 4; ++dt)
#pragma unroll
        for (int i = 0; i < 16; ++i) O[dt][i] = 0.f;
    float m_run = -1e30f, l_run = 0.f;
    const bf16_t* kbase = MK + (size_t)b * NMEM * 1024 + hc * 256;
    const bf16_t* vbase = MVT + (size_t)(hc * 256) * 2048 + (size_t)b * NMEM;
    float gkr[32];
    {
#pragma unroll
        for (int i = 0; i < 8; ++i) { const f32x4 g4 = *(const f32x4*)(p.in[I_CKG] + (tid & 7) * 32 + i * 4); gkr[4 * i] = g4[0]; gkr[4 * i + 1] = g4[1]; gkr[4 * i + 2] = g4[2]; gkr[4 * i + 3] = g4[3]; }
    }
    KVRegs<256> R;
    attn_fetch<256>(R, kbase, 1024, vbase, 2048, tid);
    for (int kc = 0; kc < 4; ++kc) {
        __syncthreads();
        attn_commit<256>(R, lds, gkr, tid);
        __syncthreads();
        if (kc < 3) attn_fetch<256>(R, kbase + (size_t)(kc + 1) * 64 * 1024, 1024, vbase + (kc + 1) * 64, 2048, tid);
        attn_chunk<256, false, true>(Qd, qp, O, m_run, l_run, lds, dh * 128, mr, mh, 0);
    }
    attn_store(O, l_run, PC + qrow * 2048 + 1024 + hc * 256 + dh * 128, YC + qrow * 1024 + hc * 256 + dh * 128, mh);
    __syncthreads();
}
DI void phase2(const Params& p, unsigned char* smem) {
    const int c = blockIdx.x;
    if (c < 128) scan_item(p, smem, c);
    for (int it = c + p.G; it < 128 && c < 128; it += p.G) scan_item(p, smem, it);
    unsigned* ctr = (unsigned*)(p.ws + OFF_CTR);
    LAS int* sitem = (LAS int*)((LAS unsigned char*)smem + LDS_BYTES - 16);
    auto fetch = [&]() -> int {
        __syncthreads();
        if (threadIdx.x == 0) *sitem = (int)atomicAdd(ctr, 1u);
        __syncthreads();
        return *sitem;
    };
    int item = fetch();
    while (item < 512) { attnA_item(p, smem, item); item = fetch(); }
    while (item < 1024) { attnC_item(p, smem, item - 512); item = fetch(); }
    if (blockIdx.x >= 128 && p.G == 256) {
        if (threadIdx.x == 0) { while (__hip_atomic_load((unsigned*)(p.ws + OFF_CTR + 64), __ATOMIC_RELAXED, __HIP_MEMORY_SCOPE_AGENT) < 512u) __builtin_amdgcn_s_sleep(8); }
        __syncthreads();
        gemm_phase<5>((LAS unsigned char*)smem, p);
    }
}

#define XB_TMO      128
#define XB_XCNT(j)  (256  + 64 * (j))
#define XB_XSUB(j)  (1280 + 64 * (j))
#define XB_XGEN(j)  (2304 + 64 * (j))
#define XB_TOP      3328
#define XB_TOPGEN   3392
#define XB_SPIN_CAP (1u << 18)
DI unsigned xb_ld(unsigned* p) { return __hip_atomic_load(p, __ATOMIC_RELAXED, __HIP_MEMORY_SCOPE_AGENT); }
DI unsigned xb_add(unsigned* p, unsigned v) { return __hip_atomic_fetch_add(p, v, __ATOMIC_RELAXED, __HIP_MEMORY_SCOPE_AGENT); }
DI unsigned xb_xcc_id() { return (unsigned)__builtin_amdgcn_s_getreg((3 << 11) | 20) & 0xFu; }
#define XB_SPIN(cond, bar) do { unsigned _sp = 0; while (cond) { __builtin_amdgcn_s_sleep(1); \
    if ((++_sp & 255u) == 0u) { if (xb_ld(&(bar)[XB_TMO])) break; if (_sp > XB_SPIN_CAP) { atomicAdd(&(bar)[XB_TMO], 1u); break; } } } } while (0)
struct XcdBarrier { unsigned* bar; unsigned x; volatile LAS unsigned* st; };
DI XcdBarrier xcd_barrier_post(unsigned* bar, volatile LAS unsigned* st) {
    XcdBarrier b; b.bar = bar; b.x = xb_xcc_id(); b.st = st;
    if (threadIdx.x == 0) (void)xb_add(&bar[XB_XCNT(b.x)], 1u);
    return b;
}
DI void xcd_barrier_complete(unsigned* bar, unsigned x, unsigned& nloc, unsigned& nx) {
    const unsigned G = gridDim.x * gridDim.y * gridDim.z;
    unsigned sum, cnt, mine, sp = 0u;
    for (;;) {
        sum = 0u; cnt = 0u; mine = 0u;
#pragma unroll
        for (unsigned j = 0; j < 16; ++j) { const unsigned c = xb_ld(&bar[XB_XCNT(j)]); sum += c; cnt += (c > 0u) ? 1u : 0u; mine = (j == x) ? c : mine; }
        if (sum == G) break;
        __builtin_amdgcn_s_sleep(1);
        if ((++sp & 255u) == 0u) { if (xb_ld(&bar[XB_TMO])) break; if (sp > XB_SPIN_CAP) { atomicAdd(&bar[XB_TMO], 1u); break; } }
    }
    nloc = mine > 0u ? mine : 1u; nx = cnt > 0u ? cnt : 1u;
}
DI void xcd_barrier(const XcdBarrier& b) {
    asm volatile("s_waitcnt vmcnt(0)" ::: "memory");
    __syncthreads();
    if (threadIdx.x == 0) {
        unsigned* bar = b.bar;
        __builtin_amdgcn_s_waitcnt(0);
        unsigned nloc = b.st[0], nx = b.st[1];
        if (nloc == 0u) { xcd_barrier_complete(bar, b.x, nloc, nx); b.st[0] = nloc; b.st[1] = nx; }
        const unsigned old = xb_add(&bar[XB_XSUB(b.x)], 1u);
        const unsigned gen = old / nloc;
        if (old + 1u == (gen + 1u) * nloc) {
            __builtin_amdgcn_fence(__ATOMIC_RELEASE, "agent");
            asm volatile("s_waitcnt vmcnt(0)" ::: "memory");
            const unsigned og = xb_add(&bar[XB_TOP], 1u);
            const unsigned tg = og / nx;
            if (og + 1u == (tg + 1u) * nx) xb_add(&bar[XB_TOPGEN], 1u);
            else XB_SPIN(xb_ld(&bar[XB_TOPGEN]) == tg, bar);
            __builtin_amdgcn_fence(__ATOMIC_ACQUIRE, "agent");
            xb_add(&bar[XB_XGEN(b.x)], 1u);
            asm volatile("s_waitcnt vmcnt(0)" ::: "memory");
        } else {
            XB_SPIN(xb_ld(&bar[XB_XGEN(b.x)]) == gen, bar);
            __builtin_amdgcn_fence(__ATOMIC_ACQUIRE, "agent");
            asm volatile("s_waitcnt vmcnt(0)" ::: "memory");
        }
    }
    __syncthreads();
}

__global__ void __launch_bounds__(NTHREADS) hybrid_fwd(Params p) {
    extern __shared__ __attribute__((aligned(16))) unsigned char smem[];
    cg::grid_group grid = cg::this_grid();
    volatile LAS unsigned* xst = (volatile LAS unsigned*)((LAS unsigned char*)smem + LDS_BYTES - 32);
    if (threadIdx.x == 0) { xst[0] = 0u; xst[1] = 0u; }
    __syncthreads();
    const XcdBarrier xb = xcd_barrier_post((unsigned*)(p.ws + OFF_BAR), xst);
    if (p.pad == 0x5a5a5a5a) grid.sync();
    phase0(p, smem);
    xcd_barrier(xb);
    gemm_phase<1>((LAS unsigned char*)smem, p); gemm_phase<7>((LAS unsigned char*)smem, p);
    xcd_barrier(xb);
    phase2(p, smem);
    xcd_barrier(xb);
    gemm_phase<3>((LAS unsigned char*)smem, p);
    xcd_barrier(xb);
    gemm_phase<4>((LAS unsigned char*)smem, p);
}

extern "C" void kernel_launch(void* const* d_in, const int* in_sizes, int n_in, void* d_out, int out_size, void* d_ws, size_t ws_size, hipStream_t stream) {
    static int grid_blocks = 0;
    if (grid_blocks == 0) {
        if (n_in != 27 || ws_size < WS_END || out_size != T_TOK * DM) { fprintf(stderr, "kernel_launch: unexpected shapes (n_in %d ws %zu out %d)\n", n_in, ws_size, out_size); grid_blocks = -1; return; }
        int dev = 0, cus = 0, per_cu = 0;
        hipGetDevice(&dev);
        hipDeviceGetAttribute(&cus, hipDeviceAttributeMultiprocessorCount, dev);
        if (hipFuncSetAttribute((const void*)hybrid_fwd, hipFuncAttributeMaxDynamicSharedMemorySize, LDS_BYTES) != hipSuccess) { fprintf(stderr, "kernel_launch: hipFuncSetAttribute failed\n"); grid_blocks = -1; return; }
        if (hipOccupancyMaxActiveBlocksPerMultiprocessor(&per_cu, (const void*)hybrid_fwd, NTHREADS, LDS_BYTES) != hipSuccess || per_cu < 1) { fprintf(stderr, "kernel_launch: occupancy query failed (%d)\n", per_cu); grid_blocks = -1; return; }
        grid_blocks = cus * 1;
        if (grid_blocks != 256) { fprintf(stderr, "kernel_launch: built for 256 CUs, found %d\n", cus); grid_blocks = -1; return; }
    }
    if (grid_blocks < 0) return;
    if (hipMemsetAsync((char*)d_ws + OFF_CTR, 0, 256 + BAR_BYTES, stream) != hipSuccess) { fprintf(stderr, "kernel_launch: hipMemsetAsync failed\n"); return; }
    Params p{};
    for (int i = 0; i < 27; ++i) p.in[i] = (const float*)d_in[i];
    p.out = (float*)d_out; p.ws = (unsigned char*)d_ws; p.G = grid_blocks; p.pad = 0;
    void* args[] = {&p};
    hipError_t e = hipLaunchCooperativeKernel((const void*)hybrid_fwd, dim3(grid_blocks), dim3(NTHREADS), args, LDS_BYTES, stream);
    if (e != hipSuccess) fprintf(stderr, "cooperative launch failed: %s (grid %d)\n", hipGetErrorString(e), grid_blocks);
}
```

```cpp
#include <hip/hip_runtime.h>
#include <hip/hip_cooperative_groups.h>
#include <cstdio>
namespace cg = cooperative_groups;

#define DI __device__ __forceinline__
#define LAS __attribute__((address_space(3)))
#define GAS __attribute__((address_space(1)))
typedef unsigned short bf16_t;
typedef short bf16x8 __attribute__((ext_vector_type(8)));
typedef float f32x2 __attribute__((ext_vector_type(2)));
typedef float f32x4 __attribute__((ext_vector_type(4)));
typedef float f32x16 __attribute__((ext_vector_type(16)));
typedef unsigned u32x2 __attribute__((ext_vector_type(2)));
typedef unsigned u32x4 __attribute__((ext_vector_type(4)));
typedef __bf16 bf16v2 __attribute__((ext_vector_type(2)));

constexpr int T_TOK = 16384, DM = 2048, SEQ = 2048, NB = 8, NMEM = 256;
constexpr int INC = 16512;
constexpr int NTHREADS = 512;
constexpr int LDS_BYTES = 139264;

constexpr size_t SZ_WT = (size_t)INC * DM * 2;
constexpr size_t OFF_WT = 0;
constexpr size_t OFF_WMEM = OFF_WT + SZ_WT;
constexpr size_t OFF_WUA = OFF_WMEM + (size_t)2048 * 2048 * 2;
constexpr size_t OFF_WUB = OFF_WUA + (size_t)2048 * 1024 * 2;
constexpr size_t OFF_WUC = OFF_WUB + (size_t)2048 * 1024 * 2;
constexpr size_t OFF_WO = OFF_WUC + (size_t)2048 * 1024 * 2;
constexpr size_t OFF_H = OFF_WO + (size_t)2048 * 2048 * 2;
constexpr size_t OFF_M = OFF_H + (size_t)T_TOK * 2048 * 2;
constexpr size_t OFF_PA = OFF_M + (size_t)2048 * 2048 * 2;
constexpr size_t OFF_PB = OFF_PA + (size_t)T_TOK * 3072 * 2;
constexpr size_t OFF_PL = OFF_PB + (size_t)T_TOK * 4096 * 2;
constexpr size_t OFF_PC = OFF_PL + (size_t)T_TOK * 256 * 2;
constexpr size_t OFF_VT = OFF_PC + (size_t)T_TOK * 2048 * 2;
constexpr size_t OFF_MK = OFF_VT + (size_t)1024 * T_TOK * 2;
constexpr size_t OFF_MVT = OFF_MK + (size_t)2048 * 1024 * 2;
constexpr size_t OFF_CTR = OFF_MVT + (size_t)1024 * 2048 * 2;
constexpr size_t OFF_BAR = OFF_CTR + 256;
constexpr size_t BAR_BYTES = 3456 * 4;
constexpr size_t WS_END = OFF_BAR + BAR_BYTES;
constexpr size_t OFF_MERGED = OFF_PB;
constexpr size_t OFF_SCR = OFF_PB + (size_t)T_TOK * 2048 * 2;
constexpr size_t OFF_G = OFF_PA;
constexpr size_t SCR_PER_WG = 2 * 131072;
constexpr size_t OFF_YA = 0, OFF_YB = (size_t)T_TOK * 1024 * 2, OFF_YC = 2 * OFF_YB;
constexpr size_t OFF_G2 = 3 * OFF_YB;

struct Params {
    const float* in[27];
    float* out;
    unsigned char* ws;
    int G; int pad;
};
enum { I_X = 0, I_MEM, I_NORMG, I_WIN, I_AQG, I_AKG, I_RELB, I_WUPA, I_MURKV, I_MUW, I_MUA, I_W0, I_W2, I_A0, I_A2, I_KK, I_KA, I_RK, I_LNW, I_LNB, I_WUPB,
       I_MEMG, I_WMEMKV, I_CQG, I_CKG, I_WUPC, I_WO };

DI unsigned pack2(float lo, float hi) { f32x2 v = {lo, hi}; bf16v2 b = __builtin_convertvector(v, bf16v2); return __builtin_bit_cast(unsigned, b); }
DI float bflo(unsigned u) { return __uint_as_float(u << 16); }
DI float bfhi(unsigned u) { return __uint_as_float(u & 0xffff0000u); }
DI float sigmoidf_(float x) { return __builtin_amdgcn_rcpf(1.0f + __expf(-x)); }
DI float siluf_(float x) { return x * sigmoidf_(x); }
DI float wave_sum(float v) {
#pragma unroll
    for (int o = 32; o > 0; o >>= 1) v += __shfl_xor(v, o);
    return v;
}
template <int CTRL> DI float dpp_mov(float x) { return __int_as_float(__builtin_amdgcn_update_dpp(0, __float_as_int(x), CTRL, 0xf, 0xf, false)); }
DI float reduce8(float x) {
    x += dpp_mov<0xB1>(x);
    x += dpp_mov<0x4E>(x);
    x += dpp_mov<0x141>(x);
    return x;
}
DI int crow(int i, int h) { return (i & 3) + 8 * (i >> 2) + 4 * h; }
#define MFMA32(a, b, c) __builtin_amdgcn_mfma_f32_32x32x16_bf16((a), (b), (c), 0, 0, 0)

struct TrTile { const float* src; bf16_t* dst; int R, C, tr, tc; };
DI void tr_load(const TrTile& t, f32x4& v0, f32x4& v1, int tid) {
    const int r = tid >> 3, cs = (tid & 7) * 8;
    const float* sp = t.src + (size_t)(t.tr * 64 + r) * t.C + t.tc * 64 + cs;
    v0 = __builtin_nontemporal_load((const f32x4*)sp); v1 = __builtin_nontemporal_load((const f32x4*)(sp + 4));
}
DI void tr_to_lds(const f32x4& v0, const f32x4& v1, float* lds, int tid) {
    const int r = tid >> 3, cs = (tid & 7) * 8;
    float* lp = lds + r * 65 + cs;
    lp[0] = v0[0]; lp[1] = v0[1]; lp[2] = v0[2]; lp[3] = v0[3]; lp[4] = v1[0]; lp[5] = v1[1]; lp[6] = v1[2]; lp[7] = v1[3];
}
DI void tr_store(const TrTile& t, const float* lds, int tid) {
    const int c = tid >> 3, ks = (tid & 7) * 8;
    u32x4 o;
    o[0] = pack2(lds[(ks + 0) * 65 + c], lds[(ks + 1) * 65 + c]);
    o[1] = pack2(lds[(ks + 2) * 65 + c], lds[(ks + 3) * 65 + c]);
    o[2] = pack2(lds[(ks + 4) * 65 + c], lds[(ks + 5) * 65 + c]);
    o[3] = pack2(lds[(ks + 6) * 65 + c], lds[(ks + 7) * 65 + c]);
    *(u32x4*)(t.dst + (size_t)(t.tc * 64 + c) * t.R + t.tr * 64 + ks) = o;
}
DI void rms_load(f32x4 (&v)[8], const float* __restrict__ x, int lane) {
#pragma unroll
    for (int i = 0; i < 8; ++i) v[i] = __builtin_nontemporal_load((const f32x4*)x + i * 64 + lane);
}
DI void rms_finish(const f32x4 (&v)[8], const float* __restrict__ g, bf16_t* __restrict__ out, int lane) {
    float ss = 0.f;
#pragma unroll
    for (int i = 0; i < 8; ++i) ss += v[i][0] * v[i][0] + v[i][1] * v[i][1] + v[i][2] * v[i][2] + v[i][3] * v[i][3];
    ss = wave_sum(ss);
    const float rstd = rsqrtf(ss * (1.0f / 2048.0f) + 1e-6f);
#pragma unroll
    for (int i = 0; i < 8; ++i) {
        const f32x4 g4 = ((const f32x4*)g)[i * 64 + lane];
        u32x2 o; o[0] = pack2(v[i][0] * rstd * g4[0], v[i][1] * rstd * g4[1]); o[1] = pack2(v[i][2] * rstd * g4[2], v[i][3] * rstd * g4[3]);
        ((u32x2*)out)[i * 64 + lane] = o;
    }
}
DI void phase0(const Params& p, unsigned char* smem) {
    float* lds = (float*)smem;
    const int G = p.G, c = blockIdx.x;
    if (c == 0 && threadIdx.x == 0) { *(unsigned*)(p.ws + OFF_CTR) = 0u; *(unsigned*)(p.ws + OFF_CTR + 64) = 0u; }
    constexpr int N_WIN = 32 * 258, N_SQ = 32 * 32, N_UP = 16 * 32;
    constexpr int NTR = N_WIN + N_SQ + 3 * N_UP + N_SQ;
    const int tid = threadIdx.x;
    auto tile_of = [&](int u, TrTile& t) {
        int l = u;
        if (l < N_WIN) { t = {p.in[I_WIN], (bf16_t*)(p.ws + OFF_WT), 2048, INC, l & 31, l >> 5}; return; }
        l -= N_WIN;
        if (l < N_SQ) { t = {p.in[I_WMEMKV], (bf16_t*)(p.ws + OFF_WMEM), 2048, 2048, l & 31, l >> 5}; return; }
        l -= N_SQ;
        if (l < 3 * N_UP) {
            const int w = l / N_UP; l -= w * N_UP;
            t = {w == 0 ? p.in[I_WUPA] : (w == 1 ? p.in[I_WUPB] : p.in[I_WUPC]), (bf16_t*)(p.ws + (w == 0 ? OFF_WUA : (w == 1 ? OFF_WUB : OFF_WUC))), 1024, 2048, l & 15, l >> 4}; return;
        }
        l -= 3 * N_UP;
        t = {p.in[I_WO], (bf16_t*)(p.ws + OFF_WO), 2048, 2048, l & 31, l >> 5};
    };
    {
        TrTile cur, nxt; f32x4 v0, v1;
        int u = c, par = 0;
        if (u < NTR) { tile_of(u, cur); tr_load(cur, v0, v1, tid); }
        for (; u < NTR; u += G) {
            float* buf = lds + par * (64 * 65);
            tr_to_lds(v0, v1, buf, tid);
            const bool more = u + G < NTR;
            if (more) { tile_of(u + G, nxt); tr_load(nxt, v0, v1, tid); }
            __syncthreads();
            tr_store(cur, buf, tid);
            cur = nxt; par ^= 1;
        }
    }
    {
        const int wid = tid >> 6, lane = tid & 63;
        auto row_ptrs = [&](int row, const float*& x, const float*& g, bf16_t*& o) {
            if (row < T_TOK) { x = p.in[I_X] + (size_t)row * 2048; g = p.in[I_NORMG]; o = (bf16_t*)(p.ws + OFF_H) + (size_t)row * 2048; }
            else { x = p.in[I_MEM] + (size_t)(row - T_TOK) * 2048; g = p.in[I_MEMG]; o = (bf16_t*)(p.ws + OFF_M) + (size_t)(row - T_TOK) * 2048; }
        };
        constexpr int NRG = (T_TOK + 2048) / 8;
        f32x4 va[8], vb[8];
        const float* x; const float* g; bf16_t* o;
        int rg = c;
        if (rg < NRG) { row_ptrs(rg * 8 + wid, x, g, o); rms_load(va, x, lane); }
        for (; rg < NRG; rg += 2 * G) {
            const float* x2; const float* g2; bf16_t* o2;
            const bool m1 = rg + G < NRG;
            if (m1) { row_ptrs((rg + G) * 8 + wid, x2, g2, o2); rms_load(vb, x2, lane); }
            rms_finish(va, g, o, lane);
            const bool m2 = rg + 2 * G < NRG;
            if (m2) { row_ptrs((rg + 2 * G) * 8 + wid, x, g, o); rms_load(va, x, lane); }
            if (m1) rms_finish(vb, g2, o2, lane);
        }
    }
    __syncthreads();
}

constexpr int BM = 256, BK = 64, HALF = 128, HTB = HALF * BK * 2;
DI int lds_byte(int r, int c) { const int st = (r >> 4) * 2 + (c >> 5), rr = r & 15, cc = c & 31, ob = rr * 64 + cc * 2; return st * 1024 + (ob ^ (((ob >> 9) & 1) << 5)); }
DI void stage_rc(int b, int& R, int& C) { const int st = b / 1024, sb = b % 1024, swz = sb ^ (((sb >> 9) & 1) << 5); R = (st >> 1) * 16 + swz / 64; C = (st & 1) * 32 + (swz % 64) / 2; }

enum { EPI_BF16 = 0, EPI_UP = 1, EPI_GATE = 2, EPI_SIG = 3, EPI_OUT = 4, EPI_UPG = 5 };
struct Unit { const char* A; const char* B; char* C; int K; int ldc; int kind; int aux; const float* X; const char* Gp; };

template <int PH>
DI void epilogue(const f32x4 (&acc)[2][2][4][2], const Unit& u, int wr, int wc, int fr, int fq, int tid, char* scr) {
    if (PH == 1) {
        const int odd = fr & 1;
        GAS bf16_t* rowe = (GAS bf16_t*)u.C + (size_t)(wr * 64 + (fr & ~1)) * u.ldc + wc * 64 + 16 * fq + odd * 8;
        const size_t step16 = (size_t)16 * u.ldc;
#pragma unroll
        for (int ai = 0; ai < 2; ++ai)
#pragma unroll
            for (int m = 0; m < 4; ++m) {
                asm volatile("" : "+v"(rowe) : : "memory");
                u32x4 o0, o1;
                { const f32x4 a0 = acc[ai][0][m][0], a1 = acc[ai][0][m][1]; o0[0] = pack2(a0[0], a0[1]); o0[1] = pack2(a0[2], a0[3]); o0[2] = pack2(a1[0], a1[1]); o0[3] = pack2(a1[2], a1[3]); }
                { const f32x4 a0 = acc[ai][1][m][0], a1 = acc[ai][1][m][1]; o1[0] = pack2(a0[0], a0[1]); o1[1] = pack2(a0[2], a0[3]); o1[2] = pack2(a1[0], a1[1]); o1[3] = pack2(a1[2], a1[3]); }
                u32x4 snd, rcv, d1, d2;
#pragma unroll
                for (int i = 0; i < 4; ++i) {
                    snd[i] = odd ? o0[i] : o1[i];
                    rcv[i] = (unsigned)__builtin_amdgcn_update_dpp(0, (int)snd[i], 0xB1, 0xf, 0xf, false);
                    d1[i] = odd ? rcv[i] : o0[i];
                    d2[i] = odd ? o1[i] : rcv[i];
                }
                *(GAS u32x4*)rowe = d1;
                *(GAS u32x4*)(rowe + u.ldc) = d2;
                rowe += (m == 3) ? 5 * step16 : step16;
            }
    } else if (PH == 4) {
        const size_t ro0 = (size_t)(wr * 64 + fr) * 2048 + wc * 64 + 16 * fq;
        const GAS float* xp = (const GAS float*)u.X + ro0; GAS float* op = (GAS float*)u.C + ro0;
#pragma unroll
        for (int ai = 0; ai < 2; ++ai) {
#pragma unroll
            for (int mp = 0; mp < 2; ++mp) {
                asm volatile("" : "+v"(xp), "+v"(op) : : "memory");
                f32x4 xv[2][4];
#pragma unroll
                for (int mm = 0; mm < 2; ++mm)
#pragma unroll
                    for (int q = 0; q < 4; ++q) xv[mm][q] = *(const GAS f32x4*)(xp + mm * 16 * 2048 + q * 4);
                asm volatile("" ::: "memory");
#pragma unroll
                for (int mm = 0; mm < 2; ++mm) {
                    const int m = mp * 2 + mm;
#pragma unroll
                    for (int bj = 0; bj < 2; ++bj)
#pragma unroll
                        for (int n = 0; n < 2; ++n) *(GAS f32x4*)(op + mm * 16 * 2048 + bj * 8 + n * 4) = acc[ai][bj][m][n] + xv[mm][bj * 2 + n];
                }
                xp += 32 * 2048; op += 32 * 2048;
            }
            xp += 64 * 2048; op += 64 * 2048;
        }
    } else if (PH == 5 || PH == 7 || (PH == 3 && u.kind == EPI_UP)) {
        const bool sg = u.kind == EPI_SIG;
        GAS u32x2* sp = (GAS u32x2*)(sg ? u.C : scr) + tid;
#pragma unroll
        for (int ai = 0; ai < 2; ++ai)
#pragma unroll
            for (int m = 0; m < 4; ++m) {
                asm volatile("" : "+v"(sp) : : "memory");
#pragma unroll
                for (int bj = 0; bj < 2; ++bj)
#pragma unroll
                    for (int n = 0; n < 2; ++n) {
                        f32x4 a = acc[ai][bj][m][n];
                        if (sg) { a[0] = sigmoidf_(a[0]); a[1] = sigmoidf_(a[1]); a[2] = sigmoidf_(a[2]); a[3] = sigmoidf_(a[3]); }
                        u32x2 o; o[0] = pack2(a[0], a[1]); o[1] = pack2(a[2], a[3]);
                        sp[(bj * 2 + n) * 512] = o;
                    }
                sp += 4 * 512;
            }
    } else {
        GAS u32x2* sp = (GAS u32x2*)scr + tid;
        const bool isg = u.kind == EPI_GATE;
        const GAS u32x2* gp = isg ? (const GAS u32x2*)scr + tid : (const GAS u32x2*)u.Gp + tid;
        const int mode = u.aux;
        u32x2 uu[2][4], mm[2][4];
        auto issue = [&](int slot) {
#pragma unroll
            for (int q = 0; q < 4; ++q) { uu[slot][q] = gp[q * 512]; mm[slot][q] = (u32x2){0u, 0u}; if (mode != 0) mm[slot][q] = sp[q * 512 + 16384]; }
        };
        issue(0);
#pragma unroll
        for (int ai = 0; ai < 2; ++ai)
#pragma unroll
            for (int m = 0; m < 4; ++m) {
                const int g = ai * 4 + m, cur = g & 1;
                GAS u32x2* spc = sp;
                sp += 4 * 512; gp += 4 * 512;
                asm volatile("" : "+v"(sp), "+v"(gp) : : "memory");
                if (g < 7) issue(cur ^ 1);
                __builtin_amdgcn_sched_barrier(0);
                GAS bf16_t* rowp = (GAS bf16_t*)u.C + (size_t)(ai * 128 + wr * 64 + m * 16 + fr) * u.ldc + wc * 64 + 16 * fq;
#pragma unroll
                for (int bj = 0; bj < 2; ++bj)
#pragma unroll
                    for (int n = 0; n < 2; ++n) {
                        const int q = bj * 2 + n;
                        const u32x2 u2 = uu[cur][q], m2 = mm[cur][q];
                        f32x4 a = acc[ai][bj][m][n];
                        if (isg) { a[0] = sigmoidf_(a[0]); a[1] = sigmoidf_(a[1]); a[2] = sigmoidf_(a[2]); a[3] = sigmoidf_(a[3]); }
                        const float r0 = bflo(m2[0]) + a[0] * bflo(u2[0]);
                        const float r1 = bfhi(m2[0]) + a[1] * bfhi(u2[0]);
                        const float r2 = bflo(m2[1]) + a[2] * bflo(u2[1]);
                        const float r3 = bfhi(m2[1]) + a[3] * bfhi(u2[1]);
                        u32x2 o; o[0] = pack2(r0, r1); o[1] = pack2(r2, r3);
                        if (mode == 2) *(GAS u32x2*)(rowp + bj * 8 + n * 4) = o; else spc[q * 512 + 16384] = o;
                    }
            }
    }
}

DI void tile_pmpn(int tl, int& pm, int& pn) { pm = (tl & 7) + 8 * (tl >> 6); pn = (tl >> 3) & 7; }
DI const char* gate_tile_ptr(const Params& p, int g) {
    const unsigned long long a0 = (unsigned long long)p.out + OFF_G2 + (unsigned long long)g * 131072ull, a1 = (unsigned long long)p.ws + OFF_G + (unsigned long long)(g - 128) * 131072ull;
    return (const char*)(g < 128 ? a0 : a1);
}
DI void gate_unit(const Params& p, int g, Unit& u) {
    const int lt = g >> 1, x = g & 1;
    int pm, pn; tile_pmpn(256 + lt, pm, pn);
    const char* ws = (const char*)p.ws;
    u.X = nullptr; u.ldc = 0; u.Gp = nullptr; u.aux = 0;
    u.K = 2048; u.kind = EPI_SIG;
    u.A = ws + OFF_H + (size_t)pm * 256 * 4096;
    u.B = ws + OFF_WT + (size_t)(10368 + 2048 * x + 256 * pn) * 4096;
    u.C = (char*)gate_tile_ptr(p, g);
}
DI bool p1_unit(const Params& p, int L, Unit& u) {
    if (L >= 2688) return false;

    u.K = 2048; u.kind = EPI_BF16; u.aux = 0; u.X = nullptr; u.Gp = nullptr;
    const char* ws = (const char*)p.ws;
    if (L < 2368) {
        const int gid = L / 296, rem = L - gid * 296, pm = gid * 8 + (rem & 7), ct = rem >> 3;
        int brow, col, ldc; size_t cb;
        if (ct < 8) { brow = ct * 256; cb = OFF_PA; col = ct * 256; ldc = 3072; }
        else if (ct < 12) { brow = 3072 + (ct - 8) * 256; cb = OFF_PA; col = 2048 + (ct - 8) * 256; ldc = 3072; }
        else if (ct < 28) { brow = 4096 + (ct - 12) * 256; cb = OFF_PB; col = (ct - 12) * 256; ldc = 4096; }
        else if (ct == 28) { brow = 8192; cb = OFF_PL; col = 0; ldc = 256; }
        else { brow = 8320 + (ct - 29) * 256; cb = OFF_PC; col = (ct - 29) * 256; ldc = 2048; }
        u.A = ws + OFF_H + (size_t)pm * 256 * 4096; u.B = ws + OFF_WT + (size_t)brow * 4096;
        u.C = (char*)p.ws + cb + ((size_t)pm * 256 * ldc + col) * 2; u.ldc = ldc;
    } else if (L < 2624) {
        const int l = L - 2368, pm = l & 3, pn = l >> 2;
        u.A = ws + OFF_WT + (size_t)(2048 + pm * 256) * 4096; u.B = ws + OFF_H + (size_t)pn * 256 * 4096;
        u.C = (char*)p.ws + OFF_VT + ((size_t)pm * 256 * T_TOK + pn * 256) * 2; u.ldc = T_TOK;
    } else if (L < 2656) {
        const int l = L - 2624, pm = l & 7, pn = l >> 3;
        u.A = ws + OFF_M + (size_t)pm * 256 * 4096; u.B = ws + OFF_WMEM + (size_t)pn * 256 * 4096;
        u.C = (char*)p.ws + OFF_MK + ((size_t)pm * 256 * 1024 + pn * 256) * 2; u.ldc = 1024;
    } else {
        const int l = L - 2656, pm = l & 3, pn = l >> 2;
        u.A = ws + OFF_WMEM + (size_t)(1024 + pm * 256) * 4096; u.B = ws + OFF_M + (size_t)pn * 256 * 4096;
        u.C = (char*)p.ws + OFF_MVT + ((size_t)pm * 256 * 2048 + pn * 256) * 2; u.ldc = 2048;
    }
    return true;
}
constexpr int PG_N = 2;
DI bool p3_unit(const Params& p, int cp, int ui, Unit& u) {
    if (ui >= 12 - PG_N) return false;
    const bool light = ui >= 6;
    int x, isgate; bool pre = false;
    if (!light) { x = ui >> 1; isgate = ui & 1; }
    else { const int li = ui - 6; if (li < PG_N) { x = li; isgate = 0; pre = true; } else { const int r = li - PG_N; x = PG_N + (r >> 1); isgate = r & 1; } }
    const int tl = light ? 256 + cp : cp;
    int pm, pn; tile_pmpn(tl, pm, pn);
    const char* ws = (const char*)p.ws; const char* yo = (const char*)p.out;
    u.X = nullptr; u.ldc = 2048; u.Gp = nullptr;
    u.C = (char*)p.ws + OFF_MERGED + ((size_t)pm * 256 * 2048 + pn * 256) * 2;
    if (!isgate) {
        u.K = 1024; u.kind = pre ? EPI_UPG : EPI_UP; u.aux = pre ? x : 0;
        u.A = yo + (size_t)x * OFF_YB + (size_t)pm * 256 * 2048;
        u.B = ws + (x == 0 ? OFF_WUA : (x == 1 ? OFF_WUB : OFF_WUC)) + (size_t)pn * 256 * 2048;
        if (pre) u.Gp = gate_tile_ptr(p, 2 * cp + x);
    } else {
        u.K = 2048; u.kind = EPI_GATE; u.aux = x;
        u.A = ws + OFF_H + (size_t)pm * 256 * 4096;
        u.B = ws + OFF_WT + (size_t)(10368 + 2048 * x + 256 * pn) * 4096;
    }
    return true;
}
DI bool pg_unit(const Params& p, int ui, Unit& u) {
    if (ui >= 3) return false;
    gate_unit(p, 128 + 3 * ((int)blockIdx.x - 128) + ui, u);
    return true;
}
DI bool p4_unit(const Params& p, int cp, int ui, Unit& u) {
    const int tl = cp + p.G * ui;
    if (tl >= 512) return false;
    int pm, pn; tile_pmpn(tl, pm, pn);
    const char* ws = (const char*)p.ws;
    u.K = 2048; u.kind = EPI_OUT; u.aux = 0; u.ldc = 2048; u.Gp = nullptr;
    u.A = ws + OFF_MERGED + (size_t)pm * 256 * 4096; u.B = ws + OFF_WO + (size_t)pn * 256 * 4096;
    u.C = (char*)(p.out + (size_t)pm * 256 * 2048 + pn * 256);
    u.X = p.in[I_X] + (size_t)pm * 256 * 2048 + pn * 256;
    return true;
}
template <int PH> DI bool get_unit(const Params& p, int cp, int ui, Unit& u) {
    if (PH == 1) return p1_unit(p, ui * p.G + cp, u);
    if (PH == 3) return p3_unit(p, cp, ui, u);
    if (PH == 5) return pg_unit(p, ui, u);
    if (PH == 7) { if (ui >= 1 || cp < 128) return false; gate_unit(p, cp - 128, u); return true; }
    return p4_unit(p, cp, ui, u);
}

template <int PH>
DI void gemm_phase(LAS unsigned char* lds, const Params& p) {
    int tid = threadIdx.x; asm volatile("" : "+v"(tid));
    const int wid = __builtin_amdgcn_readfirstlane(tid >> 6), lane = tid & 63, wr = wid >> 2, wc = wid & 3, fr = lane & 15, fq = lane >> 4;
    const int c = blockIdx.x, cp = (p.G & 7) == 0 ? (c & 7) * (p.G >> 3) + (c >> 3) : c;
    char* scr = (char*)p.ws + OFF_SCR + (size_t)c * SCR_PER_WG;
    int sR[2], sC[2];
#pragma unroll
    for (int i = 0; i < 2; ++i) stage_rc(tid * 16 + i * 8192, sR[i], sC[i]);
    int sRB[2][2];
#pragma unroll
    for (int bj = 0; bj < 2; ++bj)
#pragma unroll
        for (int i = 0; i < 2; ++i) { const int R = sR[i]; sRB[bj][i] = 64 * (R >> 5) + 16 * ((R >> 2) & 3) + 8 * bj + 4 * ((R >> 4) & 1) + (R & 3); }
    const unsigned ldsw = (unsigned)wid * 1024u;
    const int aoff = lds_byte(wr * 64 + fr, fq * 8), boff = lds_byte(wc * 32 + fr, fq * 8);
#define G_SA(b, h) (((b) * 2 + (h)) * HTB)
#define G_SB(b, h) ((4 + (b) * 2 + (h)) * HTB)
#define G_STAGE(bufoff, gbase, KK) do { _Pragma("unroll") for (int _i = 0; _i < 2; ++_i) \
        __builtin_amdgcn_global_load_lds((const unsigned*)((gbase) + (size_t)(unsigned)((sR[_i] * (KK) + sC[_i]) * 2)), (LAS unsigned*)(lds + (bufoff) + ldsw + _i * 8192), 16, 0, 0); } while (0)
#define G_STAGE_B(bufoff, gbase, KK, bj) do { _Pragma("unroll") for (int _i = 0; _i < 2; ++_i) \
        __builtin_amdgcn_global_load_lds((const unsigned*)((gbase) + (size_t)(unsigned)((sRB[bj][_i] * (KK) + sC[_i]) * 2)), (LAS unsigned*)(lds + (bufoff) + ldsw + _i * 8192), 16, 0, 0); } while (0)
#define G_LDA(dst, b, h) do { _Pragma("unroll") for (int m = 0; m < 4; ++m) _Pragma("unroll") for (int k = 0; k < 2; ++k) dst[m][k] = *(const LAS bf16x8*)(lds + G_SA(b, h) + aoff + m * 2048 + k * 1024); } while (0)
#define G_LDB(dst, b, h) do { _Pragma("unroll") for (int n = 0; n < 2; ++n) _Pragma("unroll") for (int k = 0; k < 2; ++k) dst[n][k] = *(const LAS bf16x8*)(lds + G_SB(b, h) + boff + n * 2048 + k * 1024); } while (0)
#define G_MMA(ai, bj, At, Bt) do { __builtin_amdgcn_s_setprio(1); _Pragma("unroll") for (int m = 0; m < 4; ++m) _Pragma("unroll") for (int n = 0; n < 2; ++n) _Pragma("unroll") for (int k = 0; k < 2; ++k) \
        acc[ai][bj][m][n] = __builtin_amdgcn_mfma_f32_16x16x32_bf16(Bt[n][k], At[m][k], acc[ai][bj][m][n], 0, 0, 0); __builtin_amdgcn_s_setprio(0); } while (0)
#define G_WAIT_V(n) asm volatile("s_waitcnt vmcnt(" #n ")" ::: "memory")
#define G_WAIT_L(n) asm volatile("s_waitcnt lgkmcnt(" #n ")" ::: "memory")
#define G_BAR __builtin_amdgcn_s_barrier()
#define G_SCHED __builtin_amdgcn_sched_barrier(0)
    Unit cur, nxt; int ui = 0;
    if (!get_unit<PH>(p, cp, 0, cur)) return;
    f32x4 acc[2][2][4][2];
#pragma unroll
    for (int a = 0; a < 2; ++a)
#pragma unroll
        for (int b = 0; b < 2; ++b)
#pragma unroll
            for (int m = 0; m < 4; ++m)
#pragma unroll
                for (int n = 0; n < 2; ++n) acc[a][b][m][n] = (f32x4){0.f, 0.f, 0.f, 0.f};
    bf16x8 At[4][2], B0[2][2], B1[2][2];
    const char* cA = cur.A; const char* cB = cur.B; int Kc = cur.K;
    {
        const size_t hs = (size_t)HALF * Kc * 2;
        G_STAGE_B(G_SB(0, 0), cB, Kc, 0); G_STAGE(G_SA(0, 0), cA, Kc); G_STAGE_B(G_SB(0, 1), cB, Kc, 1); G_STAGE(G_SA(0, 1), cA + hs, Kc);
        if (wr == 1) G_BAR;
        G_WAIT_V(4); G_BAR;
        G_STAGE_B(G_SB(1, 0), cB + 128, Kc, 0); G_STAGE(G_SA(1, 0), cA + 128, Kc); G_STAGE_B(G_SB(1, 1), cB + 128, Kc, 1);
        G_WAIT_V(6); G_BAR;
    }
    for (;;) {
        const bool has_next = get_unit<PH>(p, cp, ui + 1, nxt);
        const char* nA = has_next ? nxt.A : cA; const char* nB = has_next ? nxt.B : cB; const int Kn = has_next ? nxt.K : Kc;
        const int nt = Kc / BK;
        const size_t hsc = (size_t)HALF * Kc * 2;
        for (int t = 0; t < nt; t += 2) {
            const bool last = (t == nt - 2);
            const char* a1 = cA + (size_t)(t + 1) * 128;
            const int K2 = last ? Kn : Kc;
            const size_t hs2 = (size_t)HALF * K2 * 2;
            const char* a2 = last ? nA : cA + (size_t)(t + 2) * 128; const char* b2 = last ? nB : cB + (size_t)(t + 2) * 128;
            const char* a3 = a2 + 128; const char* b3 = b2 + 128;
            G_LDB(B0, 0, 0); G_SCHED; G_LDA(At, 0, 0); G_STAGE(G_SA(1, 1), a1 + hsc, Kc);
            G_WAIT_L(8); G_BAR; G_WAIT_L(0); G_MMA(0, 0, At, B0); G_BAR; G_SCHED;
            G_LDB(B1, 0, 1); G_STAGE_B(G_SB(0, 0), b2, K2, 0);
            G_BAR; G_WAIT_L(0); G_MMA(0, 1, At, B1); G_BAR;
            G_LDA(At, 0, 1); G_STAGE(G_SA(0, 0), a2, K2);
            G_BAR; G_WAIT_L(0); G_MMA(1, 0, At, B0); G_BAR; G_SCHED;
            G_STAGE_B(G_SB(0, 1), b2, K2, 1);
            G_WAIT_V(6); G_BAR; G_MMA(1, 1, At, B1); G_BAR;
            G_LDB(B0, 1, 0); G_SCHED; G_LDA(At, 1, 0); G_STAGE(G_SA(0, 1), a2 + hs2, K2);
            G_WAIT_L(8); G_BAR; G_WAIT_L(0); G_MMA(0, 0, At, B0); G_BAR; G_SCHED;
            G_LDB(B1, 1, 1); G_STAGE_B(G_SB(1, 0), b3, K2, 0);
            G_BAR; G_WAIT_L(0); G_MMA(0, 1, At, B1); G_BAR;
            G_LDA(At, 1, 1); G_STAGE(G_SA(1, 0), a3, K2);
            G_BAR; G_WAIT_L(0); G_MMA(1, 0, At, B0); G_BAR; G_SCHED;
            G_STAGE_B(G_SB(1, 1), b3, K2, 1);
            G_WAIT_V(6); G_BAR; G_MMA(1, 1, At, B1); G_BAR;
        }
        epilogue<PH>(acc, cur, wr, wc, fr, fq, tid, scr);
        if (!has_next) break;
#pragma unroll
        for (int a = 0; a < 2; ++a)
#pragma unroll
            for (int b = 0; b < 2; ++b)
#pragma unroll
                for (int m = 0; m < 4; ++m)
#pragma unroll
                    for (int n = 0; n < 2; ++n) acc[a][b][m][n] = (f32x4){0.f, 0.f, 0.f, 0.f};
        cur = nxt; cA = nA; cB = nB; Kc = Kn; ++ui;
    }
    G_WAIT_V(0);
    if (wr == 0) G_BAR;
    G_BAR;
}

constexpr int SB_W = 0, SB_KK = 8192, SB_BV = 16384, SB_KP = 24576, SB_R = 32768, SB_V = 40960, SB_O = 49152, SB_SIZE = 57344;
constexpr int SC_AWD = 114688, SC_AAD = 119296;
constexpr int SC_ASTR = 144;
DI void ld8(const bf16_t* ptr, float (&f)[8]) {
    const u32x4 v = *(const u32x4*)ptr;
#pragma unroll
    for (int i = 0; i < 4; ++i) { f[2 * i] = bflo(v[i]); f[2 * i + 1] = bfhi(v[i]); }
}
struct ScanOps { f32x4 w0, w1, a0, a1, b0, b1, k0, k1, r0, r1; f32x2 v; };
DI void scan_load(ScanOps& o, const LAS unsigned char* bp, const LAS unsigned char* vp) {
    o.w0 = *(const LAS f32x4*)(bp + SB_W); o.w1 = *(const LAS f32x4*)(bp + SB_W + 16);
    o.a0 = *(const LAS f32x4*)(bp + SB_KK); o.a1 = *(const LAS f32x4*)(bp + SB_KK + 16);
    o.b0 = *(const LAS f32x4*)(bp + SB_BV); o.b1 = *(const LAS f32x4*)(bp + SB_BV + 16);
    o.k0 = *(const LAS f32x4*)(bp + SB_KP); o.k1 = *(const LAS f32x4*)(bp + SB_KP + 16);
    o.r0 = *(const LAS f32x4*)(bp + SB_R); o.r1 = *(const LAS f32x4*)(bp + SB_R + 16);
    o.v = *(const LAS f32x2*)vp;
}
DI f32x2 lo2(f32x4 x) { return (f32x2){x[0], x[1]}; }
DI f32x2 hi2(f32x4 x) { return (f32x2){x[2], x[3]}; }
DI f32x2 splat2(float x) { return (f32x2){x, x}; }
DI void reduce8x2(float& a, float& b) {
    float ra, rb;
    asm volatile("s_nop 1\n\t"
                 "v_add_f32_dpp %0, %2, %2 quad_perm:[1,0,3,2] row_mask:0xf bank_mask:0xf bound_ctrl:1\n\t"
                 "v_add_f32_dpp %1, %3, %3 quad_perm:[1,0,3,2] row_mask:0xf bank_mask:0xf bound_ctrl:1\n\t"
                 "s_nop 0\n\t"
                 "v_add_f32_dpp %0, %0, %0 quad_perm:[2,3,0,1] row_mask:0xf bank_mask:0xf bound_ctrl:1\n\t"
                 "v_add_f32_dpp %1, %1, %1 quad_perm:[2,3,0,1] row_mask:0xf bank_mask:0xf bound_ctrl:1\n\t"
                 "s_nop 0\n\t"
                 "v_add_f32_dpp %0, %0, %0 row_half_mirror row_mask:0xf bank_mask:0xf bound_ctrl:1\n\t"
                 "v_add_f32_dpp %1, %1, %1 row_half_mirror row_mask:0xf bank_mask:0xf bound_ctrl:1\n\t"
                 "s_nop 1"
                 : "=&v"(ra), "=&v"(rb) : "v"(a), "v"(b));
    a = ra; b = rb;
}
DI void scan_step(f32x2 (&S0)[4], f32x2 (&S1)[4], const ScanOps& o, LAS unsigned char* op, bool wr) {
    const f32x2 kk[4] = {lo2(o.a0), hi2(o.a0), lo2(o.a1), hi2(o.a1)};
    f32x2 p0 = S0[0] * kk[0], p1 = S1[0] * kk[0];
#pragma unroll
    for (int q = 1; q < 4; ++q) { p0 = __builtin_elementwise_fma(S0[q], kk[q], p0); p1 = __builtin_elementwise_fma(S1[q], kk[q], p1); }
    float sa0 = p0[0] + p0[1], sa1 = p1[0] + p1[1];
    reduce8x2(sa0, sa1);
    const f32x2 ww[4] = {lo2(o.w0), hi2(o.w0), lo2(o.w1), hi2(o.w1)};
    const f32x2 bb[4] = {lo2(o.b0), hi2(o.b0), lo2(o.b1), hi2(o.b1)};
    const f32x2 kv[4] = {lo2(o.k0), hi2(o.k0), lo2(o.k1), hi2(o.k1)};
    const f32x2 rr[4] = {lo2(o.r0), hi2(o.r0), lo2(o.r1), hi2(o.r1)};
    const f32x2 v0 = splat2(o.v[0]), v1 = splat2(o.v[1]), s0 = splat2(-sa0), s1 = splat2(-sa1);
#pragma unroll
    for (int q = 0; q < 4; ++q) {
        const f32x2 t0 = __builtin_elementwise_fma(bb[q], s0, kv[q] * v0), t1 = __builtin_elementwise_fma(bb[q], s1, kv[q] * v1);
        S0[q] = __builtin_elementwise_fma(S0[q], ww[q], t0); S1[q] = __builtin_elementwise_fma(S1[q], ww[q], t1);
    }
    f32x2 q0 = S0[0] * rr[0], q1 = S1[0] * rr[0];
#pragma unroll
    for (int q = 1; q < 4; ++q) { q0 = __builtin_elementwise_fma(S0[q], rr[q], q0); q1 = __builtin_elementwise_fma(S1[q], rr[q], q1); }
    float o0 = q0[0] + q0[1], o1 = q1[0] + q1[1];
    reduce8x2(o0, o1);
    (void)wr;
    *(LAS f32x2*)op = (f32x2){o0, o1};
}
DI void scan_item(const Params& p, unsigned char* smem, int item) {
    const int b = item >> 4, h = item & 15;
    int tid = threadIdx.x; asm volatile("" : "+v"(tid));
    const int wid = __builtin_amdgcn_readfirstlane(tid >> 6), lane = tid & 63;
    const bf16_t* PB = (const bf16_t*)(p.ws + OFF_PB);
    const bf16_t* PL = (const bf16_t*)(p.ws + OFF_PL);
    bf16_t* YB = (bf16_t*)((char*)p.out + OFF_YB);
    LAS unsigned char* lds = (LAS unsigned char*)smem;
    const bool helper = wid >= 4;
    const int hw = wid & 3, mat = hw >> 1, tn = hw & 1, mr = lane & 31, mh = lane >> 5;
    bf16x8 Bf[4];
    float w0c = 0.f, a0c = 0.f, kac = 0.f;
    if (helper) {
        const float* Wx = (mat == 0 ? p.in[I_W2] : p.in[I_A2]) + h * 64 + tn * 32 + mr;
#pragma unroll
        for (int s = 0; s < 4; ++s) {
            u32x4 pk;
#pragma unroll
            for (int jj = 0; jj < 4; ++jj) pk[jj] = pack2(Wx[(size_t)(16 * s + 8 * mh + 2 * jj) * 1024], Wx[(size_t)(16 * s + 8 * mh + 2 * jj + 1) * 1024]);
            Bf[s] = __builtin_bit_cast(bf16x8, pk);
        }
        const int cj = h * 64 + tn * 32 + mr;
        w0c = p.in[I_W0][cj]; a0c = p.in[I_A0][cj]; kac = p.in[I_KA][cj];
    }
    const int ht = tid & 255, et = ht >> 3, eg = ht & 7, ec = h * 64 + eg * 8;
    float muw[8], mua[8], mur[8], muk[8], muv[8], kkc[8], rkc[8], lnw[8], lnb[8];
    {
        auto ldc = [&](const float* src, float (&d)[8]) { const f32x4 a = *(const f32x4*)src, bq = *(const f32x4*)(src + 4); d[0] = a[0]; d[1] = a[1]; d[2] = a[2]; d[3] = a[3]; d[4] = bq[0]; d[5] = bq[1]; d[6] = bq[2]; d[7] = bq[3]; };
        ldc(p.in[I_MUW] + eg * 8, muw); ldc(p.in[I_MUA] + eg * 8, mua);
        ldc(p.in[I_MURKV] + ec, mur); ldc(p.in[I_MURKV] + 1024 + ec, muk); ldc(p.in[I_MURKV] + 2048 + ec, muv);
        ldc(p.in[I_KK] + ec, kkc); ldc(p.in[I_RK] + ec, rkc); ldc(p.in[I_LNW] + ec, lnw); ldc(p.in[I_LNB] + ec, lnb);
    }
    u32x4 L[10]; u32x4 Z;
#pragma unroll
    for (int i = 0; i < 10; ++i) L[i] = (u32x4){0u, 0u, 0u, 0u};
    Z = (u32x4){0u, 0u, 0u, 0u};
    auto loadA = [&](int ch) {
        const size_t row = (size_t)b * SEQ + ch * 32 + et;
        const size_t prow = (ch * 32 + et) > 0 ? row - 1 : row;
        L[0] = *(const u32x4*)(PL + row * 256 + eg * 8); L[1] = *(const u32x4*)(PL + prow * 256 + eg * 8);
        L[2] = *(const u32x4*)(PL + row * 256 + 64 + eg * 8); L[3] = *(const u32x4*)(PL + prow * 256 + 64 + eg * 8);
#pragma unroll
        for (int q = 0; q < 3; ++q) { L[4 + 2 * q] = *(const u32x4*)(PB + row * 4096 + q * 1024 + ec); L[5 + 2 * q] = *(const u32x4*)(PB + prow * 4096 + q * 1024 + ec); }
    };
    auto loadZ = [&](int ch) { Z = *(const u32x4*)(PB + ((size_t)b * SEQ + ch * 32 + et) * 4096 + 3072 + ec); };
    auto unp = [&](const u32x4& v, float (&f)[8]) {
#pragma unroll
        for (int i = 0; i < 4; ++i) { f[2 * i] = bflo(v[i]); f[2 * i + 1] = bfhi(v[i]); } };
    auto stepA = [&](int ch, int buf) {
        const float pm = (ch * 32 + et) > 0 ? 1.0f : 0.0f;
        LAS unsigned char* bb = lds + buf * SB_SIZE;
        float cur[8], prv[8], x[8];
        unp(L[0], cur); unp(L[1], prv);
        u32x4 o;
#pragma unroll
        for (int i = 0; i < 8; ++i) { const float xx = cur[i] + muw[i] * (prv[i] * pm - cur[i]); x[i] = 1.0f - 2.0f * __builtin_amdgcn_rcpf(1.0f + __expf(2.0f * xx)); }
        o[0] = pack2(x[0], x[1]); o[1] = pack2(x[2], x[3]); o[2] = pack2(x[4], x[5]); o[3] = pack2(x[6], x[7]);
        *(LAS u32x4*)(lds + SC_AWD + et * SC_ASTR + eg * 16) = o;
        unp(L[2], cur); unp(L[3], prv);
#pragma unroll
        for (int i = 0; i < 8; ++i) x[i] = cur[i] + mua[i] * (prv[i] * pm - cur[i]);
        o[0] = pack2(x[0], x[1]); o[1] = pack2(x[2], x[3]); o[2] = pack2(x[4], x[5]); o[3] = pack2(x[6], x[7]);
        *(LAS u32x4*)(lds + SC_AAD + et * SC_ASTR + eg * 16) = o;
#pragma unroll
        for (int q = 0; q < 3; ++q) {
            unp(L[4 + 2 * q], cur); unp(L[5 + 2 * q], prv);
#pragma unroll
            for (int i = 0; i < 8; ++i) { const float m = q == 0 ? mur[i] : (q == 1 ? muk[i] : muv[i]); x[i] = cur[i] + m * (prv[i] * pm - cur[i]); }
            const int dsto = (q == 0 ? SB_R : (q == 1 ? SB_KP : SB_V)) + et * 256 + eg * 32;
            *(LAS f32x4*)(bb + dsto) = (f32x4){x[0], x[1], x[2], x[3]};
            *(LAS f32x4*)(bb + dsto + 16) = (f32x4){x[4], x[5], x[6], x[7]};
            if (q == 1) {
                float kk[8]; float ss = 0.f;
#pragma unroll
                for (int i = 0; i < 8; ++i) { kk[i] = x[i] * kkc[i]; ss += kk[i] * kk[i]; }
                ss = reduce8(ss);
                const float rn = rsqrtf(fmaxf(ss, 1e-24f));
                *(LAS f32x4*)(bb + SB_KK + et * 256 + eg * 32) = (f32x4){kk[0] * rn, kk[1] * rn, kk[2] * rn, kk[3] * rn};
                *(LAS f32x4*)(bb + SB_KK + et * 256 + eg * 32 + 16) = (f32x4){kk[4] * rn, kk[5] * rn, kk[6] * rn, kk[7] * rn};
            }
        }
    };
    auto stepB = [&](int buf) {
        LAS unsigned char* bb = lds + buf * SB_SIZE;
        f32x16 acc;
#pragma unroll
        for (int i = 0; i < 16; ++i) acc[i] = 0.f;
        const int abase = (mat == 0 ? SC_AWD : SC_AAD) + mr * SC_ASTR + mh * 16;
#pragma unroll
        for (int s = 0; s < 4; ++s) { const bf16x8 a = *(const LAS bf16x8*)(lds + abase + s * 32); acc = MFMA32(a, Bf[s], acc); }
        const int jcol = tn * 32 + mr;
#pragma unroll
        for (int i = 0; i < 16; ++i) {
            const int t = crow(i, mh);
            if (mat == 0) {
                const float y = -(w0c + acc[i]);
                const float sp = fmaxf(y, 0.f) + __logf(1.0f + __expf(-fabsf(y)));
                const float w = -sp - 0.5f;
                *(LAS float*)(bb + SB_W + t * 256 + jcol * 4) = __expf(-__expf(w));
            } else {
                const float a = sigmoidf_(a0c + acc[i]);
                const float kl = *(LAS float*)(bb + SB_KP + t * 256 + jcol * 4);
                const float kk = *(LAS float*)(bb + SB_KK + t * 256 + jcol * 4);
                *(LAS float*)(bb + SB_KP + t * 256 + jcol * 4) = kl * (1.0f + (a - 1.0f) * kac);
                *(LAS float*)(bb + SB_BV + t * 256 + jcol * 4) = kk * a;
            }
        }
    };
    auto epi = [&](int ch, int buf) {
        const size_t row = (size_t)b * SEQ + ch * 32 + et;
        LAS unsigned char* bb = lds + buf * SB_SIZE;
        const f32x4 o0 = *(const LAS f32x4*)(bb + SB_O + et * 256 + eg * 32), o1 = *(const LAS f32x4*)(bb + SB_O + et * 256 + eg * 32 + 16);
        float o[8] = {o0[0], o0[1], o0[2], o0[3], o1[0], o1[1], o1[2], o1[3]};
        float sm = 0.f;
#pragma unroll
        for (int i = 0; i < 8; ++i) sm += o[i];
        const float mean = reduce8(sm) * (1.0f / 64.0f);
        float sv = 0.f;
#pragma unroll
        for (int i = 0; i < 8; ++i) { const float d = o[i] - mean; sv += d * d; }
        const float rstd = rsqrtf(reduce8(sv) * (1.0f / 64.0f) + 64e-5f);
        const f32x4 r0 = *(const LAS f32x4*)(bb + SB_R + et * 256 + eg * 32), r1 = *(const LAS f32x4*)(bb + SB_R + et * 256 + eg * 32 + 16);
        const f32x4 k0 = *(const LAS f32x4*)(bb + SB_KP + et * 256 + eg * 32), k1 = *(const LAS f32x4*)(bb + SB_KP + et * 256 + eg * 32 + 16);
        float bs = r0[0] * k0[0] * rkc[0] + r0[1] * k0[1] * rkc[1] + r0[2] * k0[2] * rkc[2] + r0[3] * k0[3] * rkc[3]
                 + r1[0] * k1[0] * rkc[4] + r1[1] * k1[1] * rkc[5] + r1[2] * k1[2] * rkc[6] + r1[3] * k1[3] * rkc[7];
        bs = reduce8(bs);
        const f32x4 v0 = *(const LAS f32x4*)(bb + SB_V + et * 256 + eg * 32), v1 = *(const LAS f32x4*)(bb + SB_V + et * 256 + eg * 32 + 16);
        float z[8]; unp(Z, z);
        float y[8];
#pragma unroll
        for (int i = 0; i < 8; ++i) {
            const float vv = i < 4 ? v0[i] : v1[i - 4];
            y[i] = ((o[i] - mean) * rstd * lnw[i] + lnb[i] + bs * vv) * siluf_(z[i]);
        }
        u32x4 ov; ov[0] = pack2(y[0], y[1]); ov[1] = pack2(y[2], y[3]); ov[2] = pack2(y[4], y[5]); ov[3] = pack2(y[6], y[7]);
        *(u32x4*)(YB + row * 1024 + ec) = ov;
    };

    if (helper) {
        loadA(0); stepA(0, 0); loadA(1);
        __syncthreads();
        stepB(0);
        __syncthreads();
#pragma unroll 1
        for (int ch = 0; ch < SEQ / 32; ++ch) {
            const int buf = ch & 1;
            if (ch > 0) epi(ch - 1, buf ^ 1);
            if (ch + 1 < SEQ / 32) stepA(ch + 1, buf ^ 1);
            if (ch + 2 < SEQ / 32) loadA(ch + 2);
            __syncthreads();
            if (ch + 1 < SEQ / 32) stepB(buf ^ 1);
            loadZ(ch);
            __syncthreads();
        }
        epi(SEQ / 32 - 1, 1);
        __syncthreads();
    } else {
        const int il = lane >> 3, jl = lane & 7, row0 = (wid & 3) * 16 + il * 2;
        f32x2 S0[4], S1[4];
#pragma unroll
        for (int q = 0; q < 4; ++q) { S0[q] = (f32x2){0.f, 0.f}; S1[q] = (f32x2){0.f, 0.f}; }
        __syncthreads();
        __syncthreads();
#pragma unroll 1
        for (int ch = 0; ch < SEQ / 32; ++ch) {
            const int buf = ch & 1;
            const LAS unsigned char* bp = lds + buf * SB_SIZE + jl * 32;
            const LAS unsigned char* vp = lds + buf * SB_SIZE + SB_V + row0 * 4;
            LAS unsigned char* op = lds + buf * SB_SIZE + SB_O + row0 * 4;
#pragma unroll 1
            for (int half = 0; half < 2; ++half) {
                ScanOps oa, ob;
                scan_load(oa, bp + half * 16 * 256, vp + half * 16 * 256);
#pragma unroll 1
                for (int t = half * 16; t < half * 16 + 16; t += 2) {
                    scan_load(ob, bp + (t + 1) * 256, vp + (t + 1) * 256);
                    scan_step(S0, S1, oa, op + t * 256, jl == 0);
                    scan_load(oa, bp + (t + 2) * 256, vp + (t + 2) * 256);
                    scan_step(S0, S1, ob, op + (t + 1) * 256, jl == 0);
                }
                __syncthreads();
            }
        }
        __syncthreads();
    }
}

template <int HD> struct AttnCfg { static constexpr int KSTR = HD * 2 + 16, VSTR = 136, VROWS = HD, K_OFF = 0, V_OFF = 64 * KSTR, BIAS_OFF = V_OFF + VROWS * VSTR; };

template <int HD>
DI void attn_load_q(bf16x8 (&Qf)[HD / 16], const bf16_t* qrow, const float* g, float scale, int mh) {
    u32x4 raw[HD / 16]; float ss = 0.f;
#pragma unroll
    for (int s = 0; s < HD / 16; ++s) {
        raw[s] = *(const u32x4*)(qrow + 16 * s + 8 * mh);
#pragma unroll
        for (int i = 0; i < 4; ++i) { const float a = bflo(raw[s][i]), bb = bfhi(raw[s][i]); ss += a * a + bb * bb; }
    }
    ss += __shfl_xor(ss, 32);
    const float rstd = rsqrtf(ss * (1.0f / HD) + 1e-6f) * scale;
#pragma unroll
    for (int s = 0; s < HD / 16; ++s) {
        const f32x4 g0 = *(const f32x4*)(g + 16 * s + 8 * mh), g1 = *(const f32x4*)(g + 16 * s + 8 * mh + 4);
        u32x4 o;
        o[0] = pack2(bflo(raw[s][0]) * rstd * g0[0], bfhi(raw[s][0]) * rstd * g0[1]);
        o[1] = pack2(bflo(raw[s][1]) * rstd * g0[2], bfhi(raw[s][1]) * rstd * g0[3]);
        o[2] = pack2(bflo(raw[s][2]) * rstd * g1[0], bfhi(raw[s][2]) * rstd * g1[1]);
        o[3] = pack2(bflo(raw[s][3]) * rstd * g1[2], bfhi(raw[s][3]) * rstd * g1[3]);
        Qf[s] = __builtin_bit_cast(bf16x8, o);
    }
}
template <int HD> struct KVRegs { u32x4 k[HD / 64]; u32x4 v[HD == 128 ? 2 : 4]; };
template <int HD>
DI void attn_fetch(KVRegs<HD>& R, const bf16_t* ksrc, size_t ldk, const bf16_t* vsrc, size_t ldv, int tid) {
    constexpr int EPT = HD / 8;
    const int key = tid >> 3, part = tid & 7;
    const bf16_t* src = ksrc + (size_t)key * ldk + part * EPT;
#pragma unroll
    for (int v = 0; v < EPT / 8; ++v) R.k[v] = *(const u32x4*)(src + v * 8);
    constexpr int TPR = 512 / HD, KPT = 64 / TPR;
    const int d = tid / TPR, vpart = tid % TPR;
    const bf16_t* vs = vsrc + (size_t)d * ldv + vpart * KPT;
#pragma unroll
    for (int v = 0; v < KPT / 8; ++v) R.v[v] = *(const u32x4*)(vs + v * 8);
}
template <int HD>
DI void attn_commit(const KVRegs<HD>& R, LAS unsigned char* lds, const float (&gkr)[HD / 8], int tid) {
    constexpr int EPT = HD / 8;
    const int key = tid >> 3, part = tid & 7;
    float ss = 0.f;
#pragma unroll
    for (int v = 0; v < EPT / 8; ++v)
#pragma unroll
        for (int i = 0; i < 4; ++i) { const float a = bflo(R.k[v][i]), bb = bfhi(R.k[v][i]); ss += a * a + bb * bb; }
    ss = reduce8(ss);
    const float rstd = rsqrtf(ss * (1.0f / HD) + 1e-6f);
#pragma unroll
    for (int v = 0; v < EPT / 8; ++v) {
        u32x4 o;
        o[0] = pack2(bflo(R.k[v][0]) * rstd * gkr[v * 8 + 0], bfhi(R.k[v][0]) * rstd * gkr[v * 8 + 1]);
        o[1] = pack2(bflo(R.k[v][1]) * rstd * gkr[v * 8 + 2], bfhi(R.k[v][1]) * rstd * gkr[v * 8 + 3]);
        o[2] = pack2(bflo(R.k[v][2]) * rstd * gkr[v * 8 + 4], bfhi(R.k[v][2]) * rstd * gkr[v * 8 + 5]);
        o[3] = pack2(bflo(R.k[v][3]) * rstd * gkr[v * 8 + 6], bfhi(R.k[v][3]) * rstd * gkr[v * 8 + 7]);
        *(LAS u32x4*)(lds + AttnCfg<HD>::K_OFF + key * AttnCfg<HD>::KSTR + (part * EPT + v * 8) * 2) = o;
    }
    constexpr int TPR = 512 / HD, KPT = 64 / TPR;
    const int d = tid / TPR, vpart = tid % TPR;
#pragma unroll
    for (int v = 0; v < KPT / 8; ++v) {
        LAS unsigned char* dp = lds + AttnCfg<HD>::V_OFF + d * AttnCfg<HD>::VSTR + (vpart * KPT + v * 8) * 2;
        *(LAS u32x2*)dp = (u32x2){R.v[v][0], R.v[v][1]};
        *(LAS u32x2*)(dp + 8) = (u32x2){R.v[v][2], R.v[v][3]};
    }
}
template <int HD, bool BIAS, bool QLDS>
DI void attn_chunk(const bf16x8 (&Qf)[HD / 16], const LAS unsigned char* qp, f32x16 (&O)[4], float& m_run, float& l_run, const LAS unsigned char* lds, int dbase, int mr, int mh, int qk_delta) {
#pragma unroll 1
    for (int kt = 0; kt < 2; ++kt) {
        f32x16 sc;
#pragma unroll
        for (int i = 0; i < 16; ++i) sc[i] = 0.f;
        const LAS unsigned char* kp = lds + AttnCfg<HD>::K_OFF + (kt * 32 + mr) * AttnCfg<HD>::KSTR + mh * 16;
        f32x16 sc2;
#pragma unroll
        for (int i = 0; i < 16; ++i) sc2[i] = 0.f;
#pragma unroll
        for (int s = 0; s < HD / 16; s += 2) {
            if ((s & 3) == 0) __builtin_amdgcn_sched_barrier(0);
            const bf16x8 a0 = *(const LAS bf16x8*)(kp + s * 32), a1 = *(const LAS bf16x8*)(kp + s * 32 + 32);
            const bf16x8 qb0 = QLDS ? *(const LAS bf16x8*)(qp + s * 32) : Qf[s], qb1 = QLDS ? *(const LAS bf16x8*)(qp + s * 32 + 32) : Qf[s + 1];
            sc = MFMA32(a0, qb0, sc); sc2 = MFMA32(a1, qb1, sc2);
        }
#pragma unroll
        for (int i = 0; i < 16; ++i) sc[i] += sc2[i];
        float mx = -1e30f;
        if (BIAS) {
            if (qk_delta >= 192) {
                const float cb = *(const LAS float*)(lds + AttnCfg<HD>::BIAS_OFF + 256 * 4);
#pragma unroll
                for (int i = 0; i < 16; ++i) sc[i] += cb;
            } else {
#pragma unroll
                for (int i = 0; i < 16; ++i) {
                    int dist = qk_delta + mr - (kt * 32 + crow(i, mh));
                    dist = dist < -128 ? -128 : (dist > 128 ? 128 : dist);
                    sc[i] += *(const LAS float*)(lds + AttnCfg<HD>::BIAS_OFF + (dist + 128) * 4);
                }
            }
        }
#pragma unroll
        for (int i = 0; i < 16; ++i) mx = fmaxf(mx, sc[i]);
        mx = fmaxf(mx, __shfl_xor(mx, 32));
        const float m_new = fmaxf(m_run, mx), alpha = __builtin_amdgcn_exp2f(m_run - m_new);
        float ls = 0.f;
#pragma unroll
        for (int i = 0; i < 16; ++i) { const float pv = __builtin_amdgcn_exp2f(sc[i] - m_new); sc[i] = pv; ls += pv; }
        l_run = l_run * alpha + ls;
        if (__builtin_amdgcn_ballot_w64(m_new > m_run) != 0ull) {
#pragma unroll
            for (int dt = 0; dt < 4; ++dt)
#pragma unroll
                for (int i = 0; i < 16; ++i) O[dt][i] *= alpha;
        }
        m_run = m_new;
#pragma unroll
        for (int s2 = 0; s2 < 2; ++s2) {
            u32x4 pk;
#pragma unroll
            for (int j = 0; j < 4; ++j) pk[j] = pack2(sc[8 * s2 + 2 * j], sc[8 * s2 + 2 * j + 1]);
            const bf16x8 pb = __builtin_bit_cast(bf16x8, pk);
#pragma unroll
            for (int dt = 0; dt < 4; ++dt) {
                const LAS unsigned char* vp = lds + AttnCfg<HD>::V_OFF + (dbase + dt * 32 + mr) * AttnCfg<HD>::VSTR + (kt * 32 + 16 * s2 + 4 * mh) * 2;
                const u32x2 lo = *(const LAS u32x2*)vp, hi = *(const LAS u32x2*)(vp + 16);
                const u32x4 va = {lo[0], lo[1], hi[0], hi[1]};
                O[dt] = MFMA32(__builtin_bit_cast(bf16x8, va), pb, O[dt]);
            }
        }
    }
}
DI void attn_store(const f32x16 (&O)[4], float l_run, const bf16_t* zrow, bf16_t* yrow, int mh) {
    const float lt = l_run + __shfl_xor(l_run, 32);
    const float inv = 1.0f / lt;
#pragma unroll
    for (int dt = 0; dt < 4; ++dt)
#pragma unroll
        for (int g = 0; g < 4; ++g) {
            const int d = dt * 32 + 8 * g + 4 * mh;
            const u32x2 zz = *(const u32x2*)(zrow + d);
            u32x2 o;
            o[0] = pack2(O[dt][4 * g] * inv * siluf_(bflo(zz[0])), O[dt][4 * g + 1] * inv * siluf_(bfhi(zz[0])));
            o[1] = pack2(O[dt][4 * g + 2] * inv * siluf_(bflo(zz[1])), O[dt][4 * g + 3] * inv * siluf_(bfhi(zz[1])));
            *(u32x2*)(yrow + d) = o;
        }
}

DI void attnA_item(const Params& p, unsigned char* smem, int item) {
    const int b = item >> 6, head = (item >> 3) & 7, cgp = item & 7;
    int tid = threadIdx.x; asm volatile("" : "+v"(tid));
    const int wid = tid >> 6, lane = tid & 63, mr = lane & 31, mh = lane >> 5;
    LAS unsigned char* lds = (LAS unsigned char*)smem;
    const bf16_t* PA = (const bf16_t*)(p.ws + OFF_PA);
    const bf16_t* VT = (const bf16_t*)(p.ws + OFF_VT);
    bf16_t* YA = (bf16_t*)((char*)p.out + OFF_YA);
    const int cw = cgp * 4 + (wid >> 1), qt = wid & 1;
    const size_t qrow = (size_t)b * SEQ + cw * 64 + qt * 32 + mr;
    if (tid < 257) *(LAS float*)(lds + AttnCfg<128>::BIAS_OFF + tid * 4) = p.in[I_RELB][head * 257 + tid] * 1.4426950408889634f;
    bf16x8 Qf[8];
    attn_load_q<128>(Qf, PA + qrow * 3072 + head * 128, p.in[I_AQG], 0.08838834764831845f * 1.4426950408889634f, mh);
    f32x16 O[4];
#pragma unroll
    for (int dt = 0; dt < 4; ++dt)
#pragma unroll
        for (int i = 0; i < 16; ++i) O[dt][i] = 0.f;
    float m_run = -1e30f, l_run = 0.f;
    const int kc0 = cgp * 4 - 8 < 0 ? 0 : cgp * 4 - 8, kc1 = cgp * 4 + 3;
    const bf16_t* kbase = PA + (size_t)b * SEQ * 3072 + 1024 + head * 128;
    const bf16_t* vbase = VT + (size_t)(head * 128) * T_TOK + (size_t)b * SEQ;
    float gkr[16];
    {
#pragma unroll
        for (int i = 0; i < 4; ++i) { const f32x4 g4 = *(const f32x4*)(p.in[I_AKG] + (tid & 7) * 16 + i * 4); gkr[4 * i] = g4[0]; gkr[4 * i + 1] = g4[1]; gkr[4 * i + 2] = g4[2]; gkr[4 * i + 3] = g4[3]; }
    }
    KVRegs<128> R;
    attn_fetch<128>(R, kbase + (size_t)kc0 * 64 * 3072, 3072, vbase + kc0 * 64, T_TOK, tid);
    for (int kc = kc0; kc <= kc1; ++kc) {
        __syncthreads();
        attn_commit<128>(R, lds, gkr, tid);
        __syncthreads();
        if (kc < kc1) attn_fetch<128>(R, kbase + (size_t)(kc + 1) * 64 * 3072, 3072, vbase + (kc + 1) * 64, T_TOK, tid);
        if (kc >= cw - 8 && kc <= cw)
            attn_chunk<128, true, false>(Qf, lds, O, m_run, l_run, lds, 0, mr, mh, (cw - kc) * 64 + qt * 32);
    }
    attn_store(O, l_run, PA + qrow * 3072 + 2048 + head * 128, YA + qrow * 1024 + head * 128, mh);
    __syncthreads();
    if (tid == 0) __hip_atomic_fetch_add((unsigned*)(p.ws + OFF_CTR + 64), 1u, __ATOMIC_RELAXED, __HIP_MEMORY_SCOPE_AGENT);
}
DI void attnC_item(const Params& p, unsigned char* smem, int item) {
    const int b = item >> 6, hc = (item >> 4) & 3, qg = item & 15;
    int tid = threadIdx.x; asm volatile("" : "+v"(tid));
    const int wid = tid >> 6, lane = tid & 63, mr = lane & 31, mh = lane >> 5;
    LAS unsigned char* lds = (LAS unsigned char*)smem;
    const bf16_t* PC = (const bf16_t*)(p.ws + OFF_PC);
    const bf16_t* MK = (const bf16_t*)(p.ws + OFF_MK);
    const bf16_t* MVT = (const bf16_t*)(p.ws + OFF_MVT);
    bf16_t* YC = (bf16_t*)((char*)p.out + OFF_YC);
    const int qt = wid >> 1, dh = wid & 1;
    const size_t qrow = (size_t)b * SEQ + qg * 128 + qt * 32 + mr;
    constexpr int Q_OFF = AttnCfg<256>::V_OFF + 256 * AttnCfg<256>::VSTR;
    __syncthreads();
    {
        bf16x8 Qf[16];
        attn_load_q<256>(Qf, PC + qrow * 2048 + hc * 256, p.in[I_CQG], 0.0625f * 1.4426950408889634f, mh);
        if (dh == 0) {
#pragma unroll
            for (int s = 0; s < 16; ++s) *(LAS bf16x8*)(lds + Q_OFF + (qt * 32 + mr) * 528 + s * 32 + mh * 16) = Qf[s];
        }
    }
    const LAS unsigned char* qp = lds + Q_OFF + (qt * 32 + mr) * 528 + mh * 16;
    bf16x8 Qd[16];
    f32x16 O[4];
#pragma unroll
    for (int dt = 0; dt < 4; ++dt)
#pragma unroll
        for (int i = 0; i < 16; ++i) O[dt][i] = 0.f;
    float m_run = -1e30f, l_run = 0.f;
    const bf16_t* kbase = MK + (size_t)b * NMEM * 1024 + hc * 256;
    const bf16_t* vbase = MVT + (size_t)(hc * 256) * 2048 + (size_t)b * NMEM;
    float gkr[32];
    {
#pragma unroll
        for (int i = 0; i < 8; ++i) { const f32x4 g4 = *(const f32x4*)(p.in[I_CKG] + (tid & 7) * 32 + i * 4); gkr[4 * i] = g4[0]; gkr[4 * i + 1] = g4[1]; gkr[4 * i + 2] = g4[2]; gkr[4 * i + 3] = g4[3]; }
    }
    KVRegs<256> R;
    attn_fetch<256>(R, kbase, 1024, vbase, 2048, tid);
    for (int kc = 0; kc < 4; ++kc) {
        __syncthreads();
        attn_commit<256>(R, lds, gkr, tid);
        __syncthreads();
        if (kc < 3) attn_fetch<256>(R, kbase + (size_t)(kc + 1) * 64 * 1024, 1024, vbase + (kc + 1) * 64, 2048, tid);
        attn_chunk<256, false, true>(Qd, qp, O, m_run, l_run, lds, dh * 128, mr, mh, 0);
    }
    attn_store(O, l_run, PC + qrow * 2048 + 1024 + hc * 256 + dh * 128, YC + qrow * 1024 + hc * 256 + dh * 128, mh);
    __syncthreads();
}
DI void phase2(const Params& p, unsigned char* smem) {
    const int c = blockIdx.x;
    if (c < 128) scan_item(p, smem, c);
    for (int it = c + p.G; it < 128 && c < 128; it += p.G) scan_item(p, smem, it);
    unsigned* ctr = (unsigned*)(p.ws + OFF_CTR);
    LAS int* sitem = (LAS int*)((LAS unsigned char*)smem + LDS_BYTES - 16);
    auto fetch = [&]() -> int {
        __syncthreads();
        if (threadIdx.x == 0) *sitem = (int)atomicAdd(ctr, 1u);
        __syncthreads();
        return *sitem;
    };
    int item = fetch();
    while (item < 512) { attnA_item(p, smem, item); item = fetch(); }
    while (item < 1024) { attnC_item(p, smem, item - 512); item = fetch(); }
    if (blockIdx.x >= 128 && p.G == 256) {
        if (threadIdx.x == 0) { while (__hip_atomic_load((unsigned*)(p.ws + OFF_CTR + 64), __ATOMIC_RELAXED, __HIP_MEMORY_SCOPE_AGENT) < 512u) __builtin_amdgcn_s_sleep(8); }
        __syncthreads();
        gemm_phase<5>((LAS unsigned char*)smem, p);
    }
}

#define XB_TMO      128
#define XB_XCNT(j)  (256  + 64 * (j))
#define XB_XSUB(j)  (1280 + 64 * (j))
#define XB_XGEN(j)  (2304 + 64 * (j))
#define XB_TOP      3328
#define XB_TOPGEN   3392
#define XB_SPIN_CAP (1u << 18)
DI unsigned xb_ld(unsigned* p) { return __hip_atomic_load(p, __ATOMIC_RELAXED, __HIP_MEMORY_SCOPE_AGENT); }
DI unsigned xb_add(unsigned* p, unsigned v) { return __hip_atomic_fetch_add(p, v, __ATOMIC_RELAXED, __HIP_MEMORY_SCOPE_AGENT); }
DI unsigned xb_xcc_id() { return (unsigned)__builtin_amdgcn_s_getreg((3 << 11) | 20) & 0xFu; }
#define XB_SPIN(cond, bar) do { unsigned _sp = 0; while (cond) { __builtin_amdgcn_s_sleep(1); \
    if ((++_sp & 255u) == 0u) { if (xb_ld(&(bar)[XB_TMO])) break; if (_sp > XB_SPIN_CAP) { atomicAdd(&(bar)[XB_TMO], 1u); break; } } } } while (0)
struct XcdBarrier { unsigned* bar; unsigned x; volatile LAS unsigned* st; };
DI XcdBarrier xcd_barrier_post(unsigned* bar, volatile LAS unsigned* st) {
    XcdBarrier b; b.bar = bar; b.x = xb_xcc_id(); b.st = st;
    if (threadIdx.x == 0) (void)xb_add(&bar[XB_XCNT(b.x)], 1u);
    return b;
}
DI void xcd_barrier_complete(unsigned* bar, unsigned x, unsigned& nloc, unsigned& nx) {
    const unsigned G = gridDim.x * gridDim.y * gridDim.z;
    unsigned sum, cnt, mine, sp = 0u;
    for (;;) {
        sum = 0u; cnt = 0u; mine = 0u;
#pragma unroll
        for (unsigned j = 0; j < 16; ++j) { const unsigned c = xb_ld(&bar[XB_XCNT(j)]); sum += c; cnt += (c > 0u) ? 1u : 0u; mine = (j == x) ? c : mine; }
        if (sum == G) break;
        __builtin_amdgcn_s_sleep(1);
        if ((++sp & 255u) == 0u) { if (xb_ld(&bar[XB_TMO])) break; if (sp > XB_SPIN_CAP) { atomicAdd(&bar[XB_TMO], 1u); break; } }
    }
    nloc = mine > 0u ? mine : 1u; nx = cnt > 0u ? cnt : 1u;
}
DI void xcd_barrier(const XcdBarrier& b) {
    asm volatile("s_waitcnt vmcnt(0)" ::: "memory");
    __syncthreads();
    if (threadIdx.x == 0) {
        unsigned* bar = b.bar;
        __builtin_amdgcn_s_waitcnt(0);
        unsigned nloc = b.st[0], nx = b.st[1];
        if (nloc == 0u) { xcd_barrier_complete(bar, b.x, nloc, nx); b.st[0] = nloc; b.st[1] = nx; }
        const unsigned old = xb_add(&bar[XB_XSUB(b.x)], 1u);
        const unsigned gen = old / nloc;
        if (old + 1u == (gen + 1u) * nloc) {
            __builtin_amdgcn_fence(__ATOMIC_RELEASE, "agent");
            asm volatile("s_waitcnt vmcnt(0)" ::: "memory");
            const unsigned og = xb_add(&bar[XB_TOP], 1u);
            const unsigned tg = og / nx;
            if (og + 1u == (tg + 1u) * nx) xb_add(&bar[XB_TOPGEN], 1u);
            else XB_SPIN(xb_ld(&bar[XB_TOPGEN]) == tg, bar);
            __builtin_amdgcn_fence(__ATOMIC_ACQUIRE, "agent");
            xb_add(&bar[XB_XGEN(b.x)], 1u);
            asm volatile("s_waitcnt vmcnt(0)" ::: "memory");
        } else {
            XB_SPIN(xb_ld(&bar[XB_XGEN(b.x)]) == gen, bar);
            __builtin_amdgcn_fence(__ATOMIC_ACQUIRE, "agent");
            asm volatile("s_waitcnt vmcnt(0)" ::: "memory");
        }
    }
    __syncthreads();
}

__global__ void __launch_bounds__(NTHREADS) hybrid_fwd(Params p) {
    extern __shared__ __attribute__((aligned(16))) unsigned char smem[];
    cg::grid_group grid = cg::this_grid();
    volatile LAS unsigned* xst = (volatile LAS unsigned*)((LAS unsigned char*)smem + LDS_BYTES - 32);
    if (threadIdx.x == 0) { xst[0] = 0u; xst[1] = 0u; }
    __syncthreads();
    const XcdBarrier xb = xcd_barrier_post((unsigned*)(p.ws + OFF_BAR), xst);
    if (p.pad == 0x5a5a5a5a) grid.sync();
    phase0(p, smem);
    xcd_barrier(xb);
    gemm_phase<1>((LAS unsigned char*)smem, p); gemm_phase<7>((LAS unsigned char*)smem, p);
    xcd_barrier(xb);
    phase2(p, smem);
    xcd_barrier(xb);
    gemm_phase<3>((LAS unsigned char*)smem, p);
    xcd_barrier(xb);
    gemm_phase<4>((LAS unsigned char*)smem, p);
}

extern "C" void kernel_launch(void* const* d_in, const int* in_sizes, int n_in, void* d_out, int out_size, void* d_ws, size_t ws_size, hipStream_t stream) {
    static int grid_blocks = 0;
    if (grid_blocks == 0) {
        if (n_in != 27 || ws_size < WS_END || out_size != T_TOK * DM) { fprintf(stderr, "kernel_launch: unexpected shapes (n_in %d ws %zu out %d)\n", n_in, ws_size, out_size); grid_blocks = -1; return; }
        int dev = 0, cus = 0, per_cu = 0;
        hipGetDevice(&dev);
        hipDeviceGetAttribute(&cus, hipDeviceAttributeMultiprocessorCount, dev);
        if (hipFuncSetAttribute((const void*)hybrid_fwd, hipFuncAttributeMaxDynamicSharedMemorySize, LDS_BYTES) != hipSuccess) { fprintf(stderr, "kernel_launch: hipFuncSetAttribute failed\n"); grid_blocks = -1; return; }
        if (hipOccupancyMaxActiveBlocksPerMultiprocessor(&per_cu, (const void*)hybrid_fwd, NTHREADS, LDS_BYTES) != hipSuccess || per_cu < 1) { fprintf(stderr, "kernel_launch: occupancy query failed (%d)\n", per_cu); grid_blocks = -1; return; }
        grid_blocks = cus * 1;
        if (grid_blocks != 256) { fprintf(stderr, "kernel_launch: built for 256 CUs, found %d\n", cus); grid_blocks = -1; return; }
    }
    if (grid_blocks < 0) return;
    if (hipMemsetAsync((char*)d_ws + OFF_CTR, 0, 256 + BAR_BYTES, stream) != hipSuccess) { fprintf(stderr, "kernel_launch: hipMemsetAsync failed\n"); return; }
    Params p{};
    for (int i = 0; i < 27; ++i) p.in[i] = (const float*)d_in[i];
    p.out = (float*)d_out; p.ws = (unsigned char*)d_ws; p.G = grid_blocks; p.pad = 0;
    void* args[] = {&p};
    hipError_t e = hipLaunchCooperativeKernel((const void*)hybrid_fwd, dim3(grid_blocks), dim3(NTHREADS), args, LDS_BYTES, stream);
    if (e != hipSuccess) fprintf(stderr, "cooperative launch failed: %s (grid %d)\n", hipGetErrorString(e), grid_blocks);
}
```
